# Optimizing an MI355X kernel written in HIP

```python
import math
import jax, jax.numpy as jnp
from jax import lax
import numpy as np

D_MODEL = 1024
BATCH = 2
SEQ = 8192
DEPTH = 1
DEC_BATCH = 32
DEC_SEQ = 4
PAST_LEN = 8192
PAGE_SIZE = 128

MIX_WIDTH = D_MODEL
HEAD_DIM = 64
ATT_WIDTH = MIX_WIDTH // 2
N_ATT_HEADS = ATT_WIDTH // HEAD_DIM
DILATED_BRANCHES = ((128, 1), (512, 4), (2048, 16))
MAX_WINDOW = 2048
ROPE_THETA = 10000.0
SSM_WIDTH = MIX_WIDTH - ATT_WIDTH
SSM_HEAD_DIM = 64
N_SSM_HEADS = SSM_WIDTH // SSM_HEAD_DIM
SSM_GROUPS = 2
SSM_STATE = 128
CONV_WIDTH = 4
SSD_CHUNK = 128
CONV_CH = SSM_WIDTH + 2 * SSM_GROUPS * SSM_STATE
IN_SIZES = (ATT_WIDTH, ATT_WIDTH, ATT_WIDTH, SSM_WIDTH, CONV_CH, N_SSM_HEADS)
IN_WIDTH = sum(IN_SIZES)
N_MEM = 256
N_XATT_HEADS = 4
XATT_HEAD_DIM = D_MODEL // N_XATT_HEADS
XATT_WIDTH = N_XATT_HEADS * XATT_HEAD_DIM
D_FF = 4 * D_MODEL
EPS = 1e-6
F32 = jnp.float32

kernel_name = 'dilated_ssd_hybrid_step'


def rmsnorm(x, g):
    xf = x.astype(F32)
    y = xf * lax.rsqrt(jnp.mean(xf * xf, axis=-1, keepdims=True) + EPS)
    return (y * g.astype(F32)).astype(x.dtype)


def rope(t, pos):
    half = HEAD_DIM // 2
    inv = ROPE_THETA ** (-jnp.arange(half, dtype=F32) * 2.0 / HEAD_DIM)
    ang = pos.astype(F32)[:, None] * inv[None, :]
    cos = jnp.cos(ang)[None, :, None, :]
    sin = jnp.sin(ang)[None, :, None, :]
    tf = t.astype(F32)
    t1, t2 = tf[..., :half], tf[..., half:]
    return jnp.concatenate([t1 * cos - t2 * sin, t2 * cos + t1 * sin], axis=-1).astype(t.dtype)


def softmax_stats(s):
    m = jnp.max(s, axis=-1, keepdims=True)
    p = jnp.exp(s - m)
    den = jnp.sum(p, axis=-1, keepdims=True)
    return p / den, (m + jnp.log(den))[..., 0]


def dilated_branch_prompt(q, k, v, window, dil):
    b, s_len, h, dh = q.shape
    n = window // dil
    span = n * dil
    lp = -(-s_len // span) * span
    m_len = lp // dil
    nb = m_len // n

    def to_blocks(t):
        t = jnp.pad(t, ((0, 0), (0, lp - s_len), (0, 0), (0, 0)))
        t = t.reshape(b, m_len, dil, h, dh).transpose(0, 2, 1, 3, 4)
        return t.reshape(b, dil, nb, n, h, dh)

    def with_prev(t):
        prev = jnp.pad(t, ((0, 0), (0, 0), (1, 0), (0, 0), (0, 0), (0, 0)))[:, :, :nb]
        return jnp.concatenate([prev, t], axis=3)

    qb = to_blocks(q)
    kb = with_prev(to_blocks(k))
    vb = with_prev(to_blocks(v))
    s = jnp.einsum('brjqhd,brjkhd->brjhqk', qb, kb) * (HEAD_DIM ** -0.5)
    a = jnp.arange(n)[:, None]
    c = jnp.arange(2 * n)[None, :]
    dist = a + n - c
    band = (dist >= 0) & (dist <= n)
    has_prev = (jnp.arange(nb) > 0)[:, None, None] | (c >= n)[None]
    mask = band[None] & has_prev
    s = jnp.where(mask[None, None, :, None], s, -jnp.inf)
    p, lse = softmax_stats(s)
    o = jnp.einsum('brjhqk,brjkhd->brjqhd', p, vb)
    o = o.reshape(b, dil, m_len, h, dh).transpose(0, 2, 1, 3, 4).reshape(b, lp, h, dh)[:, :s_len]
    lse = lse.transpose(0, 1, 2, 4, 3).reshape(b, dil, m_len, h)
    lse = lse.transpose(0, 2, 1, 3).reshape(b, lp, h)[:, :s_len]
    return o, lse


def dilated_branch_sample(q, k_all, v_all, window, dil):
    t_len = q.shape[1]
    lb = k_all.shape[1] - t_len
    n = window // dil
    idx = lb + jnp.arange(t_len)[:, None] - dil * jnp.arange(n + 1)[None, :]
    valid = idx >= 0
    idx = jnp.maximum(idx, 0)
    kg = k_all[:, idx]
    vg = v_all[:, idx]
    s = jnp.einsum('bthd,btkhd->bthk', q, kg) * (HEAD_DIM ** -0.5)
    s = jnp.where(valid[None, :, None, :], s, -jnp.inf)
    p, lse = softmax_stats(s)
    return jnp.einsum('bthk,btkhd->bthd', p, vg), lse


def combine_branches(outs, lses):
    w = jax.nn.softmax(jnp.stack(lses, axis=0), axis=0)
    return jnp.sum(w[..., None] * jnp.stack(outs, axis=0), axis=0)


def ssd_scan(xs, dt, a_neg, bm, cm, h0):
    b, l_len, nh, hp = xs.shape
    q = min(SSD_CHUNK, l_len)
    lp = -(-l_len // q) * q
    nc = lp // q

    def pad(t):
        return jnp.pad(t, ((0, 0), (0, lp - l_len)) + ((0, 0),) * (t.ndim - 2))

    rep = nh // SSM_GROUPS
    bh = jnp.repeat(pad(bm), rep, axis=2).reshape(b, nc, q, nh, SSM_STATE)
    ch = jnp.repeat(pad(cm), rep, axis=2).reshape(b, nc, q, nh, SSM_STATE)
    dtp = pad(dt)
    xdt = (pad(xs) * dtp[..., None]).reshape(b, nc, q, nh, hp)
    a = (dtp * a_neg).reshape(b, nc, q, nh).transpose(0, 3, 1, 2)
    a_cs = jnp.cumsum(a, axis=-1)
    tri = jnp.tril(jnp.ones((q, q), dtype=bool))
    decay_in = jnp.exp(jnp.where(tri, a_cs[..., :, None] - a_cs[..., None, :], -jnp.inf))
    scores = jnp.einsum('bclhn,bcshn->bhcls', ch, bh) * decay_in
    y_diag = jnp.einsum('bhcls,bcshp->bclhp', scores, xdt)
    to_end = jnp.exp(a_cs[..., -1:] - a_cs).transpose(0, 2, 3, 1)
    chunk_states = jnp.einsum('bclhn,bclhp->bchpn', bh, xdt * to_end[..., None])
    chunk_decay = jnp.exp(a_cs[..., -1])

    def step(h, inp):
        st, dec = inp
        return h * dec[..., None, None] + st, h

    h_last, h_start = lax.scan(step, h0, (chunk_states.transpose(1, 0, 2, 3, 4),
                                          chunk_decay.transpose(2, 0, 1)))
    h_start = h_start.transpose(1, 0, 2, 3, 4)
    from_start = jnp.exp(a_cs).transpose(0, 2, 3, 1)
    y_off = jnp.einsum('bclhn,bchpn->bclhp', ch, h_start) * from_start[..., None]
    y = (y_diag + y_off).reshape(b, lp, nh, hp)[:, :l_len]
    return y, h_last


def gated_rmsnorm(y, z, g):
    b, l_len, w = y.shape
    u = (y * jax.nn.silu(z.astype(F32))).reshape(b, l_len, SSM_GROUPS, w // SSM_GROUPS)
    u = u * lax.rsqrt(jnp.mean(u * u, axis=-1, keepdims=True) + EPS)
    return u.reshape(b, l_len, w) * g.astype(F32)


def mixer(h, pos, k_past, v_past, conv_prev, ssm_prev,
          w_in, conv_w, conv_b, dt_bias, a_log, d_skip, g_ssm, w_out):
    b, l_len, _ = h.shape
    offs = np.cumsum(IN_SIZES)[:-1].tolist()
    q, k, v, z, xbc, dt = jnp.split(h @ w_in, offs, axis=-1)
    q = rope(q.reshape(b, l_len, N_ATT_HEADS, HEAD_DIM), pos).astype(F32)
    k = rope(k.reshape(b, l_len, N_ATT_HEADS, HEAD_DIM), pos)
    v = v.reshape(b, l_len, N_ATT_HEADS, HEAD_DIM)
    outs, lses = [], []
    if k_past is None:
        for window, dil in DILATED_BRANCHES:
            o, l = dilated_branch_prompt(q, k.astype(F32), v.astype(F32), window, dil)
            outs.append(o)
            lses.append(l)
        lw = min(MAX_WINDOW, l_len)
        new_k, new_v = k[:, l_len - lw:], v[:, l_len - lw:]
        conv_prev = jnp.zeros((b, CONV_WIDTH - 1, CONV_CH), xbc.dtype)
        ssm_prev = jnp.zeros((b, N_SSM_HEADS, SSM_HEAD_DIM, SSM_STATE), F32)
    else:
        lb = k_past.shape[1]
        k_all = jnp.concatenate([k_past.astype(k.dtype), k], axis=1)
        v_all = jnp.concatenate([v_past.astype(v.dtype), v], axis=1)
        for window, dil in DILATED_BRANCHES:
            o, l = dilated_branch_sample(q, k_all.astype(F32), v_all.astype(F32), window, dil)
            outs.append(o)
            lses.append(l)
        new_k, new_v = k_all[:, -lb:], v_all[:, -lb:]
    att = combine_branches(outs, lses)

    xp = jnp.concatenate([conv_prev.astype(xbc.dtype), xbc], axis=1)
    new_conv = xp[:, -(CONV_WIDTH - 1):]
    xf = xp.astype(F32)
    conv = conv_b.astype(F32)
    for i in range(CONV_WIDTH):
        conv = conv + xf[:, i:i + l_len] * conv_w[i].astype(F32)
    conv = jax.nn.silu(conv)
    xs, bm, cm = jnp.split(conv, [SSM_WIDTH, SSM_WIDTH + SSM_GROUPS * SSM_STATE], axis=-1)
    xs = xs.reshape(b, l_len, N_SSM_HEADS, SSM_HEAD_DIM)
    bm = bm.reshape(b, l_len, SSM_GROUPS, SSM_STATE)
    cm = cm.reshape(b, l_len, SSM_GROUPS, SSM_STATE)
    dtv = jax.nn.softplus(dt.astype(F32) + dt_bias.astype(F32))
    a_neg = -jnp.exp(a_log.astype(F32))
    y, new_ssm = ssd_scan(xs, dtv, a_neg, bm, cm, ssm_prev.astype(F32))
    y = (y + d_skip.astype(F32)[:, None] * xs).reshape(b, l_len, SSM_WIDTH)
    y = gated_rmsnorm(y, z, g_ssm)
    mixed = jnp.concatenate([att.reshape(b, l_len, ATT_WIDTH), y], axis=-1).astype(h.dtype)
    return mixed @ w_out, (new_k, new_v, new_conv, new_ssm)


def memory_kv(mem, g_mem, w_mk, w_mv):
    b = mem.shape[0]
    m = rmsnorm(mem, g_mem)
    mk = (m @ w_mk).reshape(b, -1, N_XATT_HEADS, XATT_HEAD_DIM)
    mv = (m @ w_mv).reshape(b, -1, N_XATT_HEADS, XATT_HEAD_DIM)
    return mk, mv


def cross_attention(h, mem_k, mem_v, w_xq, w_xo):
    b, l_len, _ = h.shape
    q = (h @ w_xq).reshape(b, l_len, N_XATT_HEADS, XATT_HEAD_DIM).astype(F32)
    s = jnp.einsum('blhd,bmhd->bhlm', q, mem_k.astype(F32)) * (XATT_HEAD_DIM ** -0.5)
    p = jax.nn.softmax(s, axis=-1)
    o = jnp.einsum('bhlm,bmhd->blhd', p, mem_v.astype(F32)).reshape(b, l_len, XATT_WIDTH)
    return o.astype(h.dtype) @ w_xo


def trunk_layer(x, pos, k_past, v_past, conv_prev, ssm_prev, mem_k, mem_v,
                g_mix, w_in, conv_w, conv_b, dt_bias, a_log, d_skip, g_ssm, w_out,
                g_xatt, w_xq, w_xo, g_mlp, w_up, w_down):
    mix, new_state = mixer(rmsnorm(x, g_mix), pos, k_past, v_past, conv_prev, ssm_prev,
                           w_in, conv_w, conv_b, dt_bias, a_log, d_skip, g_ssm, w_out)
    x = x + mix
    x = x + cross_attention(rmsnorm(x, g_xatt), mem_k, mem_v, w_xq, w_xo)
    x = x + jnp.square(jax.nn.relu(rmsnorm(x, g_mlp) @ w_up)) @ w_down
    return x, new_state


def setup_inputs(seed: int = 0) -> dict:
    key = jax.random.key(seed)
    ks = list(jax.random.split(key, 32))

    def nrm(i, shape, scale):
        return jax.random.normal(ks[i], shape, F32) * scale

    lw = min(MAX_WINDOW, PAST_LEN)
    u = jax.random.uniform(ks[20], (DEPTH, N_SSM_HEADS), F32)
    dt0 = jnp.exp(u * (math.log(0.1) - math.log(1e-3)) + math.log(1e-3))
    return {
        'x_prompt': nrm(0, (BATCH, SEQ, D_MODEL), 1.0),
        'x_sample': nrm(1, (DEC_BATCH, DEC_SEQ, D_MODEL), 1.0),
        'cache_win_k': nrm(2, (DEPTH, DEC_BATCH, lw, N_ATT_HEADS, HEAD_DIM), 1.0),
        'cache_win_v': nrm(3, (DEPTH, DEC_BATCH, lw, N_ATT_HEADS, HEAD_DIM), 1.0),
        'state_conv': nrm(4, (DEPTH, DEC_BATCH, CONV_WIDTH - 1, CONV_CH), 1.0),
        'state_ssm': nrm(5, (DEPTH, DEC_BATCH, N_SSM_HEADS, SSM_HEAD_DIM, SSM_STATE), 0.5),
        'cache_mem_k': nrm(6, (DEPTH, DEC_BATCH, N_MEM, N_XATT_HEADS, XATT_HEAD_DIM), 1.0),
        'cache_mem_v': nrm(7, (DEPTH, DEC_BATCH, N_MEM, N_XATT_HEADS, XATT_HEAD_DIM), 1.0),
        'mem_prompt': nrm(8, (BATCH, N_MEM, D_MODEL), 1.0),
        'g_mix': 1.0 + nrm(9, (DEPTH, D_MODEL), 0.01),
        'w_in': nrm(10, (DEPTH, D_MODEL, IN_WIDTH), D_MODEL ** -0.5),
        'conv_w': nrm(11, (DEPTH, CONV_WIDTH, CONV_CH), CONV_WIDTH ** -0.5),
        'conv_b': nrm(12, (DEPTH, CONV_CH), 0.01),
        'dt_bias': dt0 + jnp.log(-jnp.expm1(-dt0)),
        'a_log': jnp.log(jax.random.uniform(ks[21], (DEPTH, N_SSM_HEADS), F32, 1.0, 16.0)),
        'd_skip': 1.0 + nrm(13, (DEPTH, N_SSM_HEADS), 0.01),
        'g_ssm': 1.0 + nrm(14, (DEPTH, SSM_WIDTH), 0.01),
        'w_out': nrm(15, (DEPTH, MIX_WIDTH, D_MODEL), MIX_WIDTH ** -0.5),
        'g_xatt': 1.0 + nrm(16, (DEPTH, D_MODEL), 0.01),
        'g_mem': 1.0 + nrm(17, (DEPTH, D_MODEL), 0.01),
        'w_xq': nrm(18, (DEPTH, D_MODEL, XATT_WIDTH), D_MODEL ** -0.5),
        'w_mk': nrm(19, (DEPTH, D_MODEL, XATT_WIDTH), D_MODEL ** -0.5),
        'w_mv': nrm(22, (DEPTH, D_MODEL, XATT_WIDTH), D_MODEL ** -0.5),
        'w_xo': nrm(23, (DEPTH, XATT_WIDTH, D_MODEL), XATT_WIDTH ** -0.5),
        'g_mlp': 1.0 + nrm(24, (DEPTH, D_MODEL), 0.01),
        'w_up': nrm(25, (DEPTH, D_MODEL, D_FF), D_MODEL ** -0.5),
        'w_down': nrm(26, (DEPTH, D_FF, D_MODEL), D_FF ** -0.5),
        'g_final': 1.0 + nrm(27, (D_MODEL,), 0.01),
    }


def reference(x_prompt, x_sample, cache_win_k, cache_win_v, state_conv, state_ssm,
              cache_mem_k, cache_mem_v, mem_prompt,
              g_mix, w_in, conv_w, conv_b, dt_bias, a_log, d_skip, g_ssm, w_out,
              g_xatt, g_mem, w_xq, w_mk, w_mv, w_xo, g_mlp, w_up, w_down, g_final):
    pos_p = jnp.arange(x_prompt.shape[1], dtype=jnp.int32)
    pos_s = PAST_LEN + jnp.arange(x_sample.shape[1], dtype=jnp.int32)
    hp, hs = x_prompt, x_sample
    wk_p, wv_p, cv_p, ss_p, mk_p, mv_p = [], [], [], [], [], []
    wk_s, wv_s, cv_s, ss_s = [], [], [], []
    for l in range(DEPTH):
        lw = (g_mix[l], w_in[l], conv_w[l], conv_b[l], dt_bias[l], a_log[l], d_skip[l],
              g_ssm[l], w_out[l], g_xatt[l], w_xq[l], w_xo[l], g_mlp[l], w_up[l], w_down[l])
        mk, mv = memory_kv(mem_prompt, g_mem[l], w_mk[l], w_mv[l])
        hp, (nk, nv, nc, ns) = trunk_layer(hp, pos_p, None, None, None, None, mk, mv, *lw)
        wk_p.append(nk)
        wv_p.append(nv)
        cv_p.append(nc)
        ss_p.append(ns)
        mk_p.append(mk)
        mv_p.append(mv)
        hs, (nk, nv, nc, ns) = trunk_layer(hs, pos_s, cache_win_k[l], cache_win_v[l],
                                           state_conv[l], state_ssm[l],
                                           cache_mem_k[l], cache_mem_v[l], *lw)
        wk_s.append(nk)
        wv_s.append(nv)
        cv_s.append(nc)
        ss_s.append(ns)
    y_prompt = rmsnorm(hp, g_final)
    y_sample = rmsnorm(hs, g_final)
    return (y_prompt, y_sample,
            jnp.stack(wk_p), jnp.stack(wv_p), jnp.stack(cv_p), jnp.stack(ss_p),
            jnp.stack(mk_p), jnp.stack(mv_p),
            jnp.stack(wk_s), jnp.stack(wv_s), jnp.stack(cv_s), jnp.stack(ss_s))
```

```cpp
#include <hip/hip_runtime.h>
#include <hip/hip_cooperative_groups.h>
#include <cstdio>
#include <cstdint>
namespace cg = cooperative_groups;
#define N_LAUNCHES 1
namespace pg8 {
#define PG8_LAS __attribute__((address_space(3)))
typedef unsigned short bf16_t;
typedef short bf16x8 __attribute__((ext_vector_type(8)));
typedef float f32x4 __attribute__((ext_vector_type(4)));
typedef unsigned u32x4 __attribute__((ext_vector_type(4)));
constexpr int BM = 256, BK = 64, HALF = 128, HTB = HALF * BK * 2  , STAGE_BYTES = 8 * HTB, NXCD = 8, WGM = 8;

__host__ __device__ __forceinline__ int lds_byte(int r, int c) { const int st = (r >> 4) * 2 + (c >> 5), rr = r & 15, cc = c & 31, ob = rr * 64 + cc * 2; return st * 1024 + (ob ^ (((ob >> 9) & 1) << 5)); }
__host__ __device__ __forceinline__ void stage_rc(int b, int& R, int& C) { const int st = b / 1024, sb = b % 1024, swz = sb ^ (((sb >> 9) & 1) << 5); R = (st >> 1) * 16 + swz / 64; C = (st & 1) * 32 + (swz % 64) / 2; }
__host__ __device__ __forceinline__ int perm32(int rho) { const int n = rho >> 4, i = rho & 15; return 8 * (i >> 2) + 4 * n + (i & 3); }

struct Unit { int pm, pn; };
struct Gemm { const bf16_t* A; const bf16_t* Bt; int M, N, K; };

struct StaticOrder {
    int nM, nN, nwg, G, c;
    __host__ __device__ void init(int M, int N, int G_, int c_) { nM = M / BM; nN = N / BM; nwg = nM * nN; G = G_; c = c_; }
    __host__ __device__ bool next(int i, Unit& u) const {
        const long L = (long)i * G + c; if (L >= nwg) return false;
        int wgid = (int)L; { const int q = nwg / NXCD, r = nwg % NXCD, xcd = wgid % NXCD, off = wgid / NXCD; wgid = (xcd < r ? xcd * (q + 1) : r * (q + 1) + (xcd - r) * q) + off; }
        const int nig = WGM * nN, gid = wgid / nig, fm = gid * WGM, gsz = (nM - fm) < WGM ? (nM - fm) : WGM;
        u.pm = fm + ((wgid % nig) % gsz); u.pn = (wgid % nig) / gsz; return true;
    }
    __device__ __forceinline__ void a_ready(const Unit&) const {}
    __device__ __forceinline__ void done(const Unit&) const {}
};
__device__ __forceinline__ unsigned cvt_pk_bf16(float lo, float hi) { unsigned r; asm volatile("v_cvt_pk_bf16_f32 %0, %1, %2" : "=v"(r) : "v"(lo), "v"(hi)); return r; }
template <class Epi, class Sched, bool ALIGN_EPI = false, bool SP2 = false>
__device__ __forceinline__ void gemm_phase(PG8_LAS unsigned char* lds, const Gemm g, const Sched& S, const Epi& E) {
    const int tid = threadIdx.x, wid = __builtin_amdgcn_readfirstlane(tid >> 6), lane = tid & 63, wr = wid >> 2, wc = wid & 3, fr = lane & 15, fq = lane >> 4;
    const int K = g.K, nt = K / BK;
    unsigned voffA[2], voffB[2];
#pragma unroll
    for (int i = 0; i < 2; ++i) { int R, C; stage_rc(tid * 16 + i * 8192, R, C); const int Rb = Epi::PERM ? ((R & ~31) + perm32(R & 31)) : R;
        voffA[i] = (unsigned)(R * K + C) * 2u; voffB[i] = (unsigned)(Rb * K + C) * 2u; }
    const size_t kstep = (size_t)(BK * 2);
    const size_t hstep = (size_t)HALF * K * 2;
    const size_t tstep = 2 * hstep;
    const unsigned ldsw = (unsigned)wid * 1024u;
    const int aoff = lds_byte(wr * 64 + fr, fq * 8), boff = lds_byte(wc * 32 + fr, fq * 8);
#define PG8_SA(b, h) (((b) * 2 + (h)) * HTB)
#define PG8_SB(b, h) ((4 + (b) * 2 + (h)) * HTB)
#define PG8_STAGE(bufoff, gbase, voff) do { _Pragma("unroll") for (int _i = 0; _i < 2; ++_i) \
        __builtin_amdgcn_global_load_lds((const unsigned*)((const char*)(gbase) + (voff)[_i]), (PG8_LAS unsigned*)(lds + (bufoff) + ldsw + _i * 8192), 16, 0, 0); } while (0)
#define PG8_LDA(dst, b, h) do { _Pragma("unroll") for (int m = 0; m < 4; ++m) _Pragma("unroll") for (int k = 0; k < 2; ++k) dst[m][k] = *(const PG8_LAS bf16x8*)(lds + PG8_SA(b, h) + aoff + m * 2048 + k * 1024); } while (0)
#define PG8_LDB(dst, b, h) do { _Pragma("unroll") for (int n = 0; n < 2; ++n) _Pragma("unroll") for (int k = 0; k < 2; ++k) dst[n][k] = *(const PG8_LAS bf16x8*)(lds + PG8_SB(b, h) + boff + n * 2048 + k * 1024); } while (0)
#define PG8_MMA(ai, bj, At, Bt) do { __builtin_amdgcn_s_setprio(1); _Pragma("unroll") for (int m = 0; m < 4; ++m) _Pragma("unroll") for (int n = 0; n < 2; ++n) _Pragma("unroll") for (int k = 0; k < 2; ++k) \
        acc[ai][bj][m][n] = __builtin_amdgcn_mfma_f32_16x16x32_bf16(Bt[n][k], At[m][k], acc[ai][bj][m][n], 0, 0, 0); __builtin_amdgcn_s_setprio(0); } while (0)
#define PG8_WAIT_V(n) asm volatile("s_waitcnt vmcnt(" #n ")" ::: "memory")
#define PG8_WAIT_L(n) asm volatile("s_waitcnt lgkmcnt(" #n ")" ::: "memory")
#define PG8_BAR __builtin_amdgcn_s_barrier()
#define PG8_SCHED __builtin_amdgcn_sched_barrier(0)
    Unit cur, nxt; int ui = 0;
    if (!S.next(0, cur)) return;
    f32x4 acc[2][2][4][2];
#pragma unroll
    for (int a = 0; a < 2; ++a)
#pragma unroll
        for (int b = 0; b < 2; ++b)
#pragma unroll
            for (int m = 0; m < 4; ++m)
#pragma unroll
                for (int n = 0; n < 2; ++n) acc[a][b][m][n] = (f32x4){0.f, 0.f, 0.f, 0.f};
    bf16x8 At[4][2], B0[2][2], B1[2][2];
    const char* cA = (const char*)g.A + (size_t)cur.pm * tstep; const char* cB = (const char*)g.Bt + (size_t)cur.pn * tstep;
    S.a_ready(cur);
    if constexpr (SP2) {
        PG8_STAGE(PG8_SB(0, 0), cB, voffB); PG8_STAGE(PG8_SB(0, 1), cB + hstep, voffB); PG8_STAGE(PG8_SA(0, 0), cA, voffA); PG8_STAGE(PG8_SA(0, 1), cA + hstep, voffA);
        if (wr == 1) PG8_BAR;
        PG8_WAIT_V(2); PG8_BAR;
        PG8_STAGE(PG8_SB(1, 0), cB + kstep, voffB); PG8_STAGE(PG8_SA(1, 0), cA + kstep, voffA); PG8_STAGE(PG8_SB(1, 1), cB + hstep + kstep, voffB);
        PG8_WAIT_V(6); PG8_BAR;
    } else {
        PG8_STAGE(PG8_SB(0, 0), cB, voffB); PG8_STAGE(PG8_SA(0, 0), cA, voffA); PG8_STAGE(PG8_SB(0, 1), cB + hstep, voffB); PG8_STAGE(PG8_SA(0, 1), cA + hstep, voffA);
        if (wr == 1) PG8_BAR;
        PG8_WAIT_V(4); PG8_BAR;
        PG8_STAGE(PG8_SB(1, 0), cB + kstep, voffB); PG8_STAGE(PG8_SA(1, 0), cA + kstep, voffA); PG8_STAGE(PG8_SB(1, 1), cB + hstep + kstep, voffB);
        PG8_WAIT_V(6); PG8_BAR;
    }
    for (;;) {
        const bool has_next = S.next(ui + 1, nxt);
        const char* nA = has_next ? (const char*)g.A + (size_t)nxt.pm * tstep : cA; const char* nB = has_next ? (const char*)g.Bt + (size_t)nxt.pn * tstep : cB;
        for (int t = 0; t < nt; t += 2) {
            const bool last = (t == nt - 2);
            const char* a1 = cA + (size_t)(t + 1) * kstep;
            const char* a2 = last ? nA : cA + (size_t)(t + 2) * kstep; const char* b2 = last ? nB : cB + (size_t)(t + 2) * kstep;
            const char* a3 = a2 + kstep; const char* b3 = b2 + kstep;
            if (last && has_next) S.a_ready(nxt);
            if constexpr (SP2) {
            PG8_LDB(B0, 0, 0); PG8_LDB(B1, 0, 1); PG8_SCHED; PG8_LDA(At, 0, 0); PG8_STAGE(PG8_SA(1, 1), a1 + hstep, voffA);
            PG8_WAIT_V(8); PG8_WAIT_L(0); PG8_BAR; PG8_MMA(0, 0, At, B0); PG8_MMA(0, 1, At, B1); PG8_BAR; PG8_SCHED;
            PG8_LDA(At, 0, 1); PG8_STAGE(PG8_SB(0, 0), b2, voffB); PG8_STAGE(PG8_SB(0, 1), b2 + hstep, voffB); PG8_STAGE(PG8_SA(0, 0), a2, voffA);
            PG8_WAIT_V(8); PG8_WAIT_L(0); PG8_BAR; PG8_MMA(1, 0, At, B0); PG8_MMA(1, 1, At, B1); PG8_BAR; PG8_SCHED;
            PG8_LDB(B0, 1, 0); PG8_LDB(B1, 1, 1); PG8_SCHED; PG8_LDA(At, 1, 0); PG8_STAGE(PG8_SA(0, 1), a2 + hstep, voffA);
            PG8_WAIT_V(8); PG8_WAIT_L(0); PG8_BAR; PG8_MMA(0, 0, At, B0); PG8_MMA(0, 1, At, B1); PG8_BAR; PG8_SCHED;
            PG8_LDA(At, 1, 1); PG8_STAGE(PG8_SB(1, 0), b3, voffB); PG8_STAGE(PG8_SB(1, 1), b3 + hstep, voffB); PG8_STAGE(PG8_SA(1, 0), a3, voffA);
            PG8_WAIT_V(8); PG8_WAIT_L(0); PG8_BAR; PG8_MMA(1, 0, At, B0); PG8_MMA(1, 1, At, B1); PG8_BAR; PG8_SCHED;
            } else {
            PG8_LDB(B0, 0, 0); PG8_SCHED; PG8_LDA(At, 0, 0); PG8_STAGE(PG8_SA(1, 1), a1 + hstep, voffA);
            PG8_WAIT_L(8); PG8_BAR; PG8_WAIT_L(0); PG8_MMA(0, 0, At, B0); PG8_BAR; PG8_SCHED;
            PG8_LDB(B1, 0, 1); PG8_STAGE(PG8_SB(0, 0), b2, voffB);
            PG8_BAR; PG8_WAIT_L(0); PG8_MMA(0, 1, At, B1); PG8_BAR;
            PG8_LDA(At, 0, 1); PG8_STAGE(PG8_SA(0, 0), a2, voffA);
            PG8_BAR; PG8_WAIT_L(0); PG8_MMA(1, 0, At, B0); PG8_BAR; PG8_SCHED;
            PG8_STAGE(PG8_SB(0, 1), b2 + hstep, voffB);
            PG8_WAIT_V(6); PG8_BAR; PG8_MMA(1, 1, At, B1); PG8_BAR;
            PG8_LDB(B0, 1, 0); PG8_SCHED; PG8_LDA(At, 1, 0); PG8_STAGE(PG8_SA(0, 1), a2 + hstep, voffA);
            PG8_WAIT_L(8); PG8_BAR; PG8_WAIT_L(0); PG8_MMA(0, 0, At, B0); PG8_BAR; PG8_SCHED;
            PG8_LDB(B1, 1, 1); PG8_STAGE(PG8_SB(1, 0), b3, voffB);
            PG8_BAR; PG8_WAIT_L(0); PG8_MMA(0, 1, At, B1); PG8_BAR;
            PG8_LDA(At, 1, 1); PG8_STAGE(PG8_SA(1, 0), a3, voffA);
            PG8_BAR; PG8_WAIT_L(0); PG8_MMA(1, 0, At, B0); PG8_BAR; PG8_SCHED;
            PG8_STAGE(PG8_SB(1, 1), b3 + hstep, voffB);
            PG8_WAIT_V(6); PG8_BAR; PG8_MMA(1, 1, At, B1); PG8_BAR;
            }
        }
        if constexpr (ALIGN_EPI) { if (wr == 0) PG8_BAR; }
        if constexpr (!Epi::AFTER_DRAIN) { E(acc, cur, wr, wc, fr, fq); S.done(cur); }
        if (!has_next) break;
#pragma unroll
        for (int a = 0; a < 2; ++a)
#pragma unroll
            for (int b = 0; b < 2; ++b)
#pragma unroll
                for (int m = 0; m < 4; ++m)
#pragma unroll
                    for (int n = 0; n < 2; ++n) acc[a][b][m][n] = (f32x4){0.f, 0.f, 0.f, 0.f};
        cur = nxt; cA = nA; cB = nB; ++ui;
        if constexpr (ALIGN_EPI) { if (wr == 1) PG8_BAR; }
    }
    PG8_WAIT_V(0);
    if constexpr (!ALIGN_EPI) { if (wr == 0) PG8_BAR; }
    PG8_BAR;
    if constexpr (Epi::AFTER_DRAIN) { E.fused(acc, cur, wr, wc, fr, fq, lds, wid, lane); S.done(cur); }
#undef PG8_SA
#undef PG8_SB
#undef PG8_STAGE
#undef PG8_LDA
#undef PG8_LDB
#undef PG8_MMA
#undef PG8_WAIT_V
#undef PG8_WAIT_L
#undef PG8_BAR
#undef PG8_SCHED
}
}

#define LAS __attribute__((address_space(3)))
typedef unsigned short bf16;
typedef unsigned v4u __attribute__((ext_vector_type(4)));
typedef unsigned v2u __attribute__((ext_vector_type(2)));
typedef float f32x4 __attribute__((ext_vector_type(4)));
typedef short bf16x8 __attribute__((ext_vector_type(8)));
#define LDS_WAIT() asm volatile("s_waitcnt lgkmcnt(0)" ::: "memory")
__device__ __forceinline__ unsigned pk2(float lo, float hi) { return pg8::cvt_pk_bf16(lo, hi); }
__device__ __forceinline__ bf16 f2bf(float f) { return (bf16)(pg8::cvt_pk_bf16(f, 0.f) & 0xffffu); }
__device__ __forceinline__ float bf2f(unsigned b) { return __uint_as_float((b & 0xffffu) << 16); }
__device__ __forceinline__ float bflo(unsigned w) { return __uint_as_float(w << 16); }
__device__ __forceinline__ float bfhi(unsigned w) { return __uint_as_float(w & 0xffff0000u); }
__device__ __forceinline__ float wave_sum(float v) {
#pragma unroll
    for (int o = 1; o < 64; o <<= 1) v += __shfl_xor(v, o);
    return v;
}
__device__ __forceinline__ float wave_max(float v) {
#pragma unroll
    for (int o = 1; o < 64; o <<= 1) v = fmaxf(v, __shfl_xor(v, o));
    return v;
}
__device__ __forceinline__ float sum16(float v) { v += __shfl_xor(v, 1); v += __shfl_xor(v, 2); v += __shfl_xor(v, 4); v += __shfl_xor(v, 8); return v; }
__device__ __forceinline__ float max16(float v) { v = fmaxf(v, __shfl_xor(v, 1)); v = fmaxf(v, __shfl_xor(v, 2)); v = fmaxf(v, __shfl_xor(v, 4)); v = fmaxf(v, __shfl_xor(v, 8)); return v; }
__device__ __forceinline__ float silu_f(float v) { return v / (1.f + __expf(-v)); }
__device__ __forceinline__ float softplus_f(float x) { return fmaxf(x, 0.f) + log1pf(__expf(-fabsf(x))); }
__device__ __forceinline__ f32x4 mfma16(bf16x8 a, bf16x8 b, f32x4 c) { return __builtin_amdgcn_mfma_f32_16x16x32_bf16(a, b, c, 0, 0, 0); }

#define XB_TMO      128
#define XB_XCNT(j)  (256  + 64 * (j))
#define XB_XSUB(j)  (1280 + 64 * (j))
#define XB_XGEN(j)  (2304 + 64 * (j))
#define XB_TOP      3328
#define XB_TOPGEN   3392
#define XCD_BAR_WORDS 3456
#define XB_SPIN_CAP (1u << 18)

__device__ __forceinline__ unsigned xb_ld(unsigned* p)              { return __hip_atomic_load(p, __ATOMIC_RELAXED, __HIP_MEMORY_SCOPE_AGENT); }
__device__ __forceinline__ unsigned xb_add(unsigned* p, unsigned v) { return __hip_atomic_fetch_add(p, v, __ATOMIC_RELAXED, __HIP_MEMORY_SCOPE_AGENT); }
__device__ __forceinline__ unsigned xb_xcc_id() { return (unsigned)__builtin_amdgcn_s_getreg((3 << 11) | 20) & 0xFu; }
#define XB_SPIN(cond, bar) do { unsigned _sp = 0; while (cond) { __builtin_amdgcn_s_sleep(1); \
    if ((++_sp & 255u) == 0u) { if (xb_ld(&(bar)[XB_TMO])) break; if (_sp > XB_SPIN_CAP) { atomicAdd(&(bar)[XB_TMO], 1u); break; } } } } while (0)

struct XcdBarrier {
    unsigned* bar; unsigned x;
    volatile LAS unsigned* st;
};

__device__ __forceinline__ XcdBarrier xcd_barrier_post(unsigned* bar, volatile LAS unsigned* st) {
    XcdBarrier b; b.bar = bar; b.x = xb_xcc_id(); b.st = st;
    if (threadIdx.x == 0) (void)xb_add(&bar[XB_XCNT(b.x)], 1u);
    return b;
}
__device__ __forceinline__ void xcd_barrier_complete(unsigned* bar, unsigned x, unsigned& nloc, unsigned& nx) {
    const unsigned G = gridDim.x * gridDim.y * gridDim.z;
    unsigned sum, cnt, mine, sp = 0u;
    for (;;) {
        sum = 0u; cnt = 0u; mine = 0u;
#pragma unroll
        for (unsigned j = 0; j < 16; ++j) { const unsigned c = xb_ld(&bar[XB_XCNT(j)]); sum += c; cnt += (c > 0u) ? 1u : 0u; mine = (j == x) ? c : mine; }
        if (sum == G) break;
        __builtin_amdgcn_s_sleep(1);
        if ((++sp & 255u) == 0u) { if (xb_ld(&bar[XB_TMO])) break; if (sp > XB_SPIN_CAP) { atomicAdd(&bar[XB_TMO], 1u); break; } }
    }
    nloc = mine > 0u ? mine : 1u; nx = cnt > 0u ? cnt : 1u;
}

__device__ __forceinline__ void xcd_barrier(const XcdBarrier& b) {
    asm volatile("s_waitcnt vmcnt(0)" ::: "memory");
    __syncthreads();
    if (threadIdx.x == 0) {
        unsigned* bar = b.bar;
        __builtin_amdgcn_s_waitcnt(0);
        unsigned nloc = b.st[0], nx = b.st[1];
        if (nloc == 0u) { xcd_barrier_complete(bar, b.x, nloc, nx); b.st[0] = nloc; b.st[1] = nx; }
        const unsigned old = xb_add(&bar[XB_XSUB(b.x)], 1u);
        const unsigned gen = old / nloc;
        if (old + 1u == (gen + 1u) * nloc) {
            __builtin_amdgcn_fence(__ATOMIC_RELEASE, "agent");
            asm volatile("s_waitcnt vmcnt(0)" ::: "memory");
            const unsigned og = xb_add(&bar[XB_TOP], 1u);
            const unsigned tg = og / nx;
            if (og + 1u == (tg + 1u) * nx) xb_add(&bar[XB_TOPGEN], 1u);
            else XB_SPIN(xb_ld(&bar[XB_TOPGEN]) == tg, bar);
            __builtin_amdgcn_fence(__ATOMIC_ACQUIRE, "agent");
            xb_add(&bar[XB_XGEN(b.x)], 1u);
            asm volatile("s_waitcnt vmcnt(0)" ::: "memory");
        } else {
            XB_SPIN(xb_ld(&bar[XB_XGEN(b.x)]) == gen, bar);
            __builtin_amdgcn_fence(__ATOMIC_ACQUIRE, "agent");
            asm volatile("s_waitcnt vmcnt(0)" ::: "memory");
        }
    }
    __syncthreads();
}

constexpr int DM = 1024, SEQ = 8192, NBAT = 2, MP = NBAT * SEQ, SB = 32, ST = 4, MS = SB * ST, MT = MP + MS;
constexpr int NIN = 3072, INW = 3080, DFF = 4096, NMEM = 256, LW = 2048;
constexpr float EPS = 1e-6f;
constexpr int NWAVES = 8, NTHR = 512;
constexpr int LDS_BYTES = 147456;

constexpr size_t O_YP = 0, O_YS = O_YP + (size_t)MP * DM, O_WKP = O_YS + (size_t)MS * DM, O_WVP = O_WKP + (size_t)NBAT * LW * 512,
    O_CVP = O_WVP + (size_t)NBAT * LW * 512, O_SSP = O_CVP + (size_t)NBAT * 3 * 1024, O_MKP = O_SSP + (size_t)NBAT * 8 * 64 * 128,
    O_MVP = O_MKP + (size_t)NBAT * NMEM * 1024, O_WKS = O_MVP + (size_t)NBAT * NMEM * 1024, O_WVS = O_WKS + (size_t)SB * LW * 512,
    O_CVS = O_WVS + (size_t)SB * LW * 512, O_SSS = O_CVS + (size_t)SB * 3 * 1024, O_END = O_SSS + (size_t)SB * 8 * 64 * 128;

constexpr size_t MiB = 1u << 20;
constexpr size_t WS_WIN = 1 * MiB, WS_WOUT = 7 * MiB, WS_WXQ = 9 * MiB, WS_WMKV = 11 * MiB, WS_WXO = 15 * MiB, WS_WUP = 17 * MiB, WS_WDN = 25 * MiB;
constexpr size_t WS_COS = 33 * MiB, WS_SIN = 35 * MiB, WS_AM = 37 * MiB, WS_DT = 38 * MiB, WS_MKB = 39 * MiB, WS_MVB = 40 * MiB;
constexpr size_t WS_SSQ1 = 41 * MiB, WS_SSQ2 = 43 * MiB + 256 * 1024, WS_SSQ3 = 45 * MiB + 512 * 1024;
constexpr size_t WS_A0 = 48 * MiB;
constexpr size_t WS_MIX = 81 * MiB;
constexpr size_t WS_X = 114 * MiB;
constexpr size_t WS_XB = 179 * MiB;
constexpr size_t WS_QB = 212 * MiB, WS_KB = 229 * MiB, WS_VB = 246 * MiB, WS_ZB = 263 * MiB;
constexpr size_t WS_XBC = 280 * MiB;
constexpr size_t WS_OBR = 313 * MiB;
constexpr size_t WS_LSE = 361 * MiB;
constexpr size_t WS_STATE = 363 * MiB;
constexpr size_t WS_HST = 395 * MiB;
constexpr size_t WS_DEC = 411 * MiB;
constexpr size_t WS_SMISC = 412 * MiB;
constexpr size_t WS_XC = 413 * MiB;
constexpr size_t WS_U = 212 * MiB;
constexpr size_t WS_END = 446 * MiB;

struct Args { const float* in[28]; float* out; unsigned char* ws; int ph_lo, ph_hi; };

template <class F> struct EpiWrap {
    static constexpr bool PERM = true, AFTER_DRAIN = false;
    F f;
    __device__ __forceinline__ void operator()(const pg8::f32x4 (&acc)[2][2][4][2], const pg8::Unit& u, int wr, int wc, int fr, int fq) const {
#pragma unroll
        for (int ai = 0; ai < 2; ++ai) {
            float rs[4]; typename F::Pre pre[4][2];
#pragma unroll
            for (int m = 0; m < 4; ++m) {
                const int row = u.pm * 256 + ai * 128 + wr * 64 + m * 16 + fr;
                rs[m] = f.rowscale(row);
#pragma unroll
                for (int bj = 0; bj < 2; ++bj) pre[m][bj] = f.pre(row, u.pn * 256 + bj * 128 + wc * 32 + 8 * fq);
            }
#pragma unroll
            for (int m = 0; m < 4; ++m) {
                const int row = u.pm * 256 + ai * 128 + wr * 64 + m * 16 + fr;
#pragma unroll
                for (int bj = 0; bj < 2; ++bj) f.apply(row, u.pn * 256 + bj * 128 + wc * 32 + 8 * fq, acc[ai][bj][m][0], acc[ai][bj][m][1], rs[m], pre[m][bj]);
            }
        }
    }
};
struct NoPre {};

template <int RB, class F> __device__ __forceinline__ void small_gemm_unit(LAS unsigned char* lds, const bf16* A, int rowg0, const bf16* Bt, int K, int col0, const F& f, int wave, int lane) {
    const int fr = lane & 15, fq = lane >> 4;
    const int kw = K >> 3;
    const bf16* ap = A + (size_t)fr * K + wave * kw + 8 * fq;
    const bf16* bp0 = Bt + (size_t)(col0 + pg8::perm32(fr)) * K + wave * kw + 8 * fq;
    const bf16* bp1 = Bt + (size_t)(col0 + pg8::perm32(16 + fr)) * K + wave * kw + 8 * fq;
    f32x4 acc[RB][2];
#pragma unroll
    for (int rb = 0; rb < RB; ++rb) { acc[rb][0] = (f32x4){0.f, 0.f, 0.f, 0.f}; acc[rb][1] = (f32x4){0.f, 0.f, 0.f, 0.f}; }
#pragma unroll(RB == 1 ? 8 : 2)
    for (int k0 = 0; k0 < kw; k0 += 32) {
        const bf16x8 b0 = *(const bf16x8*)(bp0 + k0), b1 = *(const bf16x8*)(bp1 + k0);
        bf16x8 a[RB];
#pragma unroll
        for (int rb = 0; rb < RB; ++rb) a[rb] = *(const bf16x8*)(ap + (size_t)rb * 16 * K + k0);
#pragma unroll
        for (int rb = 0; rb < RB; ++rb) { acc[rb][0] = mfma16(b0, a[rb], acc[rb][0]); acc[rb][1] = mfma16(b1, a[rb], acc[rb][1]); }
    }
#pragma unroll
    for (int rb = 0; rb < RB; ++rb) {
        *(LAS f32x4*)(lds + ((wave * RB + rb) * 2 + 0) * 1024 + lane * 16) = acc[rb][0];
        *(LAS f32x4*)(lds + ((wave * RB + rb) * 2 + 1) * 1024 + lane * 16) = acc[rb][1];
    }
    __syncthreads();
    if (wave < RB) {
        f32x4 c0 = {0.f, 0.f, 0.f, 0.f}, c1 = {0.f, 0.f, 0.f, 0.f};
#pragma unroll
        for (int w2 = 0; w2 < 8; ++w2) {
            c0 = c0 + *(const LAS f32x4*)(lds + ((w2 * RB + wave) * 2 + 0) * 1024 + lane * 16);
            c1 = c1 + *(const LAS f32x4*)(lds + ((w2 * RB + wave) * 2 + 1) * 1024 + lane * 16);
        }
        const int row = rowg0 + wave * 16 + fr;
        const float rs = f.rowscale(row);
        const typename F::Pre pre = f.pre(row, col0 + 8 * fq);
        f.apply(row, col0 + 8 * fq, c0, c1, rs, pre);
    }
    __syncthreads();
}

__device__ __forceinline__ v4u pack8(f32x4 v0, f32x4 v1) { v4u w; w.x = pk2(v0[0], v0[1]); w.y = pk2(v0[2], v0[3]); w.z = pk2(v1[0], v1[1]); w.w = pk2(v1[2], v1[3]); return w; }

struct F1 {
    bf16 *Qb, *Kb, *Vb, *Zb, *XBCb; float* out; float *SQ, *SXBC; const float *cosT, *sinT;
    typedef NoPre Pre;
    __device__ __forceinline__ float rowscale(int) const { return 1.f; }
    __device__ __forceinline__ Pre pre(int, int) const { return Pre{}; }
    __device__ __forceinline__ void apply(int row, int col, f32x4 v0, f32x4 v1, float, const Pre&) const {
        const bool samp = row >= MP;
        int b, t, pos;
        if (!samp) { b = row >> 13; t = row & 8191; pos = t; } else { b = (row - MP) >> 2; t = (row - MP) & 3; pos = SEQ + t; }
        if (col < 1024) {
            const int isk = col >> 9, c = col & 511, hd = c >> 6, i0 = (c & 63) >> 1;
            const f32x4 cs = *(const f32x4*)(cosT + pos * 32 + i0), sn = *(const f32x4*)(sinT + pos * 32 + i0);
            const f32x4 t1 = {v0[0], v0[2], v1[0], v1[2]}, t2 = {v0[1], v0[3], v1[1], v1[3]};
            const f32x4 a = t1 * cs - t2 * sn, bb = t2 * cs + t1 * sn;
            v4u w; w.x = pk2(a[0], bb[0]); w.y = pk2(a[1], bb[1]); w.z = pk2(a[2], bb[2]); w.w = pk2(a[3], bb[3]);
            *(v4u*)((isk ? Kb : Qb) + (size_t)row * 512 + c) = w;
            float* o = nullptr;
            if (isk) {
                if (!samp) { if (t >= SEQ - LW) o = out + O_WKP + ((size_t)(b * LW + t - (SEQ - LW)) * 512 + hd * 64); }
                else o = out + O_WKS + ((size_t)(b * LW + LW - ST + t) * 512 + hd * 64);
            } else if (samp) o = SQ + (size_t)(row - MP) * 512 + hd * 64;
            if (o) { *(f32x4*)(o + i0) = a; *(f32x4*)(o + 32 + i0) = bb; }
        } else if (col < 1536) {
            const int c = col - 1024;
            *(v4u*)(Vb + (size_t)row * 512 + c) = pack8(v0, v1);
            float* o = nullptr;
            if (!samp) { if (t >= SEQ - LW) o = out + O_WVP + ((size_t)(b * LW + t - (SEQ - LW)) * 512 + c); }
            else o = out + O_WVS + ((size_t)(b * LW + LW - ST + t) * 512 + c);
            if (o) { *(f32x4*)o = v0; *(f32x4*)(o + 4) = v1; }
        } else if (col < 2048) {
            *(v4u*)(Zb + (size_t)row * 512 + (col - 1536)) = pack8(v0, v1);
        } else {
            const int c = col - 2048;
            *(v4u*)(XBCb + (size_t)row * 1024 + c) = pack8(v0, v1);
            if (!samp) { if (t >= SEQ - 3) { float* o = out + O_CVP + (size_t)(b * 3 + t - (SEQ - 3)) * 1024 + c; *(f32x4*)o = v0; *(f32x4*)(o + 4) = v1; } }
            else {
                float* o = SXBC + (size_t)(row - MP) * 1024 + c; *(f32x4*)o = v0; *(f32x4*)(o + 4) = v1;
                if (t >= 1) { float* o2 = out + O_CVS + (size_t)(b * 3 + t - 1) * 1024 + c; *(f32x4*)o2 = v0; *(f32x4*)(o2 + 4) = v1; }
            }
        }
    }
};
struct FMem {
    float* out; bf16 *MKb, *MVb;
    typedef NoPre Pre;
    __device__ __forceinline__ float rowscale(int) const { return 1.f; }
    __device__ __forceinline__ Pre pre(int, int) const { return Pre{}; }
    __device__ __forceinline__ void apply(int row, int col, f32x4 v0, f32x4 v1, float, const Pre&) const {
        const int isv = col >> 10, c = col & 1023;
        float* o = out + (isv ? O_MVP : O_MKP) + (size_t)row * 1024 + c; *(f32x4*)o = v0; *(f32x4*)(o + 4) = v1;
        *(v4u*)((isv ? MVb : MKb) + (size_t)row * 1024 + c) = pack8(v0, v1);
    }
};
template <int MODE  > struct FRes {
    const float *xp, *xs; float* out; bf16* Xb; float* ssq;
    struct Pre { f32x4 r0, r1; };
    __device__ __forceinline__ float rowscale(int) const { return 1.f; }
    __device__ __forceinline__ Pre pre(int row, int col) const {
        Pre p;
        if (MODE == 0) { const float* r = (row < MP) ? xp + (size_t)row * DM : xs + (size_t)(row - MP) * DM; p.r0 = *(const f32x4*)(r + col); p.r1 = *(const f32x4*)(r + col + 4); }
        else { const v4u w = *(const v4u*)(Xb + (size_t)row * DM + col); p.r0 = (f32x4){bflo(w.x), bfhi(w.x), bflo(w.y), bfhi(w.y)}; p.r1 = (f32x4){bflo(w.z), bfhi(w.z), bflo(w.w), bfhi(w.w)}; }
        return p;
    }
    __device__ __forceinline__ void apply(int row, int col, f32x4 v0, f32x4 v1, float, const Pre& pr) const {
        v0 = v0 + pr.r0; v1 = v1 + pr.r1;
        if (MODE == 2) { float* d = (row < MP) ? out + O_YP + (size_t)row * DM : out + O_YS + (size_t)(row - MP) * DM; *(f32x4*)(d + col) = v0; *(f32x4*)(d + col + 4) = v1; }
        else *(v4u*)(Xb + (size_t)row * DM + col) = pack8(v0, v1);
        float s = (v0[0] * v0[0] + v0[1] * v0[1]) + (v0[2] * v0[2] + v0[3] * v0[3]) + (v1[0] * v1[0] + v1[1] * v1[1]) + (v1[2] * v1[2] + v1[3] * v1[3]);
        s += __shfl_xor(s, 16); s += __shfl_xor(s, 32);
        if ((threadIdx.x & 48) == 0) ssq[(size_t)row * 32 + (col >> 5)] = s;
    }
};
__device__ __forceinline__ float rstd_from(const float* ssq, int row) {
    const f32x4* p = (const f32x4*)(ssq + (size_t)row * 32 + 8 * ((threadIdx.x >> 4) & 3));
    const f32x4 a = p[0] + p[1];
    float t = (a[0] + a[1]) + (a[2] + a[3]);
    t += __shfl_xor(t, 16); t += __shfl_xor(t, 32);
    return rsqrtf(t * (1.f / DM) + EPS);
}
template <int ACT  > struct FScale {
    const float* ssq; bf16* O; int ldo; float mul;
    typedef NoPre Pre;
    __device__ __forceinline__ float rowscale(int row) const { return rstd_from(ssq, row) * mul; }
    __device__ __forceinline__ Pre pre(int, int) const { return Pre{}; }
    __device__ __forceinline__ void apply(int row, int col, f32x4 v0, f32x4 v1, float rs, const Pre&) const {
        v0 = v0 * rs; v1 = v1 * rs;
        if (ACT == 1) {
#pragma unroll
            for (int i = 0; i < 4; ++i) { const float a = fmaxf(v0[i], 0.f), b = fmaxf(v1[i], 0.f); v0[i] = a * a; v1[i] = b * b; }
        }
        *(v4u*)(O + (size_t)row * ldo + col) = pack8(v0, v1);
    }
};

__device__ __forceinline__ void tr_item(const float* W, int ldw, int K, const float* g, bf16* WT, int row_off, bool permqk, LAS float* scr, int item, int nblk, int lane) {
    const int kb = item / nblk, nb = item % nblk, k0 = 64 * kb, n0 = 32 * nb;
    float wv[32];
#pragma unroll
    for (int i = 0; i < 32; ++i) { const int kk = 2 * i + (lane >> 5); wv[i] = W[(size_t)(k0 + kk) * ldw + n0 + (lane & 31)]; }
#pragma unroll
    for (int i = 0; i < 32; ++i) { const int kk = 2 * i + (lane >> 5); const float gv = g ? g[k0 + kk] : 1.f; scr[kk * 33 + (lane & 31)] = wv[i] * gv; }
    LDS_WAIT();
    const int c = lane & 7;
#pragma unroll
    for (int j = 0; j < 4; ++j) {
        const int n = (lane >> 3) + 8 * j; const LAS float* s = scr + (8 * c) * 33 + n;
        v4u o; o.x = pk2(s[0 * 33], s[1 * 33]); o.y = pk2(s[2 * 33], s[3 * 33]); o.z = pk2(s[4 * 33], s[5 * 33]); o.w = pk2(s[6 * 33], s[7 * 33]);
        const int nsrc = n0 + n; int ndst = nsrc;
        if (permqk && nsrc < 1024) { const int d = nsrc & 63; ndst = (nsrc & ~63) + (d < 32 ? 2 * d : 2 * (d - 32) + 1); }
        *(v4u*)(WT + (size_t)(row_off + ndst) * K + k0 + 8 * c) = o;
    }
    LDS_WAIT();
}

__device__ __forceinline__ void p0_prologue(const Args& A, LAS unsigned char* lds, int tid, int wave, int lane) {
    unsigned char* ws = A.ws;
    const int G = gridDim.x, gw = blockIdx.x * NWAVES + wave, NGW = G * NWAVES;
    const int gt = blockIdx.x * NTHR + tid, NGT = G * NTHR;
    {
        LAS float* scr = (LAS float*)(lds + wave * 16384);
        constexpr int I_IN = 16 * 96, I_SQ = 16 * 32, I_UP = 16 * 128, I_DN = 64 * 32;
        constexpr int NIT = I_IN + 5 * I_SQ + I_UP + I_DN;
        for (int it = gw; it < NIT; it += NGW) {
            int r = it;
            if (r < I_IN) { tr_item(A.in[10], INW, DM, A.in[9], (bf16*)(ws + WS_WIN), 0, true, scr, r, 96, lane); continue; } r -= I_IN;
            if (r < I_SQ) { tr_item(A.in[17], DM, DM, nullptr, (bf16*)(ws + WS_WOUT), 0, false, scr, r, 32, lane); continue; } r -= I_SQ;
            if (r < I_SQ) { tr_item(A.in[20], DM, DM, A.in[18], (bf16*)(ws + WS_WXQ), 0, false, scr, r, 32, lane); continue; } r -= I_SQ;
            if (r < I_SQ) { tr_item(A.in[21], DM, DM, nullptr, (bf16*)(ws + WS_WMKV), 0, false, scr, r, 32, lane); continue; } r -= I_SQ;
            if (r < I_SQ) { tr_item(A.in[22], DM, DM, nullptr, (bf16*)(ws + WS_WMKV), 1024, false, scr, r, 32, lane); continue; } r -= I_SQ;
            if (r < I_SQ) { tr_item(A.in[23], DM, DM, nullptr, (bf16*)(ws + WS_WXO), 0, false, scr, r, 32, lane); continue; } r -= I_SQ;
            if (r < I_UP) { tr_item(A.in[25], DFF, DM, A.in[24], (bf16*)(ws + WS_WUP), 0, false, scr, r, 128, lane); continue; } r -= I_UP;
            tr_item(A.in[26], DM, DFF, nullptr, (bf16*)(ws + WS_WDN), 0, false, scr, r, 32, lane);
        }
    }
    __syncthreads();
    LAS float* wdt = (LAS float*)lds;
    for (int i = tid; i < DM * 8; i += NTHR) { const int k = i >> 3, j = i & 7; wdt[i] = A.in[10][(size_t)k * INW + NIN + j] * A.in[9][k]; }
    __syncthreads();
    {
        bf16* A0 = (bf16*)(ws + WS_A0); float* dtr = (float*)(ws + WS_DT);
        f32x4 nv[4];
        if (gw < MT) {
            const float* xr = (gw < MP) ? A.in[0] + (size_t)gw * DM : A.in[1] + (size_t)(gw - MP) * DM;
#pragma unroll
            for (int j = 0; j < 4; ++j) nv[j] = *(const f32x4*)(xr + 4 * lane + 256 * j);
        }
        for (int row = gw; row < MT; row += NGW) {
            f32x4 v[4]; float s = 0.f;
#pragma unroll
            for (int j = 0; j < 4; ++j) { v[j] = nv[j]; s += (v[j][0] * v[j][0] + v[j][1] * v[j][1]) + (v[j][2] * v[j][2] + v[j][3] * v[j][3]); }
            if (row + NGW < MT) {
                const int rn = row + NGW;
                const float* xr = (rn < MP) ? A.in[0] + (size_t)rn * DM : A.in[1] + (size_t)(rn - MP) * DM;
#pragma unroll
                for (int j = 0; j < 4; ++j) nv[j] = *(const f32x4*)(xr + 4 * lane + 256 * j);
            }
            const float rstd = rsqrtf(wave_sum(s) * (1.f / DM) + EPS);
            float d[8] = {0.f, 0.f, 0.f, 0.f, 0.f, 0.f, 0.f, 0.f};
#pragma unroll
            for (int j = 0; j < 4; ++j) {
                v[j] = v[j] * rstd;
                v2u o; o.x = pk2(v[j][0], v[j][1]); o.y = pk2(v[j][2], v[j][3]);
                *(v2u*)(A0 + (size_t)row * DM + 4 * lane + 256 * j) = o;
#pragma unroll
                for (int e = 0; e < 4; ++e) {
                    const LAS f32x4* wp = (const LAS f32x4*)(wdt + (4 * lane + 256 * j + e) * 8);
                    const f32x4 w0 = wp[0], w1 = wp[1];
                    d[0] += v[j][e] * w0[0]; d[1] += v[j][e] * w0[1]; d[2] += v[j][e] * w0[2]; d[3] += v[j][e] * w0[3];
                    d[4] += v[j][e] * w1[0]; d[5] += v[j][e] * w1[1]; d[6] += v[j][e] * w1[2]; d[7] += v[j][e] * w1[3];
                }
            }
#pragma unroll
            for (int e = 0; e < 8; ++e) d[e] = wave_sum(d[e]);
            if (lane == 0) { *(f32x4*)(dtr + (size_t)row * 8) = (f32x4){d[0], d[1], d[2], d[3]}; *(f32x4*)(dtr + (size_t)row * 8 + 4) = (f32x4){d[4], d[5], d[6], d[7]}; }
        }
        bf16* Am = (bf16*)(ws + WS_AM);
        for (int row = gw; row < NBAT * NMEM; row += NGW) {
            const float* xr = A.in[8] + (size_t)row * DM;
            f32x4 v[4]; float s = 0.f;
#pragma unroll
            for (int j = 0; j < 4; ++j) { v[j] = *(const f32x4*)(xr + 4 * lane + 256 * j); s += (v[j][0] * v[j][0] + v[j][1] * v[j][1]) + (v[j][2] * v[j][2] + v[j][3] * v[j][3]); }
            const float rstd = rsqrtf(wave_sum(s) * (1.f / DM) + EPS);
#pragma unroll
            for (int j = 0; j < 4; ++j) {
                const f32x4 gg = *(const f32x4*)(A.in[19] + 4 * lane + 256 * j);
                v[j] = v[j] * rstd * gg;
                v2u o; o.x = pk2(v[j][0], v[j][1]); o.y = pk2(v[j][2], v[j][3]);
                *(v2u*)(Am + (size_t)row * DM + 4 * lane + 256 * j) = o;
            }
        }
    }
    {
        float* cosT = (float*)(ws + WS_COS); float* sinT = (float*)(ws + WS_SIN);
        for (int i = gt; i < (SEQ + ST) * 32; i += NGT) {
            const int pos = i >> 5, k = i & 31;
            const double inv = exp2(-(double)k * (13.287712379549449 / 32.0));
            const double rev = (double)pos * inv * 0.15915494309189535;
            const double fr = rev - floor(rev);
            const float f = (float)fr;
            cosT[i] = __builtin_amdgcn_cosf(f); sinT[i] = __builtin_amdgcn_sinf(f);
        }
    }
}

constexpr int KS_OFF = 0, KSTR = 72;
constexpr int VS_OFF = 36864;
constexpr int PS_OFF = 73728, PSTR = 264;
typedef short v4i16_t __attribute__((ext_vector_type(4)));

__device__ __forceinline__ bf16x8 tr_frag(const LAS unsigned char* tile, int row0, int col0, int strideel, int lane) {
    const int g = lane >> 4, i = lane & 15, q = i >> 2, p = i & 3;
    const LAS unsigned char* a = tile + ((row0 + 8 * g + q) * strideel + col0 + 4 * p) * 2;
    const v4i16_t lo = __builtin_amdgcn_ds_read_tr16_b64_v4i16((LAS v4i16_t*)a);
    const v4i16_t hi = __builtin_amdgcn_ds_read_tr16_b64_v4i16((LAS v4i16_t*)(a + 4 * strideel * 2));
    bf16x8 r; r[0] = lo[0]; r[1] = lo[1]; r[2] = lo[2]; r[3] = lo[3]; r[4] = hi[0]; r[5] = hi[1]; r[6] = hi[2]; r[7] = hi[3];
    return r;
}

constexpr int CP_PER = (LW - ST) * 128, CP_FULL = LW * 128, CP_CHUNKS = SB * CP_PER / 4096;
constexpr int CP_P7 = 512, CP_P3 = CP_CHUNKS - CP_P7;
static_assert(SB * CP_PER % 4096 == 0 && CP_P3 > 0 && 2 * CP_P3 <= 3072, "copy chunks: the dilated-attention units carry half chunks (2048 float4 per tensor)");
template <int NV> __device__ __forceinline__ void cp_load(const Args& A, int base, f32x4 (&ck)[NV], f32x4 (&cv)[NV], int tid) {
    const f32x4* srck = (const f32x4*)A.in[2]; const f32x4* srcv = (const f32x4*)A.in[3];
#pragma unroll
    for (int k = 0; k < NV; ++k) {
        const int i = base + k * NTHR + tid, sb = i / CP_PER, r = i - sb * CP_PER;
        const size_t so = (size_t)sb * CP_FULL + ST * 128 + r;
        ck[k] = __builtin_nontemporal_load(srck + so); cv[k] = __builtin_nontemporal_load(srcv + so);
    }
}
template <int NV> __device__ __forceinline__ void cp_store(const Args& A, int base, const f32x4 (&ck)[NV], const f32x4 (&cv)[NV], int tid) {
    f32x4* dstk = (f32x4*)(A.out + O_WKS); f32x4* dstv = (f32x4*)(A.out + O_WVS);
#pragma unroll
    for (int k = 0; k < NV; ++k) {
        const int i = base + k * NTHR + tid, sb = i / CP_PER, r = i - sb * CP_PER;
        const size_t dof = (size_t)sb * CP_FULL + r;
        __builtin_nontemporal_store(ck[k], dstk + dof); __builtin_nontemporal_store(cv[k], dstv + dof);
    }
}
struct DilUnit { const bf16 *Q, *K, *V; bf16* O; float* L; ptrdiff_t stride, lstride; bool has_prev; };
__device__ __forceinline__ DilUnit dil_unit(unsigned char* ws, int u) {
    const int br = u >> 10, rem = u & 1023, b = rem >> 9, h = (rem >> 6) & 7, sj = rem & 63;
    const int dil = br == 0 ? 1 : (br == 1 ? 4 : 16);
    const int r = sj % dil, j = sj / dil;
    const ptrdiff_t qrow = (ptrdiff_t)b * SEQ + (ptrdiff_t)j * 128 * dil + r, krow = qrow - (ptrdiff_t)128 * dil;
    DilUnit d;
    d.Q = (const bf16*)(ws + WS_QB) + qrow * 512 + h * 64; d.K = (const bf16*)(ws + WS_KB) + krow * 512 + h * 64; d.V = (const bf16*)(ws + WS_VB) + krow * 512 + h * 64;
    d.O = (bf16*)(ws + WS_OBR) + (size_t)br * MP * 512 + qrow * 512 + h * 64; d.L = (float*)(ws + WS_LSE) + (size_t)br * MP * 8 + qrow * 8 + h;
    d.stride = (ptrdiff_t)dil * 512; d.lstride = (ptrdiff_t)dil * 8; d.has_prev = j > 0;
    return d;
}
__device__ __forceinline__ void dil_load(const DilUnit& d, v4u (&kr)[4], v4u (&vr)[4], bf16x8& q0, bf16x8& q1, int tid, int wave, int lane) {
#pragma unroll
    for (int i = 0; i < 4; ++i) {
        const int idx = tid + NTHR * i, c = idx >> 3, ch = idx & 7;
        kr[i] = (v4u){0u, 0u, 0u, 0u}; vr[i] = (v4u){0u, 0u, 0u, 0u};
        if (d.has_prev || c >= 128) { kr[i] = *(const v4u*)(d.K + (ptrdiff_t)c * d.stride + ch * 8); vr[i] = *(const v4u*)(d.V + (ptrdiff_t)c * d.stride + ch * 8); }
    }
    const bf16* qrow = d.Q + (ptrdiff_t)(wave * 16 + (lane & 15)) * d.stride + 8 * (lane >> 4);
    q0 = *(const bf16x8*)qrow; q1 = *(const bf16x8*)(qrow + 32);
}

__device__ __forceinline__ void dil_attn_phase(const Args& A, LAS unsigned char* lds, int tid, int wave, int lane) {
    const int G = gridDim.x;
    int u = blockIdx.x;
    if (u >= 3072) return;
    const int fr = lane & 15, fq = lane >> 4;
    v4u kr[4], vr[4]; bf16x8 qn0, qn1;
    { const DilUnit fu = dil_unit(A.ws, u); dil_load(fu, kr, vr, qn0, qn1, tid, wave, lane); }
    LAS bf16* Pw = (LAS bf16*)(lds + PS_OFF + wave * 8448);
    f32x4 ck[4], cv[4]; int pend = -1;
    for (;;) {
        const DilUnit cu = dil_unit(A.ws, u);
#pragma unroll
        for (int i = 0; i < 4; ++i) {
            const int idx = tid + NTHR * i, c = idx >> 3, ch = idx & 7;
            *(LAS v4u*)(lds + KS_OFF + (c * KSTR + ch * 8) * 2) = kr[i];
            *(LAS v4u*)(lds + VS_OFF + (c * KSTR + ch * 8) * 2) = vr[i];
        }
        const bf16x8 q0 = qn0, q1 = qn1;
        __syncthreads();
        const int un = u + G; const bool more = un < 3072;
        if (more) { const DilUnit nu = dil_unit(A.ws, un); dil_load(nu, kr, vr, qn0, qn1, tid, wave, lane); }
        if (pend >= 0) cp_store<4>(A, pend * 2048, ck, cv, tid);
        pend = -1;
        if (u < 2 * CP_P3) { cp_load<4>(A, u * 2048, ck, cv, tid); pend = u; }
        f32x4 s[9];
#pragma unroll
        for (int i = 0; i < 9; ++i) {
            const LAS unsigned char* kp = lds + KS_OFF + (((wave + i) * 16 + fr) * KSTR + 8 * fq) * 2;
            const bf16x8 k0 = *(const LAS bf16x8*)kp, k1 = *(const LAS bf16x8*)(kp + 64);
            s[i] = mfma16(k0, q0, (f32x4){0.f, 0.f, 0.f, 0.f}); s[i] = mfma16(k1, q1, s[i]);
        }
        float inv_own;
        {
            const int nbz = (wave & 1) ? wave - 1 : wave + 9;
            const int a = wave * 16 + fr;
            float m = -INFINITY;
#pragma unroll
            for (int i = 0; i < 9; ++i)
#pragma unroll
                for (int j = 0; j < 4; ++j) {
                    const int c = (wave + i) * 16 + 4 * fq + j;
                    const bool ok = (c >= a) && (c <= a + 128) && (cu.has_prev || c >= 128);
                    const float v = ok ? s[i][j] * 0.125f : -INFINITY;
                    s[i][j] = v; m = fmaxf(m, v);
                }
            m = fmaxf(m, __shfl_xor(m, 16)); m = fmaxf(m, __shfl_xor(m, 32));
            float sum = 0.f;
#pragma unroll
            for (int i = 0; i < 9; ++i) {
                const float p0 = __expf(s[i][0] - m), p1 = __expf(s[i][1] - m), p2 = __expf(s[i][2] - m), p3 = __expf(s[i][3] - m);
                sum += (p0 + p1) + (p2 + p3);
                v2u w; w.x = pk2(p0, p1); w.y = pk2(p2, p3);
                *(LAS v2u*)(Pw + fr * PSTR + (wave + i) * 16 + 4 * fq) = w;
            }
            *(LAS v2u*)(Pw + fr * PSTR + nbz * 16 + 4 * fq) = (v2u){0u, 0u};
            sum += __shfl_xor(sum, 16); sum += __shfl_xor(sum, 32);
            inv_own = 1.f / sum;
            if (fq == 0) cu.L[(ptrdiff_t)a * cu.lstride] = m + __logf(sum);
        }
        asm volatile("" ::: "memory");
        f32x4 o[4];
#pragma unroll
        for (int db = 0; db < 4; ++db) o[db] = (f32x4){0.f, 0.f, 0.f, 0.f};
#pragma unroll
        for (int kk = 0; kk < 5; ++kk) {
            const int ks = (wave >> 1) + kk;
            const bf16x8 pa = *(const LAS bf16x8*)(Pw + fr * PSTR + ks * 32 + 8 * fq);
#pragma unroll
            for (int db = 0; db < 4; ++db) o[db] = mfma16(tr_frag(lds + VS_OFF, ks * 32, db * 16, KSTR, lane), pa, o[db]);
        }
        {
            bf16* orow = cu.O + (ptrdiff_t)(wave * 16 + fr) * cu.stride + 4 * fq;
#pragma unroll
            for (int db = 0; db < 4; ++db) { v2u w; w.x = pk2(o[db][0] * inv_own, o[db][1] * inv_own); w.y = pk2(o[db][2] * inv_own, o[db][3] * inv_own); *(v2u*)(orow + db * 16) = w; }
        }
        LDS_WAIT(); __builtin_amdgcn_s_barrier(); asm volatile("" ::: "memory");
        if (!more) break;
        u = un;
    }
    if (pend >= 0) cp_store<4>(A, pend * 2048, ck, cv, tid);
}

__device__ __forceinline__ void xattn_load(v4u (&r)[4], const bf16* base, int dc, int tid) {
#pragma unroll
    for (int i = 0; i < 4; ++i) { const int idx = tid + NTHR * i, c = idx >> 3, ch = idx & 7; r[i] = *(const v4u*)(base + (size_t)c * 1024 + dc * 64 + ch * 8); }
}
__device__ __forceinline__ void xattn_store(LAS unsigned char* dst, const v4u (&r)[4], int tid) {
#pragma unroll
    for (int i = 0; i < 4; ++i) { const int idx = tid + NTHR * i, c = idx >> 3, ch = idx & 7; *(LAS v4u*)(dst + (c * KSTR + ch * 8) * 2) = r[i]; }
}
__device__ __forceinline__ void xattn_phase(const Args& A, LAS unsigned char* lds, int tid, int wave, int lane) {
    const int G = gridDim.x;
    const int fr = lane & 15, fq = lane >> 4;
    unsigned char* ws = A.ws;
    LAS bf16* Pw = (LAS bf16*)(lds + PS_OFF + wave * 8448);
    int u = blockIdx.x;
    if (u >= 512) return;
    v4u r0[4], r1[4];
    {
        const int b = u >> 8, h = u & 3; const bf16* Kp = (const bf16*)(ws + WS_MKB) + (size_t)b * NMEM * 1024 + h * 256;
        xattn_load(r0, Kp, 0, tid); xattn_load(r1, Kp, 1, tid);
        xattn_store(lds + KS_OFF, r0, tid); xattn_load(r0, Kp, 2, tid);
        LDS_WAIT(); __builtin_amdgcn_s_barrier(); asm volatile("" ::: "memory");
    }
    for (;;) {
        const int b = u >> 8, qt = (u & 255) >> 2, h = u & 3;
        const size_t row0 = (size_t)b * SEQ + qt * 128;
        const bf16* Qp = (const bf16*)(ws + WS_A0) + (row0 + wave * 16 + fr) * 1024 + h * 256 + 8 * fq;
        const bf16* Kp = (const bf16*)(ws + WS_MKB) + (size_t)b * NMEM * 1024 + h * 256;
        const bf16* Vp = (const bf16*)(ws + WS_MVB) + (size_t)b * NMEM * 1024 + h * 256;
        bf16* Op = (bf16*)(ws + WS_MIX) + row0 * 1024 + h * 256;
        const int un = u + G; const bool more = un < 512;
        const bf16* Kn = (const bf16*)(ws + WS_MKB) + (size_t)(un >> 8) * NMEM * 1024 + (un & 3) * 256;
        bf16x8 qn0 = *(const bf16x8*)Qp, qn1 = *(const bf16x8*)(Qp + 32);
        f32x4 s[16];
#pragma unroll
        for (int nb = 0; nb < 16; ++nb) s[nb] = (f32x4){0.f, 0.f, 0.f, 0.f};
#pragma unroll
        for (int dc = 0; dc < 4; ++dc) {
            if (dc == 0) { xattn_store(lds + VS_OFF, r1, tid); xattn_load(r1, Kp, 3, tid); }
            else if (dc == 1) { xattn_store(lds + KS_OFF, r0, tid); xattn_load(r0, Vp, 0, tid); }
            else if (dc == 2) { xattn_store(lds + VS_OFF, r1, tid); xattn_load(r1, Vp, 1, tid); }
            else { xattn_store(lds + KS_OFF, r0, tid); xattn_load(r0, Vp, 2, tid); }
            const bf16x8 q0 = qn0, q1 = qn1;
            if (dc < 3) { qn0 = *(const bf16x8*)(Qp + (dc + 1) * 64); qn1 = *(const bf16x8*)(Qp + (dc + 1) * 64 + 32); }
            const LAS unsigned char* kb = lds + ((dc & 1) ? VS_OFF : KS_OFF);
#pragma unroll
            for (int nb = 0; nb < 16; ++nb) {
                const LAS unsigned char* kp = kb + ((nb * 16 + fr) * KSTR + 8 * fq) * 2;
                const bf16x8 k0 = *(const LAS bf16x8*)kp, k1 = *(const LAS bf16x8*)(kp + 64);
                s[nb] = mfma16(k0, q0, s[nb]); s[nb] = mfma16(k1, q1, s[nb]);
            }
            LDS_WAIT(); __builtin_amdgcn_s_barrier(); asm volatile("" ::: "memory");
        }
        float inv_own;
        {
            float m = -INFINITY;
#pragma unroll
            for (int nb = 0; nb < 16; ++nb) m = fmaxf(fmaxf(m, fmaxf(s[nb][0], s[nb][1])), fmaxf(s[nb][2], s[nb][3]));
            m = fmaxf(m, __shfl_xor(m, 16)); m = fmaxf(m, __shfl_xor(m, 32));
            float sum = 0.f;
#pragma unroll
            for (int nb = 0; nb < 16; ++nb) {
                const float p0 = __expf(s[nb][0] - m), p1 = __expf(s[nb][1] - m), p2 = __expf(s[nb][2] - m), p3 = __expf(s[nb][3] - m);
                sum += (p0 + p1) + (p2 + p3);
                v2u w; w.x = pk2(p0, p1); w.y = pk2(p2, p3);
                *(LAS v2u*)(Pw + fr * PSTR + nb * 16 + 4 * fq) = w;
            }
            sum += __shfl_xor(sum, 16); sum += __shfl_xor(sum, 32);
            inv_own = 1.f / sum;
        }
#pragma unroll
        for (int dc = 0; dc < 4; ++dc) {
            if (dc == 0) { xattn_store(lds + VS_OFF, r1, tid); xattn_load(r1, Vp, 3, tid); }
            else if (dc == 1) { xattn_store(lds + KS_OFF, r0, tid); if (more) xattn_load(r0, Kn, 0, tid); }
            else if (dc == 2) { xattn_store(lds + VS_OFF, r1, tid); if (more) xattn_load(r1, Kn, 1, tid); }
            else if (more) { xattn_store(lds + KS_OFF, r0, tid); xattn_load(r0, Kn, 2, tid); }
            const LAS unsigned char* vb = lds + ((dc & 1) ? VS_OFF : KS_OFF);
            f32x4 o[4];
#pragma unroll
            for (int db = 0; db < 4; ++db) o[db] = (f32x4){0.f, 0.f, 0.f, 0.f};
#pragma unroll
            for (int ks = 0; ks < 8; ++ks) {
                const bf16x8 pa = *(const LAS bf16x8*)(Pw + fr * PSTR + ks * 32 + 8 * fq);
#pragma unroll
                for (int db = 0; db < 4; ++db) o[db] = mfma16(tr_frag(vb, ks * 32, db * 16, KSTR, lane), pa, o[db]);
            }
            {
                bf16* orow = Op + (size_t)(wave * 16 + fr) * 1024 + dc * 64 + 4 * fq;
#pragma unroll
                for (int db = 0; db < 4; ++db) { v2u w; w.x = pk2(o[db][0] * inv_own, o[db][1] * inv_own); w.y = pk2(o[db][2] * inv_own, o[db][3] * inv_own); *(v2u*)(orow + db * 16) = w; }
            }
            LDS_WAIT(); __builtin_amdgcn_s_barrier(); asm volatile("" ::: "memory");
        }
        if (!more) break;
        u = un;
    }
}

constexpr int SSTR = 136;
constexpr int ACS_OFF = 139264, DTV_OFF = 141312;
__device__ __forceinline__ void ssd_dt_scan(const Args& A, LAS unsigned char* lds, int b, int c, int g, int wave, int lane, float* decay_out) {
    if (wave < 4) {
        const int h = g * 4 + wave;
        const float* dtr = (const float*)(A.ws + WS_DT);
        const float bias = A.in[13][h], aneg = -__expf(A.in[14][h]);
        const size_t row0 = (size_t)b * SEQ + c * 128 + 2 * lane;
        const float d0 = softplus_f(dtr[row0 * 8 + h] + bias), d1 = softplus_f(dtr[(row0 + 1) * 8 + h] + bias);
        const float a0 = d0 * aneg, a1 = d1 * aneg;
        float sc = a0 + a1;
#pragma unroll
        for (int o = 1; o < 64; o <<= 1) { const float t = __shfl_up(sc, o); if (lane >= o) sc += t; }
        const float ex = sc - (a0 + a1);
        LAS float* acs = (LAS float*)(lds + ACS_OFF) + wave * 128; LAS float* dtv = (LAS float*)(lds + DTV_OFF) + wave * 128;
        acs[2 * lane] = ex + a0; acs[2 * lane + 1] = sc; dtv[2 * lane] = d0; dtv[2 * lane + 1] = d1;
        if (decay_out && lane == 63) decay_out[(b * 8 + h) * 64 + c] = __expf(sc);
    }
}

constexpr int XWSTR = 264, BNSTR = 136;
__device__ __forceinline__ void ssd_pass1_unit(const Args& A, LAS unsigned char* lds, int u, int tid, int wave, int lane) {
    const int g = u & 1, c = (u >> 1) & 63, b = u >> 7;
    unsigned char* ws = A.ws;
    ssd_dt_scan(A, lds, b, c, g, wave, lane, (float*)(ws + WS_DEC));
    __syncthreads();
    const LAS float* acs = (const LAS float*)(lds + ACS_OFF); const LAS float* dtv = (const LAS float*)(lds + DTV_OFF);
    LAS bf16* Xw = (LAS bf16*)lds;
    LAS bf16* Bn = (LAS bf16*)(lds + 67584);
    {
        const int c8 = tid & 63, ci = 8 * c8;
        int ch; if (ci < 256) ch = g * 256 + ci; else if (ci < 384) ch = 512 + g * 128 + (ci - 256); else ch = 768 + g * 128 + (ci - 384);
        const float* cw = A.in[11]; const float* cb = A.in[12];
        float w[4][8], bia[8];
#pragma unroll
        for (int k = 0; k < 4; ++k) { const f32x4 a = *(const f32x4*)(cw + k * 1024 + ch), bq = *(const f32x4*)(cw + k * 1024 + ch + 4);
            w[k][0] = a[0]; w[k][1] = a[1]; w[k][2] = a[2]; w[k][3] = a[3]; w[k][4] = bq[0]; w[k][5] = bq[1]; w[k][6] = bq[2]; w[k][7] = bq[3]; }
        { const f32x4 a = *(const f32x4*)(cb + ch), bq = *(const f32x4*)(cb + ch + 4); bia[0] = a[0]; bia[1] = a[1]; bia[2] = a[2]; bia[3] = a[3]; bia[4] = bq[0]; bia[5] = bq[1]; bia[6] = bq[2]; bia[7] = bq[3]; }
        const bf16* xb = (const bf16*)(ws + WS_XBC) + (size_t)b * SEQ * 1024 + ch;
        bf16* xc = (bf16*)(ws + WS_XC) + (size_t)b * SEQ * 1024 + ch;
        const int hh = ci >> 6;
        float aend = 0.f; if (ci < 256) aend = acs[hh * 128 + 127];
#pragma unroll 1
        for (int half = 0; half < 2; ++half) {
            const int l0 = wave * 16 + half * 8, t0 = c * 128 + l0;
            v4u raw[11];
#pragma unroll
            for (int k = 0; k < 11; ++k) { const int t = t0 - 3 + k; raw[k] = (v4u){0u, 0u, 0u, 0u}; if (t >= 0) raw[k] = *(const v4u*)(xb + (size_t)t * 1024); }
#pragma unroll
            for (int r = 0; r < 8; ++r) {
                float v[8];
#pragma unroll
                for (int e = 0; e < 8; ++e) {
                    float acc = bia[e];
#pragma unroll
                    for (int k = 0; k < 4; ++k) { const unsigned wd = raw[r + k][e >> 1]; acc += w[k][e] * ((e & 1) ? bfhi(wd) : bflo(wd)); }
                    v[e] = silu_f(acc);
                }
                const int l = l0 + r;
                v4u o; o.x = pk2(v[0], v[1]); o.y = pk2(v[2], v[3]); o.z = pk2(v[4], v[5]); o.w = pk2(v[6], v[7]);
                *(v4u*)(xc + (size_t)(t0 + r) * 1024) = o;
                if (ci < 256) {
                    const float wgt = dtv[hh * 128 + l] * __expf(aend - acs[hh * 128 + l]);
                    v4u ow; ow.x = pk2(v[0] * wgt, v[1] * wgt); ow.y = pk2(v[2] * wgt, v[3] * wgt); ow.z = pk2(v[4] * wgt, v[5] * wgt); ow.w = pk2(v[6] * wgt, v[7] * wgt);
                    *(LAS v4u*)(Xw + l * XWSTR + ci) = ow;
                } else if (ci < 384) {
                    *(LAS v4u*)(Bn + l * BNSTR + (ci - 256)) = o;
                }
            }
        }
    }
    __syncthreads();
    {
        const int fr = lane & 15, fq = lane >> 4, pb = wave & 3, nh = wave >> 2;
        float* st = (float*)(ws + WS_STATE);
#pragma unroll 1
        for (int hh = 0; hh < 4; ++hh) {
            f32x4 acc[4];
#pragma unroll
            for (int i = 0; i < 4; ++i) acc[i] = (f32x4){0.f, 0.f, 0.f, 0.f};
#pragma unroll
            for (int ks = 0; ks < 4; ++ks) {
                const bf16x8 a = tr_frag((const LAS unsigned char*)Xw, ks * 32, hh * 64 + pb * 16, XWSTR, lane);
#pragma unroll
                for (int i = 0; i < 4; ++i) acc[i] = mfma16(tr_frag((const LAS unsigned char*)Bn, ks * 32, (nh * 4 + i) * 16, BNSTR, lane), a, acc[i]);
            }
            float* sp = st + ((size_t)((b * 64 + c) * 8 + g * 4 + hh)) * 8192 + (pb * 16 + fr) * 128 + 4 * fq;
#pragma unroll
            for (int i = 0; i < 4; ++i) *(f32x4*)(sp + (nh * 4 + i) * 16) = acc[i];
        }
    }
    __syncthreads();
}

__device__ __forceinline__ void ssd_pass2_unit(const Args& A, LAS unsigned char* lds, int u, int tid, int wave, int lane) {
    const int g = u & 1, c = (u >> 1) & 63, b = u >> 7;
    unsigned char* ws = A.ws;
    const int fr = lane & 15, fq = lane >> 4;
    ssd_dt_scan(A, lds, b, c, g, wave, lane, nullptr);
    LAS bf16* Cs = (LAS bf16*)lds; LAS bf16* Bs = (LAS bf16*)(lds + 34816);
    LAS bf16* Pw = (LAS bf16*)(lds + 69632 + wave * 4352);
    LAS bf16* XT = (LAS bf16*)(lds + 104448); LAS bf16* Hs = (LAS bf16*)(lds + 121856);
    const LAS float* acs = (const LAS float*)(lds + ACS_OFF); const LAS float* dtv = (const LAS float*)(lds + DTV_OFF);
    const size_t row0 = (size_t)b * SEQ + c * 128;
    const bf16* xc = (const bf16*)(ws + WS_XC) + row0 * 1024;
#pragma unroll
    for (int i = 0; i < 4; ++i) {
        const int idx = tid + NTHR * i, r = idx >> 4, ch = idx & 15;
        *(LAS v4u*)(Cs + r * SSTR + ch * 8) = *(const v4u*)(xc + (size_t)r * 1024 + 768 + g * 128 + ch * 8);
        *(LAS v4u*)(Bs + r * SSTR + ch * 8) = *(const v4u*)(xc + (size_t)r * 1024 + 512 + g * 128 + ch * 8);
    }
    __syncthreads();
    f32x4 G[8];
#pragma unroll
    for (int nb = 0; nb < 8; ++nb) G[nb] = (f32x4){0.f, 0.f, 0.f, 0.f};
#pragma unroll
    for (int ks = 0; ks < 4; ++ks) {
        const bf16x8 a = *(const LAS bf16x8*)(Cs + (wave * 16 + fr) * SSTR + ks * 32 + 8 * fq);
#pragma unroll
        for (int nb = 0; nb < 8; ++nb) { const bf16x8 bb = *(const LAS bf16x8*)(Bs + (nb * 16 + fr) * SSTR + ks * 32 + 8 * fq); G[nb] = mfma16(bb, a, G[nb]); }
    }
    const int l = wave * 16 + fr;
    float ssq1 = 0.f;
    bf16* tmp = (bf16*)(ws + WS_STATE) + (size_t)u * 128 * 256 + (size_t)l * 256 + 4 * fq;
    const bf16* zb = (const bf16*)(ws + WS_ZB) + (row0 + l) * 512 + 4 * fq;
    v4u xr[2], hr[2];
    {
        const bf16* hst0 = (const bf16*)(ws + WS_HST) + ((size_t)((b * 64 + c) * 8 + g * 4)) * 8192;
#pragma unroll
        for (int i = 0; i < 2; ++i) {
            const int idx = tid + NTHR * i;
            xr[i] = *(const v4u*)(xc + (size_t)(idx >> 3) * 1024 + g * 256 + (idx & 7) * 8);
            hr[i] = *(const v4u*)(hst0 + (idx >> 4) * 128 + (idx & 15) * 8);
        }
    }
#pragma unroll 1
    for (int hh = 0; hh < 4; ++hh) {
        const int h = g * 4 + hh;
        __syncthreads();
#pragma unroll
        for (int i = 0; i < 2; ++i) {
            const int idx = tid + NTHR * i, r = idx >> 3, ch = idx & 7;
            const v4u val = xr[i];
            const float d = dtv[hh * 128 + r];
            LAS bf16* xt = XT + (ch * 8) * SSTR + r;
            xt[0 * SSTR] = f2bf(bflo(val.x) * d); xt[1 * SSTR] = f2bf(bfhi(val.x) * d);
            xt[2 * SSTR] = f2bf(bflo(val.y) * d); xt[3 * SSTR] = f2bf(bfhi(val.y) * d);
            xt[4 * SSTR] = f2bf(bflo(val.z) * d); xt[5 * SSTR] = f2bf(bfhi(val.z) * d);
            xt[6 * SSTR] = f2bf(bflo(val.w) * d); xt[7 * SSTR] = f2bf(bfhi(val.w) * d);
        }
#pragma unroll
        for (int i = 0; i < 2; ++i) {
            const int idx = tid + NTHR * i, r = idx >> 4, ch = idx & 15;
            *(LAS v4u*)(Hs + r * SSTR + ch * 8) = hr[i];
        }
        if (hh < 3) {
            const bf16* hstn = (const bf16*)(ws + WS_HST) + ((size_t)((b * 64 + c) * 8 + h + 1)) * 8192;
#pragma unroll
            for (int i = 0; i < 2; ++i) {
                const int idx = tid + NTHR * i;
                xr[i] = *(const v4u*)(xc + (size_t)(idx >> 3) * 1024 + (h + 1) * 64 + (idx & 7) * 8);
                hr[i] = *(const v4u*)(hstn + (idx >> 4) * 128 + (idx & 15) * 8);
            }
        }
        v2u zv[4];
#pragma unroll
        for (int pb = 0; pb < 4; ++pb) zv[pb] = *(const v2u*)(zb + h * 64 + pb * 16);
        {
            const float al = acs[hh * 128 + l];
#pragma unroll
            for (int nb = 0; nb < 8; ++nb) {
                const int s0 = nb * 16 + 4 * fq;
                const f32x4 as = *(const LAS f32x4*)(acs + hh * 128 + s0);
                float p[4];
#pragma unroll
                for (int j = 0; j < 4; ++j) p[j] = (s0 + j <= l) ? G[nb][j] * __expf(al - as[j]) : 0.f;
                v2u w; w.x = pk2(p[0], p[1]); w.y = pk2(p[2], p[3]);
                *(LAS v2u*)(Pw + fr * SSTR + s0) = w;
            }
        }
        __syncthreads();
        f32x4 yd[4], yo[4];
#pragma unroll
        for (int pb = 0; pb < 4; ++pb) { yd[pb] = (f32x4){0.f, 0.f, 0.f, 0.f}; yo[pb] = (f32x4){0.f, 0.f, 0.f, 0.f}; }
#pragma unroll
        for (int ks = 0; ks < 4; ++ks) {
            const bf16x8 pa = *(const LAS bf16x8*)(Pw + fr * SSTR + ks * 32 + 8 * fq);
            const bf16x8 ca = *(const LAS bf16x8*)(Cs + (wave * 16 + fr) * SSTR + ks * 32 + 8 * fq);
#pragma unroll
            for (int pb = 0; pb < 4; ++pb) {
                const bf16x8 xb = *(const LAS bf16x8*)(XT + (pb * 16 + fr) * SSTR + ks * 32 + 8 * fq);
                const bf16x8 hb = *(const LAS bf16x8*)(Hs + (pb * 16 + fr) * SSTR + ks * 32 + 8 * fq);
                yd[pb] = mfma16(xb, pa, yd[pb]); yo[pb] = mfma16(hb, ca, yo[pb]);
            }
        }
        const float dsk = A.in[15][h];
        const float ea = __expf(acs[hh * 128 + l]), idt = 1.f / dtv[hh * 128 + l];
#pragma unroll
        for (int pb = 0; pb < 4; ++pb) {
            const float zf[4] = {bflo(zv[pb].x), bfhi(zv[pb].x), bflo(zv[pb].y), bfhi(zv[pb].y)};
            f32x4 uu;
#pragma unroll
            for (int j = 0; j < 4; ++j) {
                const int p = pb * 16 + 4 * fq + j;
                const float xv = bf2f(XT[p * SSTR + l]) * idt;
                const float y = yd[pb][j] + ea * yo[pb][j] + dsk * xv;
                uu[j] = y * silu_f(zf[j]);
                ssq1 += uu[j] * uu[j];
            }
            { v2u w; w.x = pk2(uu[0], uu[1]); w.y = pk2(uu[2], uu[3]); *(v2u*)(tmp + hh * 64 + pb * 16) = w; }
        }
    }
    bf16* mix = (bf16*)(ws + WS_MIX) + (row0 + l) * 1024 + 512 + g * 256 + 4 * fq;
    const float* gs = A.in[16] + g * 256 + 4 * fq;
    ssq1 += __shfl_xor(ssq1, 16); ssq1 += __shfl_xor(ssq1, 32);
    const float rs = rsqrtf(ssq1 * (1.f / 256.f) + EPS);
#pragma unroll
    for (int half = 0; half < 2; ++half) {
        v2u tv[8]; f32x4 gv[8];
#pragma unroll
        for (int q = 0; q < 8; ++q) { tv[q] = *(const v2u*)(tmp + (half * 8 + q) * 16); gv[q] = *(const f32x4*)(gs + (half * 8 + q) * 16); }
#pragma unroll
        for (int q = 0; q < 8; ++q) {
            const f32x4 o = (f32x4){bflo(tv[q].x), bfhi(tv[q].x), bflo(tv[q].y), bfhi(tv[q].y)} * rs * gv[q];
            v2u w; w.x = pk2(o[0], o[1]); w.y = pk2(o[2], o[3]);
            *(v2u*)(mix + (half * 8 + q) * 16) = w;
        }
    }
    __syncthreads();
}

__device__ __forceinline__ void sample_attn_pair(const Args& A, LAS unsigned char* lds, int wu, int wave, int lane) {
    const int sb = wu >> 5, h = (wu >> 2) & 7, t = wu & 3;
    const int sub = lane & 7, grp = lane >> 3, half = wave >> 2;
    LAS float* sc = (LAS float*)(lds + wave * 2048);
    const float* SQ = (const float*)(A.ws + WS_SMISC);
    const float* qp = SQ + (size_t)(sb * 4 + t) * 512 + h * 64 + 8 * sub;
    const f32x4 qa = *(const f32x4*)qp, qb = *(const f32x4*)(qp + 4);
    const float* ck = A.in[2]; const float* cv = A.in[3];
    const float* ok = A.out + O_WKS; const float* ov = A.out + O_WVS;
    constexpr int NK = 387;
    const int it0 = half ? 25 : 0, it1 = half ? 49 : 25, k0 = it0 * 8, k1 = (it1 * 8 < NK) ? it1 * 8 : NK;
#pragma unroll 5
    for (int it = it0; it < it1; ++it) {
        const int kk = it * 8 + grp, kc = kk < NK ? kk : NK - 1;
        const int br = kc / 129, j = kc - br * 129, dil = br == 0 ? 1 : (br == 1 ? 4 : 16);
        const int idx = LW + t - dil * j;
        const float* kp = ((idx < LW) ? ck + ((size_t)(sb * LW + idx) * 512 + h * 64) : ok + ((size_t)(sb * LW + idx - ST) * 512 + h * 64)) + 8 * sub;
        const f32x4 ka = *(const f32x4*)kp, kb = *(const f32x4*)(kp + 4);
        float s = ((qa[0] * ka[0] + qa[1] * ka[1]) + (qa[2] * ka[2] + qa[3] * ka[3])) + ((qb[0] * kb[0] + qb[1] * kb[1]) + (qb[2] * kb[2] + qb[3] * kb[3]));
        s += __shfl_xor(s, 1); s += __shfl_xor(s, 2); s += __shfl_xor(s, 4);
        if (sub == 0 && kk < NK) sc[kk - k0] = s * 0.125f;
    }
    LDS_WAIT();
    const int nk = k1 - k0;
    float m = -INFINITY;
    for (int kk = lane; kk < nk; kk += 64) m = fmaxf(m, sc[kk]);
    m = wave_max(m);
    float sum = 0.f;
    for (int kk = lane; kk < nk; kk += 64) { const float p = __expf(sc[kk] - m); sc[kk] = p; sum += p; }
    sum = wave_sum(sum);
    LDS_WAIT();
    f32x4 acca = {0.f, 0.f, 0.f, 0.f}, accb = {0.f, 0.f, 0.f, 0.f};
#pragma unroll 5
    for (int it = it0; it < it1; ++it) {
        const int kk = it * 8 + grp, kc = kk < NK ? kk : NK - 1;
        const int br = kc / 129, j = kc - br * 129, dil = br == 0 ? 1 : (br == 1 ? 4 : 16);
        const int idx = LW + t - dil * j;
        const float* vp = ((idx < LW) ? cv + ((size_t)(sb * LW + idx) * 512 + h * 64) : ov + ((size_t)(sb * LW + idx - ST) * 512 + h * 64)) + 8 * sub;
        const f32x4 va = *(const f32x4*)vp, vb = *(const f32x4*)(vp + 4);
        const float p = kk < NK ? sc[kk - k0] : 0.f;
        acca = acca + va * p; accb = accb + vb * p;
    }
#pragma unroll
    for (int e = 0; e < 4; ++e) {
        acca[e] += __shfl_xor(acca[e], 8); acca[e] += __shfl_xor(acca[e], 16); acca[e] += __shfl_xor(acca[e], 32);
        accb[e] += __shfl_xor(accb[e], 8); accb[e] += __shfl_xor(accb[e], 16); accb[e] += __shfl_xor(accb[e], 32);
    }
    if (half == 1 && grp == 0) {
        *(LAS f32x4*)(sc + 400 + 2 + 8 * sub + 6) = acca; *(LAS f32x4*)(sc + 400 + 2 + 8 * sub + 10) = accb;
        if (sub == 0) { sc[400] = m; sc[401] = sum; }
    }
    __syncthreads();
    if (half == 0 && grp == 0) {
        const LAS float* ps = (const LAS float*)(lds + (wave + 4) * 2048) + 400;
        const float m1 = ps[0], s1 = ps[1];
        const f32x4 oa = *(const LAS f32x4*)(ps + 8 + 8 * sub), ob = *(const LAS f32x4*)(ps + 12 + 8 * sub);
        const float mm = fmaxf(m, m1), a0 = __expf(m - mm), a1 = __expf(m1 - mm);
        const float is = 1.f / (sum * a0 + s1 * a1);
        const f32x4 ra = (acca * a0 + oa * a1) * is, rb = (accb * a0 + ob * a1) * is;
        v4u o; o.x = pk2(ra[0], ra[1]); o.y = pk2(ra[2], ra[3]); o.z = pk2(rb[0], rb[1]); o.w = pk2(rb[2], rb[3]);
        *(v4u*)((bf16*)(A.ws + WS_MIX) + (size_t)(MP + sb * 4 + t) * 1024 + h * 64 + 8 * sub) = o;
    }
    __syncthreads();
}

__device__ __forceinline__ void sample_ssd_unit(const Args& A, LAS unsigned char* lds, int u, int tid) {
    const int sb = u >> 3, h = u & 7, g = h >> 2;
    LAS float* cvv = (LAS float*)lds;
    LAS float* dts = cvv + 1280;
    const float* SX = (const float*)(A.ws + WS_SMISC) + 128 * 512;
    float* SY = (float*)(A.ws + WS_SMISC) + 128 * 512 + 128 * 1024;
    for (int idx = tid; idx < 1280; idx += NTHR) {
        const int t = idx / 320, ci = idx - t * 320;
        int ch; if (ci < 64) ch = h * 64 + ci; else if (ci < 192) ch = 512 + g * 128 + (ci - 64); else ch = 768 + g * 128 + (ci - 192);
        float acc = A.in[12][ch];
#pragma unroll
        for (int i = 0; i < 4; ++i) {
            const int k = t + i;
            const float xv = (k < 3) ? A.in[4][(size_t)(sb * 3 + k) * 1024 + ch] : SX[(size_t)(sb * 4 + k - 3) * 1024 + ch];
            acc += xv * A.in[11][i * 1024 + ch];
        }
        cvv[idx] = silu_f(acc);
    }
    if (tid < 4) {
        const float d = softplus_f(((const float*)(A.ws + WS_DT))[(size_t)(MP + sb * 4 + tid) * 8 + h] + A.in[13][h]);
        dts[tid] = d; dts[4 + tid] = __expf(d * -__expf(A.in[14][h]));
    }
    __syncthreads();
    const int p = tid >> 3, n0 = (tid & 7) * 16;
    const float* sin_ = A.in[5] + ((size_t)(sb * 8 + h) * 64 + p) * 128 + n0;
    float hs[16];
#pragma unroll
    for (int i = 0; i < 4; ++i) { const f32x4 v = *(const f32x4*)(sin_ + 4 * i); hs[4 * i] = v[0]; hs[4 * i + 1] = v[1]; hs[4 * i + 2] = v[2]; hs[4 * i + 3] = v[3]; }
    const float dsk = A.in[15][h];
#pragma unroll
    for (int t = 0; t < 4; ++t) {
        const float dA = dts[4 + t], xv = cvv[t * 320 + p], xd = xv * dts[t];
        float part = 0.f;
#pragma unroll
        for (int i = 0; i < 16; ++i) { hs[i] = hs[i] * dA + xd * cvv[t * 320 + 64 + n0 + i]; part += cvv[t * 320 + 192 + n0 + i] * hs[i]; }
        part += __shfl_xor(part, 1); part += __shfl_xor(part, 2); part += __shfl_xor(part, 4);
        if ((tid & 7) == 0) SY[(size_t)(sb * 4 + t) * 512 + h * 64 + p] = part + dsk * xv;
    }
    float* so = A.out + O_SSS + ((size_t)(sb * 8 + h) * 64 + p) * 128 + n0;
#pragma unroll
    for (int i = 0; i < 4; ++i) *(f32x4*)(so + 4 * i) = (f32x4){hs[4 * i], hs[4 * i + 1], hs[4 * i + 2], hs[4 * i + 3]};
    __syncthreads();
}

__device__ __forceinline__ void sample_xattn_unit(const Args& A, LAS unsigned char* lds, int u, int tid, int wave, int lane) {
    const int sb = u >> 2, h = u & 3;
    LAS float* qs = (LAS float*)lds; LAS float* sc = qs + 1024; LAS float* red = sc + 1024;
    const bf16* XQ = (const bf16*)(A.ws + WS_A0);
    for (int i = tid; i < 1024; i += NTHR) qs[i] = bf2f(XQ[(size_t)(MP + sb * 4 + (i >> 8)) * 1024 + h * 256 + (i & 255)]);
    __syncthreads();
    const float* cmk = A.in[6]; const float* cmv = A.in[7];
    {
        f32x4 q[4];
#pragma unroll
        for (int t = 0; t < 4; ++t) q[t] = *(const LAS f32x4*)(qs + t * 256 + 4 * lane);
#pragma unroll 8
        for (int mi = 0; mi < 32; ++mi) {
            const int m = wave * 32 + mi;
            const f32x4 k4 = *(const f32x4*)(cmk + ((size_t)(sb * 256 + m) * 4 + h) * 256 + 4 * lane);
#pragma unroll
            for (int t = 0; t < 4; ++t) {
                float s = (q[t][0] * k4[0] + q[t][1] * k4[1]) + (q[t][2] * k4[2] + q[t][3] * k4[3]);
                s = wave_sum(s);
                if (lane == 0) sc[t * 256 + m] = s;
            }
        }
    }
    __syncthreads();
    if (wave < 4) {
        float v[4]; float m = -INFINITY;
#pragma unroll
        for (int i = 0; i < 4; ++i) { v[i] = sc[wave * 256 + lane + 64 * i]; m = fmaxf(m, v[i]); }
        m = wave_max(m);
        float sum = 0.f;
#pragma unroll
        for (int i = 0; i < 4; ++i) { v[i] = __expf(v[i] - m); sum += v[i]; }
        sum = wave_sum(sum);
        const float is = 1.f / sum;
#pragma unroll
        for (int i = 0; i < 4; ++i) sc[wave * 256 + lane + 64 * i] = v[i] * is;
    }
    __syncthreads();
    {
        f32x4 o[4];
#pragma unroll
        for (int t = 0; t < 4; ++t) o[t] = (f32x4){0.f, 0.f, 0.f, 0.f};
#pragma unroll 8
        for (int mi = 0; mi < 32; ++mi) {
            const int m = wave * 32 + mi;
            const f32x4 v = *(const f32x4*)(cmv + ((size_t)(sb * 256 + m) * 4 + h) * 256 + 4 * lane);
#pragma unroll
            for (int t = 0; t < 4; ++t) o[t] = o[t] + v * sc[t * 256 + m];
        }
#pragma unroll
        for (int t = 0; t < 4; ++t) *(LAS f32x4*)(red + (wave * 4 + t) * 256 + 4 * lane) = o[t];
    }
    __syncthreads();
    {
        bf16* XO = (bf16*)(A.ws + WS_MIX);
        for (int i = tid; i < 1024; i += NTHR) {
            const int t = i >> 8, d = i & 255; float a = 0.f;
#pragma unroll
            for (int w2 = 0; w2 < 8; ++w2) a += red[(w2 * 4 + t) * 256 + d];
            XO[(size_t)(MP + sb * 4 + t) * 1024 + h * 256 + d] = f2bf(a);
        }
    }
    __syncthreads();
}

#ifndef N_LAUNCHES
#define N_LAUNCHES 1
#endif
constexpr int NPHASE = 13;

__global__ void __launch_bounds__(NTHR, 2) mega_fwd(Args A) {
    extern __shared__ __attribute__((aligned(16))) unsigned char lds_raw[];
    LAS unsigned char* lds = (LAS unsigned char*)lds_raw;
    cg::grid_group grid = cg::this_grid();
    const int tid = threadIdx.x, lane = tid & 63, wave = __builtin_amdgcn_readfirstlane(tid >> 6);
    const int G = gridDim.x, bid = blockIdx.x;
    unsigned char* ws = A.ws;
    const int lo = A.ph_lo, hi = A.ph_hi;
    volatile LAS unsigned* bst = (volatile LAS unsigned*)(lds + LDS_BYTES - 16);
    if (tid < 4) bst[tid] = 0u;
    unsigned* barw = (unsigned*)ws;
    __syncthreads();
    if (lo < 0) grid.sync();
    XcdBarrier xbar = xcd_barrier_post(barw, bst);
#ifndef PHASE_MASK
#define PHASE_MASK 0xfff
#endif
#define IN(k) (((PHASE_MASK >> (k)) & 1) && lo <= (k) && (k) < hi)
#ifndef REPEAT_MASK
#define REPEAT_MASK 0
#endif
#if REPEAT_MASK == 0
#define PH(k) if (IN(k))
#define rep_ 0
#else
#define PH(k) for (int rep_ = 0; rep_ < 1 + ((REPEAT_MASK >> (k)) & 1); ++rep_) if (IN(k))
#endif
#define SEAM(k) do { if (IN(k) && IN((k) + 1)) xcd_barrier(xbar); } while (0)

    PH(0) { if (rep_) grid.sync(); p0_prologue(A, lds, tid, wave, lane); }
    SEAM(0);

    PH(1) { if (rep_) grid.sync();
        F1 f{(bf16*)(ws + WS_QB), (bf16*)(ws + WS_KB), (bf16*)(ws + WS_VB), (bf16*)(ws + WS_ZB), (bf16*)(ws + WS_XBC), A.out,
             (float*)(ws + WS_SMISC), (float*)(ws + WS_SMISC) + 128 * 512, (const float*)(ws + WS_COS), (const float*)(ws + WS_SIN)};
        {
            pg8::Gemm g{(const pg8::bf16_t*)(ws + WS_A0), (const pg8::bf16_t*)(ws + WS_WIN), MP, NIN, DM};
            pg8::StaticOrder S; S.init(MP, NIN, G, bid);
            EpiWrap<F1> E{f};
            pg8::gemm_phase<EpiWrap<F1>, pg8::StaticOrder, true, true>(lds, g, S, E);
        }
        for (int u = bid; u < 2 * (NIN / 32); u += G)
            small_gemm_unit<4>(lds, (const bf16*)(ws + WS_A0) + (size_t)(MP + (u & 1) * 64) * DM, MP + (u & 1) * 64, (const bf16*)(ws + WS_WIN), DM, (u >> 1) * 32, f, wave, lane);
        FMem fm{A.out, (bf16*)(ws + WS_MKB), (bf16*)(ws + WS_MVB)};
        for (int u = bid; u < 4 * 64; u += G) {
            const int rt = u >> 6, cn = u & 63;
            small_gemm_unit<8>(lds, (const bf16*)(ws + WS_AM) + (size_t)rt * 128 * DM, rt * 128, (const bf16*)(ws + WS_WMKV), DM, cn * 32, fm, wave, lane);
        }
    }
    SEAM(1);

    PH(2) { if (rep_) grid.sync();
        static_assert(CP_P7 == 512, "256 pass-1 units + 256 sample SSD units carry the 512 remaining copy chunks");
        for (int u = bid; u < 256; u += G) { f32x4 ck[8], cv[8]; cp_load<8>(A, (CP_P3 + u) * 4096, ck, cv, tid); ssd_pass1_unit(A, lds, u, tid, wave, lane); cp_store<8>(A, (CP_P3 + u) * 4096, ck, cv, tid); }
        for (int u = bid; u < SB * 8; u += G) { f32x4 ck[8], cv[8]; cp_load<8>(A, (CP_P3 + 256 + u) * 4096, ck, cv, tid); sample_ssd_unit(A, lds, u, tid); cp_store<8>(A, (CP_P3 + 256 + u) * 4096, ck, cv, tid); }
        for (int pu = bid * 4; pu < SB * 8 * ST; pu += G * 4) sample_attn_pair(A, lds, pu + (wave & 3), wave, lane);
        __syncthreads();
    }
    SEAM(2);

    PH(3) { if (rep_) grid.sync();
        {
            const float* st = (const float*)(ws + WS_STATE); bf16* hst = (bf16*)(ws + WS_HST); const float* dec = (const float*)(ws + WS_DEC);
            for (int e = bid * NTHR + tid; e < NBAT * 8 * 64 * 128; e += G * NTHR) {
                const int pn = e & 8191, h = (e >> 13) & 7, b = e >> 16;
                float hr = 0.f;
#pragma unroll 1
                for (int c0 = 0; c0 < 64; c0 += 32) {
                    float sv[32], dv[32];
#pragma unroll
                    for (int k = 0; k < 32; ++k) { sv[k] = st[((size_t)((b * 64 + c0 + k) * 8 + h)) * 8192 + pn]; dv[k] = dec[(b * 8 + h) * 64 + c0 + k]; }
#pragma unroll
                    for (int k = 0; k < 32; ++k) { hst[((size_t)((b * 64 + c0 + k) * 8 + h)) * 8192 + pn] = f2bf(hr); hr = hr * dv[k] + sv[k]; }
                }
                A.out[O_SSP + (size_t)(b * 8 + h) * 8192 + pn] = hr;
            }
        }
        dil_attn_phase(A, lds, tid, wave, lane);
    }
    SEAM(3);

    PH(4) { if (rep_) grid.sync();
        for (int u = bid; u < 256; u += G) ssd_pass2_unit(A, lds, u, tid, wave, lane);
        {
            const float* lse = (const float*)(ws + WS_LSE); const bf16* obr = (const bf16*)(ws + WS_OBR); bf16* mix = (bf16*)(ws + WS_MIX);
            for (int i0 = bid * NTHR + tid; i0 < MP * 64; i0 += 4 * G * NTHR) {
                float w0[4], w1[4], w2[4]; v4u a[4], b2[4], c2[4];
#pragma unroll
                for (int k = 0; k < 4; ++k) {
                    const int i = i0 + k * G * NTHR;
                    if (i < MP * 64) {
                        const int row = i >> 6, hc = i & 63, h = hc >> 3;
                        w0[k] = lse[(size_t)row * 8 + h]; w1[k] = lse[(size_t)MP * 8 + (size_t)row * 8 + h]; w2[k] = lse[(size_t)2 * MP * 8 + (size_t)row * 8 + h];
                        const size_t o = (size_t)row * 512 + hc * 8;
                        a[k] = *(const v4u*)(obr + o); b2[k] = *(const v4u*)(obr + (size_t)MP * 512 + o); c2[k] = *(const v4u*)(obr + (size_t)2 * MP * 512 + o);
                    }
                }
#pragma unroll
                for (int k = 0; k < 4; ++k) {
                    const int i = i0 + k * G * NTHR;
                    if (i < MP * 64) {
                        const int row = i >> 6, hc = i & 63;
                        const float m = fmaxf(w0[k], fmaxf(w1[k], w2[k]));
                        float e0 = __expf(w0[k] - m), e1 = __expf(w1[k] - m), e2 = __expf(w2[k] - m);
                        const float is = 1.f / (e0 + e1 + e2); e0 *= is; e1 *= is; e2 *= is;
                        v4u r;
                        r.x = pk2(e0 * bflo(a[k].x) + e1 * bflo(b2[k].x) + e2 * bflo(c2[k].x), e0 * bfhi(a[k].x) + e1 * bfhi(b2[k].x) + e2 * bfhi(c2[k].x));
                        r.y = pk2(e0 * bflo(a[k].y) + e1 * bflo(b2[k].y) + e2 * bflo(c2[k].y), e0 * bfhi(a[k].y) + e1 * bfhi(b2[k].y) + e2 * bfhi(c2[k].y));
                        r.z = pk2(e0 * bflo(a[k].z) + e1 * bflo(b2[k].z) + e2 * bflo(c2[k].z), e0 * bfhi(a[k].z) + e1 * bfhi(b2[k].z) + e2 * bfhi(c2[k].z));
                        r.w = pk2(e0 * bflo(a[k].w) + e1 * bflo(b2[k].w) + e2 * bflo(c2[k].w), e0 * bfhi(a[k].w) + e1 * bfhi(b2[k].w) + e2 * bfhi(c2[k].w));
                        *(v4u*)(mix + (size_t)row * 1024 + hc * 8) = r;
                    }
                }
            }
            const float* SY = (const float*)(ws + WS_SMISC) + 128 * 512 + 128 * 1024; const bf16* zb = (const bf16*)(ws + WS_ZB);
            for (int wu = bid * NWAVES + wave; wu < MS * 2; wu += G * NWAVES) {
                const int r = wu >> 1, g = wu & 1;
                const f32x4 y = *(const f32x4*)(SY + (size_t)r * 512 + g * 256 + 4 * lane);
                const v2u zz = *(const v2u*)(zb + (size_t)(MP + r) * 512 + g * 256 + 4 * lane);
                f32x4 uu = {y[0] * silu_f(bflo(zz.x)), y[1] * silu_f(bfhi(zz.x)), y[2] * silu_f(bflo(zz.y)), y[3] * silu_f(bfhi(zz.y))};
                const float s = wave_sum((uu[0] * uu[0] + uu[1] * uu[1]) + (uu[2] * uu[2] + uu[3] * uu[3]));
                const float rs = rsqrtf(s * (1.f / 256.f) + EPS);
                const f32x4 gg = *(const f32x4*)(A.in[16] + g * 256 + 4 * lane);
                v2u o; o.x = pk2(uu[0] * rs * gg[0], uu[1] * rs * gg[1]); o.y = pk2(uu[2] * rs * gg[2], uu[3] * rs * gg[3]);
                *(v2u*)(mix + (size_t)(MP + r) * 1024 + 512 + g * 256 + 4 * lane) = o;
            }
        }
    }
    SEAM(4);

    PH(5) { if (rep_) grid.sync();
        FRes<0> f{A.in[0], A.in[1], A.out, (bf16*)(ws + WS_XB), (float*)(ws + WS_SSQ1)};
        {
            pg8::Gemm g{(const pg8::bf16_t*)(ws + WS_MIX), (const pg8::bf16_t*)(ws + WS_WOUT), MP, DM, DM};
            pg8::StaticOrder S; S.init(MP, DM, G, bid);
            EpiWrap<FRes<0>> E{f};
            pg8::gemm_phase<EpiWrap<FRes<0>>, pg8::StaticOrder, true, true>(lds, g, S, E);
        }
        for (int u = bid; u < 8 * (DM / 32); u += G)
            small_gemm_unit<1>(lds, (const bf16*)(ws + WS_MIX) + (size_t)MP * DM + (size_t)(u & 7) * 16 * DM, MP + (u & 7) * 16, (const bf16*)(ws + WS_WOUT), DM, (u >> 3) * 32, f, wave, lane);
    }
    SEAM(5);

    PH(6) { if (rep_) grid.sync();
        FScale<0> f{(const float*)(ws + WS_SSQ1), (bf16*)(ws + WS_A0), DM, 0.0625f};
        {
            pg8::Gemm g{(const pg8::bf16_t*)(ws + WS_XB), (const pg8::bf16_t*)(ws + WS_WXQ), MP, DM, DM};
            pg8::StaticOrder S; S.init(MP, DM, G, bid);
            EpiWrap<FScale<0>> E{f};
            pg8::gemm_phase<EpiWrap<FScale<0>>, pg8::StaticOrder, true, true>(lds, g, S, E);
        }
        for (int u = bid; u < 8 * (DM / 32); u += G)
            small_gemm_unit<1>(lds, (const bf16*)(ws + WS_XB) + (size_t)MP * DM + (size_t)(u & 7) * 16 * DM, MP + (u & 7) * 16, (const bf16*)(ws + WS_WXQ), DM, (u >> 3) * 32, f, wave, lane);
    }
    SEAM(6);

    PH(7) { if (rep_) grid.sync();
        xattn_phase(A, lds, tid, wave, lane);
        for (int u = bid; u < SB * 4; u += G) sample_xattn_unit(A, lds, u, tid, wave, lane);
    }
    SEAM(7);

    PH(8) { if (rep_) grid.sync();
        FRes<1> f{nullptr, nullptr, A.out, (bf16*)(ws + WS_XB), (float*)(ws + WS_SSQ2)};
        {
            pg8::Gemm g{(const pg8::bf16_t*)(ws + WS_MIX), (const pg8::bf16_t*)(ws + WS_WXO), MP, DM, DM};
            pg8::StaticOrder S; S.init(MP, DM, G, bid);
            EpiWrap<FRes<1>> E{f};
            pg8::gemm_phase<EpiWrap<FRes<1>>, pg8::StaticOrder, true, true>(lds, g, S, E);
        }
        for (int u = bid; u < 8 * (DM / 32); u += G)
            small_gemm_unit<1>(lds, (const bf16*)(ws + WS_MIX) + (size_t)MP * DM + (size_t)(u & 7) * 16 * DM, MP + (u & 7) * 16, (const bf16*)(ws + WS_WXO), DM, (u >> 3) * 32, f, wave, lane);
    }
    SEAM(8);

    PH(9) { if (rep_) grid.sync();
        FScale<1> f{(const float*)(ws + WS_SSQ2), (bf16*)(ws + WS_U), DFF, 1.f};
        {
            pg8::Gemm g{(const pg8::bf16_t*)(ws + WS_XB), (const pg8::bf16_t*)(ws + WS_WUP), MP, DFF, DM};
            pg8::StaticOrder S; S.init(MP, DFF, G, bid);
            EpiWrap<FScale<1>> E{f};
            pg8::gemm_phase<EpiWrap<FScale<1>>, pg8::StaticOrder, true, true>(lds, g, S, E);
        }
        for (int u = bid; u < 2 * (DFF / 32); u += G)
            small_gemm_unit<4>(lds, (const bf16*)(ws + WS_XB) + (size_t)(MP + (u & 1) * 64) * DM, MP + (u & 1) * 64, (const bf16*)(ws + WS_WUP), DM, (u >> 1) * 32, f, wave, lane);
    }
    SEAM(9);

    PH(10) { if (rep_) grid.sync();
        FRes<1> f{nullptr, nullptr, A.out, (bf16*)(ws + WS_XB), (float*)(ws + WS_SSQ3)};
        {
            pg8::Gemm g{(const pg8::bf16_t*)(ws + WS_U), (const pg8::bf16_t*)(ws + WS_WDN), MP, DM, DFF};
            pg8::StaticOrder S; S.init(MP, DM, G, bid);
            EpiWrap<FRes<1>> E{f};
            pg8::gemm_phase<EpiWrap<FRes<1>>, pg8::StaticOrder, true, true>(lds, g, S, E);
        }
        for (int u = bid; u < 8 * (DM / 32); u += G)
            small_gemm_unit<1>(lds, (const bf16*)(ws + WS_U) + (size_t)MP * DFF + (size_t)(u & 7) * 16 * DFF, MP + (u & 7) * 16, (const bf16*)(ws + WS_WDN), DFF, (u >> 3) * 32, f, wave, lane);
    }
    SEAM(10);

    PH(11) { if (rep_) grid.sync();
        const float* ssq = (const float*)(ws + WS_SSQ3); const bf16* xb = (const bf16*)(ws + WS_XB);
        f32x4 gg[4];
#pragma unroll
        for (int j = 0; j < 4; ++j) gg[j] = *(const f32x4*)(A.in[27] + 4 * lane + 256 * j);
        const int r0 = bid * NWAVES + wave, rstep = G * NWAVES;
        v2u nv[4]; float nrs = 0.f;
        if (r0 < MT) {
            nrs = rstd_from(ssq, r0);
#pragma unroll
            for (int j = 0; j < 4; ++j) nv[j] = *(const v2u*)(xb + (size_t)r0 * DM + 4 * lane + 256 * j);
        }
        for (int row = r0; row < MT; row += rstep) {
            v2u v[4]; const float rs = nrs;
#pragma unroll
            for (int j = 0; j < 4; ++j) v[j] = nv[j];
            const int rn = row + rstep;
            if (rn < MT) {
                nrs = rstd_from(ssq, rn);
#pragma unroll
                for (int j = 0; j < 4; ++j) nv[j] = *(const v2u*)(xb + (size_t)rn * DM + 4 * lane + 256 * j);
            }
            float* y = (row < MP) ? A.out + O_YP + (size_t)row * DM : A.out + O_YS + (size_t)(row - MP) * DM;
#pragma unroll
            for (int j = 0; j < 4; ++j) *(f32x4*)(y + 4 * lane + 256 * j) = (f32x4){bflo(v[j].x), bfhi(v[j].x), bflo(v[j].y), bfhi(v[j].y)} * rs * gg[j];
        }
    }
#ifdef EXTRA_SYNCS
    if (hi == NPHASE && lo == 0) { for (int i = 0; i < EXTRA_SYNCS; ++i) grid.sync(); }
#endif
#undef IN
#undef SEAM
}

extern "C" void kernel_launch(void* const* d_in, const int* in_sizes, int n_in, void* d_out, int out_size, void* d_ws, size_t ws_size, hipStream_t stream) {
    static int grid = 0;
    if (grid == 0) {
        if (n_in != 28 || (size_t)out_size != O_END || ws_size < WS_END) { fprintf(stderr, "kernel_launch: unexpected shapes: n_in %d out %d ws %zu\n", n_in, out_size, ws_size); grid = -1; return; }
        int dev = 0, cus = 0, per_cu = 0;
        (void)hipGetDevice(&dev);
        (void)hipDeviceGetAttribute(&cus, hipDeviceAttributeMultiprocessorCount, dev);
        if (hipFuncSetAttribute((const void*)mega_fwd, hipFuncAttributeMaxDynamicSharedMemorySize, LDS_BYTES) != hipSuccess) { fprintf(stderr, "kernel_launch: hipFuncSetAttribute failed\n"); grid = -1; return; }
        if (hipOccupancyMaxActiveBlocksPerMultiprocessor(&per_cu, (const void*)mega_fwd, NTHR, LDS_BYTES) != hipSuccess || per_cu < 1) { fprintf(stderr, "kernel_launch: occupancy query says %d\n", per_cu); (void)hipGetLastError(); per_cu = 1; }
        grid = cus * 1;
        if (grid <= 0) grid = 256;
    }
    if (grid < 0) return;
    Args a{};
    for (int i = 0; i < 28; ++i) a.in[i] = (const float*)d_in[i];
    a.out = (float*)d_out; a.ws = (unsigned char*)d_ws;
    auto launch = [&](int lo, int hi) {
        a.ph_lo = lo; a.ph_hi = hi;
        (void)hipMemsetAsync(d_ws, 0, XCD_BAR_WORDS * 4, stream);
        void* args[] = {&a};
        hipError_t e = hipLaunchCooperativeKernel((const void*)mega_fwd, dim3(grid), dim3(NTHR), args, LDS_BYTES, stream);
        if (e != hipSuccess) fprintf(stderr, "kernel_launch: cooperative launch failed: %s (grid %d)\n", hipGetErrorString(e), grid);
    };
#if defined(PROBE_PHASE)
    launch(0, PROBE_PHASE + 1); launch(PROBE_PHASE, PROBE_PHASE + 1); if (PROBE_PHASE + 1 < NPHASE) launch(PROBE_PHASE + 1, NPHASE);
#elif N_LAUNCHES == 1
    launch(0, NPHASE);
#else
    for (int p = 0; p < NPHASE; ++p) launch(p, p + 1);
#endif
}
```

```cpp
#include <hip/hip_runtime.h>
#include <hip/hip_cooperative_groups.h>
#include <cstdio>
#include <cstdint>
namespace cg = cooperative_groups;
#define N_LAUNCHES 1
namespace pg8 {
#define PG8_LAS __attribute__((address_space(3)))
typedef unsigned short bf16_t;
typedef short bf16x8 __attribute__((ext_vector_type(8)));
typedef float f32x4 __attribute__((ext_vector_type(4)));
typedef unsigned u32x4 __attribute__((ext_vector_type(4)));
constexpr int BM = 256, BK = 64, HALF = 128, HTB = HALF * BK * 2  , STAGE_BYTES = 8 * HTB, NXCD = 8, WGM = 8;

__host__ __device__ __forceinline__ int lds_byte(int r, int c) { const int st = (r >> 4) * 2 + (c >> 5), rr = r & 15, cc = c & 31, ob = rr * 64 + cc * 2; return st * 1024 + (ob ^ (((ob >> 9) & 1) << 5)); }
__host__ __device__ __forceinline__ void stage_rc(int b, int& R, int& C) { const int st = b / 1024, sb = b % 1024, swz = sb ^ (((sb >> 9) & 1) << 5); R = (st >> 1) * 16 + swz / 64; C = (st & 1) * 32 + (swz % 64) / 2; }
__host__ __device__ __forceinline__ int perm32(int rho) { const int n = rho >> 4, i = rho & 15; return 8 * (i >> 2) + 4 * n + (i & 3); }

struct Unit { int pm, pn; };
struct Gemm { const bf16_t* A; const bf16_t* Bt; int M, N, K; };

struct StaticOrder {
    int nM, nN, nwg, G, c;
    __host__ __device__ void init(int M, int N, int G_, int c_) { nM = M / BM; nN = N / BM; nwg = nM * nN; G = G_; c = c_; }
    __host__ __device__ bool next(int i, Unit& u) const {
        const long L = (long)i * G + c; if (L >= nwg) return false;
        int wgid = (int)L; { const int q = nwg / NXCD, r = nwg % NXCD, xcd = wgid % NXCD, off = wgid / NXCD; wgid = (xcd < r ? xcd * (q + 1) : r * (q + 1) + (xcd - r) * q) + off; }
        const int nig = WGM * nN, gid = wgid / nig, fm = gid * WGM, gsz = (nM - fm) < WGM ? (nM - fm) : WGM;
        u.pm = fm + ((wgid % nig) % gsz); u.pn = (wgid % nig) / gsz; return true;
    }
    __device__ __forceinline__ void a_ready(const Unit&) const {}
    __device__ __forceinline__ void done(const Unit&) const {}
};
__device__ __forceinline__ unsigned cvt_pk_bf16(float lo, float hi) { unsigned r; asm volatile("v_cvt_pk_bf16_f32 %0, %1, %2" : "=v"(r) : "v"(lo), "v"(hi)); return r; }
template <class Epi, class Sched, bool ALIGN_EPI = false, bool SP2 = false>
__device__ __forceinline__ void gemm_phase(PG8_LAS unsigned char* lds, const Gemm g, const Sched& S, const Epi& E) {
    const int tid = threadIdx.x, wid = __builtin_amdgcn_readfirstlane(tid >> 6), lane = tid & 63, wr = wid >> 2, wc = wid & 3, fr = lane & 15, fq = lane >> 4;
    const int K = g.K, nt = K / BK;
    unsigned voffA[2], voffB[2];
#pragma unroll
    for (int i = 0; i < 2; ++i) { int R, C; stage_rc(tid * 16 + i * 8192, R, C); const int Rb = Epi::PERM ? ((R & ~31) + perm32(R & 31)) : R;
        voffA[i] = (unsigned)(R * K + C) * 2u; voffB[i] = (unsigned)(Rb * K + C) * 2u; }
    const size_t kstep = (size_t)(BK * 2);
    const size_t hstep = (size_t)HALF * K * 2;
    const size_t tstep = 2 * hstep;
    const unsigned ldsw = (unsigned)wid * 1024u;
    const int aoff = lds_byte(wr * 64 + fr, fq * 8), boff = lds_byte(wc * 32 + fr, fq * 8);
#define PG8_SA(b, h) (((b) * 2 + (h)) * HTB)
#define PG8_SB(b, h) ((4 + (b) * 2 + (h)) * HTB)
#define PG8_STAGE(bufoff, gbase, voff) do { _Pragma("unroll") for (int _i = 0; _i < 2; ++_i) \
        __builtin_amdgcn_global_load_lds((const unsigned*)((const char*)(gbase) + (voff)[_i]), (PG8_LAS unsigned*)(lds + (bufoff) + ldsw + _i * 8192), 16, 0, 0); } while (0)
#define PG8_LDA(dst, b, h) do { _Pragma("unroll") for (int m = 0; m < 4; ++m) _Pragma("unroll") for (int k = 0; k < 2; ++k) dst[m][k] = *(const PG8_LAS bf16x8*)(lds + PG8_SA(b, h) + aoff + m * 2048 + k * 1024); } while (0)
#define PG8_LDB(dst, b, h) do { _Pragma("unroll") for (int n = 0; n < 2; ++n) _Pragma("unroll") for (int k = 0; k < 2; ++k) dst[n][k] = *(const PG8_LAS bf16x8*)(lds + PG8_SB(b, h) + boff + n * 2048 + k * 1024); } while (0)
#define PG8_MMA(ai, bj, At, Bt) do { __builtin_amdgcn_s_setprio(1); _Pragma("unroll") for (int m = 0; m < 4; ++m) _Pragma("unroll") for (int n = 0; n < 2; ++n) _Pragma("unroll") for (int k = 0; k < 2; ++k) \
        acc[ai][bj][m][n] = __builtin_amdgcn_mfma_f32_16x16x32_bf16(Bt[n][k], At[m][k], acc[ai][bj][m][n], 0, 0, 0); __builtin_amdgcn_s_setprio(0); } while (0)
#define PG8_WAIT_V(n) asm volatile("s_waitcnt vmcnt(" #n ")" ::: "memory")
#define PG8_WAIT_L(n) asm volatile("s_waitcnt lgkmcnt(" #n ")" ::: "memory")
#define PG8_BAR __builtin_amdgcn_s_barrier()
#define PG8_SCHED __builtin_amdgcn_sched_barrier(0)
    Unit cur, nxt; int ui = 0;
    if (!S.next(0, cur)) return;
    f32x4 acc[2][2][4][2];
#pragma unroll
    for (int a = 0; a < 2; ++a)
#pragma unroll
        for (int b = 0; b < 2; ++b)
#pragma unroll
            for (int m = 0; m < 4; ++m)
#pragma unroll
                for (int n = 0; n < 2; ++n) acc[a][b][m][n] = (f32x4){0.f, 0.f, 0.f, 0.f};
    bf16x8 At[4][2], B0[2][2], B1[2][2];
    const char* cA = (const char*)g.A + (size_t)cur.pm * tstep; const char* cB = (const char*)g.Bt + (size_t)cur.pn * tstep;
    S.a_ready(cur);
    if constexpr (SP2) {
        PG8_STAGE(PG8_SB(0, 0), cB, voffB); PG8_STAGE(PG8_SB(0, 1), cB + hstep, voffB); PG8_STAGE(PG8_SA(0, 0), cA, voffA); PG8_STAGE(PG8_SA(0, 1), cA + hstep, voffA);
        if (wr == 1) PG8_BAR;
        PG8_WAIT_V(2); PG8_BAR;
        PG8_STAGE(PG8_SB(1, 0), cB + kstep, voffB); PG8_STAGE(PG8_SA(1, 0), cA + kstep, voffA); PG8_STAGE(PG8_SB(1, 1), cB + hstep + kstep, voffB);
        PG8_WAIT_V(6); PG8_BAR;
    } else {
        PG8_STAGE(PG8_SB(0, 0), cB, voffB); PG8_STAGE(PG8_SA(0, 0), cA, voffA); PG8_STAGE(PG8_SB(0, 1), cB + hstep, voffB); PG8_STAGE(PG8_SA(0, 1), cA + hstep, voffA);
        if (wr == 1) PG8_BAR;
        PG8_WAIT_V(4); PG8_BAR;
        PG8_STAGE(PG8_SB(1, 0), cB + kstep, voffB); PG8_STAGE(PG8_SA(1, 0), cA + kstep, voffA); PG8_STAGE(PG8_SB(1, 1), cB + hstep + kstep, voffB);
        PG8_WAIT_V(6); PG8_BAR;
    }
    for (;;) {
        const bool has_next = S.next(ui + 1, nxt);
        const char* nA = has_next ? (const char*)g.A + (size_t)nxt.pm * tstep : cA; const char* nB = has_next ? (const char*)g.Bt + (size_t)nxt.pn * tstep : cB;
        for (int t = 0; t < nt; t += 2) {
            const bool last = (t == nt - 2);
            const char* a1 = cA + (size_t)(t + 1) * kstep;
            const char* a2 = last ? nA : cA + (size_t)(t + 2) * kstep; const char* b2 = last ? nB : cB + (size_t)(t + 2) * kstep;
            const char* a3 = a2 + kstep; const char* b3 = b2 + kstep;
            if (last && has_next) S.a_ready(nxt);
            if constexpr (SP2) {
            PG8_LDB(B0, 0, 0); PG8_LDB(B1, 0, 1); PG8_SCHED; PG8_LDA(At, 0, 0); PG8_STAGE(PG8_SA(1, 1), a1 + hstep, voffA);
            PG8_WAIT_V(8); PG8_WAIT_L(0); PG8_BAR; PG8_MMA(0, 0, At, B0); PG8_MMA(0, 1, At, B1); PG8_BAR; PG8_SCHED;
            PG8_LDA(At, 0, 1); PG8_STAGE(PG8_SB(0, 0), b2, voffB); PG8_STAGE(PG8_SB(0, 1), b2 + hstep, voffB); PG8_STAGE(PG8_SA(0, 0), a2, voffA);
            PG8_WAIT_V(8); PG8_WAIT_L(0); PG8_BAR; PG8_MMA(1, 0, At, B0); PG8_MMA(1, 1, At, B1); PG8_BAR; PG8_SCHED;
            PG8_LDB(B0, 1, 0); PG8_LDB(B1, 1, 1); PG8_SCHED; PG8_LDA(At, 1, 0); PG8_STAGE(PG8_SA(0, 1), a2 + hstep, voffA);
            PG8_WAIT_V(8); PG8_WAIT_L(0); PG8_BAR; PG8_MMA(0, 0, At, B0); PG8_MMA(0, 1, At, B1); PG8_BAR; PG8_SCHED;
            PG8_LDA(At, 1, 1); PG8_STAGE(PG8_SB(1, 0), b3, voffB); PG8_STAGE(PG8_SB(1, 1), b3 + hstep, voffB); PG8_STAGE(PG8_SA(1, 0), a3, voffA);
            PG8_WAIT_V(8); PG8_WAIT_L(0); PG8_BAR; PG8_MMA(1, 0, At, B0); PG8_MMA(1, 1, At, B1); PG8_BAR; PG8_SCHED;
            } else {
            PG8_LDB(B0, 0, 0); PG8_SCHED; PG8_LDA(At, 0, 0); PG8_STAGE(PG8_SA(1, 1), a1 + hstep, voffA);
            PG8_WAIT_L(8); PG8_BAR; PG8_WAIT_L(0); PG8_MMA(0, 0, At, B0); PG8_BAR; PG8_SCHED;
            PG8_LDB(B1, 0, 1); PG8_STAGE(PG8_SB(0, 0), b2, voffB);
            PG8_BAR; PG8_WAIT_L(0); PG8_MMA(0, 1, At, B1); PG8_BAR;
            PG8_LDA(At, 0, 1); PG8_STAGE(PG8_SA(0, 0), a2, voffA);
            PG8_BAR; PG8_WAIT_L(0); PG8_MMA(1, 0, At, B0); PG8_BAR; PG8_SCHED;
            PG8_STAGE(PG8_SB(0, 1), b2 + hstep, voffB);
            PG8_WAIT_V(6); PG8_BAR; PG8_MMA(1, 1, At, B1); PG8_BAR;
            PG8_LDB(B0, 1, 0); PG8_SCHED; PG8_LDA(At, 1, 0); PG8_STAGE(PG8_SA(0, 1), a2 + hstep, voffA);
            PG8_WAIT_L(8); PG8_BAR; PG8_WAIT_L(0); PG8_MMA(0, 0, At, B0); PG8_BAR; PG8_SCHED;
            PG8_LDB(B1, 1, 1); PG8_STAGE(PG8_SB(1, 0), b3, voffB);
            PG8_BAR; PG8_WAIT_L(0); PG8_MMA(0, 1, At, B1); PG8_BAR;
            PG8_LDA(At, 1, 1); PG8_STAGE(PG8_SA(1, 0), a3, voffA);
            PG8_BAR; PG8_WAIT_L(0); PG8_MMA(1, 0, At, B0); PG8_BAR; PG8_SCHED;
            PG8_STAGE(PG8_SB(1, 1), b3 + hstep, voffB);
            PG8_WAIT_V(6); PG8_BAR; PG8_MMA(1, 1, At, B1); PG8_BAR;
            }
        }
        if constexpr (ALIGN_EPI) { if (wr == 0) PG8_BAR; }
        if constexpr (!Epi::AFTER_DRAIN) { E(acc, cur, wr, wc, fr, fq); S.done(cur); }
        if (!has_next) break;
#pragma unroll
        for (int a = 0; a < 2; ++a)
#pragma unroll
            for (int b = 0; b < 2; ++b)
#pragma unroll
                for (int m = 0; m < 4; ++m)
#pragma unroll
                    for (int n = 0; n < 2; ++n) acc[a][b][m][n] = (f32x4){0.f, 0.f, 0.f, 0.f};
        cur = nxt; cA = nA; cB = nB; ++ui;
        if constexpr (ALIGN_EPI) { if (wr == 1) PG8_BAR; }
    }
    PG8_WAIT_V(0);
    if constexpr (!ALIGN_EPI) { if (wr == 0) PG8_BAR; }
    PG8_BAR;
    if constexpr (Epi::AFTER_DRAIN) { E.fused(acc, cur, wr, wc, fr, fq, lds, wid, lane); S.done(cur); }
#undef PG8_SA
#undef PG8_SB
#undef PG8_STAGE
#undef PG8_LDA
#undef PG8_LDB
#undef PG8_MMA
#undef PG8_WAIT_V
#undef PG8_WAIT_L
#undef PG8_BAR
#undef PG8_SCHED
}
}

#define LAS __attribute__((address_space(3)))
typedef unsigned short bf16;
typedef unsigned v4u __attribute__((ext_vector_type(4)));
typedef unsigned v2u __attribute__((ext_vector_type(2)));
typedef float f32x4 __attribute__((ext_vector_type(4)));
typedef short bf16x8 __attribute__((ext_vector_type(8)));
#define LDS_WAIT() asm volatile("s_waitcnt lgkmcnt(0)" ::: "memory")
__device__ __forceinline__ unsigned pk2(float lo, float hi) { return pg8::cvt_pk_bf16(lo, hi); }
__device__ __forceinline__ bf16 f2bf(float f) { return (bf16)(pg8::cvt_pk_bf16(f, 0.f) & 0xffffu); }
__device__ __forceinline__ float bf2f(unsigned b) { return __uint_as_float((b & 0xffffu) << 16); }
__device__ __forceinline__ float bflo(unsigned w) { return __uint_as_float(w << 16); }
__device__ __forceinline__ float bfhi(unsigned w) { return __uint_as_float(w & 0xffff0000u); }
__device__ __forceinline__ float wave_sum(float v) {
#pragma unroll
    for (int o = 1; o < 64; o <<= 1) v += __shfl_xor(v, o);
    return v;
}
__device__ __forceinline__ float wave_max(float v) {
#pragma unroll
    for (int o = 1; o < 64; o <<= 1) v = fmaxf(v, __shfl_xor(v, o));
    return v;
}
__device__ __forceinline__ float sum16(float v) { v += __shfl_xor(v, 1); v += __shfl_xor(v, 2); v += __shfl_xor(v, 4); v += __shfl_xor(v, 8); return v; }
__device__ __forceinline__ float max16(float v) { v = fmaxf(v, __shfl_xor(v, 1)); v = fmaxf(v, __shfl_xor(v, 2)); v = fmaxf(v, __shfl_xor(v, 4)); v = fmaxf(v, __shfl_xor(v, 8)); return v; }
__device__ __forceinline__ float silu_f(float v) { return v / (1.f + __expf(-v)); }
__device__ __forceinline__ float softplus_f(float x) { return fmaxf(x, 0.f) + log1pf(__expf(-fabsf(x))); }
__device__ __forceinline__ f32x4 mfma16(bf16x8 a, bf16x8 b, f32x4 c) { return __builtin_amdgcn_mfma_f32_16x16x32_bf16(a, b, c, 0, 0, 0); }

#define XB_TMO      128
#define XB_XCNT(j)  (256  + 64 * (j))
#define XB_XSUB(j)  (1280 + 64 * (j))
#define XB_XGEN(j)  (2304 + 64 * (j))
#define XB_TOP      3328
#define XB_TOPGEN   3392
#define XCD_BAR_WORDS 3456
#define XB_SPIN_CAP (1u << 18)

__device__ __forceinline__ unsigned xb_ld(unsigned* p)              { return __hip_atomic_load(p, __ATOMIC_RELAXED, __HIP_MEMORY_SCOPE_AGENT); }
__device__ __forceinline__ unsigned xb_add(unsigned* p, unsigned v) { return __hip_atomic_fetch_add(p, v, __ATOMIC_RELAXED, __HIP_MEMORY_SCOPE_AGENT); }
__device__ __forceinline__ unsigned xb_xcc_id() { return (unsigned)__builtin_amdgcn_s_getreg((3 << 11) | 20) & 0xFu; }
#define XB_SPIN(cond, bar) do { unsigned _sp = 0; while (cond) { __builtin_amdgcn_s_sleep(1); \
    if ((++_sp & 255u) == 0u) { if (xb_ld(&(bar)[XB_TMO])) break; if (_sp > XB_SPIN_CAP) { atomicAdd(&(bar)[XB_TMO], 1u); break; } } } } while (0)

struct XcdBarrier {
    unsigned* bar; unsigned x;
    volatile LAS unsigned* st;
};

__device__ __forceinline__ XcdBarrier xcd_barrier_post(unsigned* bar, volatile LAS unsigned* st) {
    XcdBarrier b; b.bar = bar; b.x = xb_xcc_id(); b.st = st;
    if (threadIdx.x == 0) (void)xb_add(&bar[XB_XCNT(b.x)], 1u);
    return b;
}
__device__ __forceinline__ void xcd_barrier_complete(unsigned* bar, unsigned x, unsigned& nloc, unsigned& nx) {
    const unsigned G = gridDim.x * gridDim.y * gridDim.z;
    unsigned sum, cnt, mine, sp = 0u;
    for (;;) {
        sum = 0u; cnt = 0u; mine = 0u;
#pragma unroll
        for (unsigned j = 0; j < 16; ++j) { const unsigned c = xb_ld(&bar[XB_XCNT(j)]); sum += c; cnt += (c > 0u) ? 1u : 0u; mine = (j == x) ? c : mine; }
        if (sum == G) break;
        __builtin_amdgcn_s_sleep(1);
        if ((++sp & 255u) == 0u) { if (xb_ld(&bar[XB_TMO])) break; if (sp > XB_SPIN_CAP) { atomicAdd(&bar[XB_TMO], 1u); break; } }
    }
    nloc = mine > 0u ? mine : 1u; nx = cnt > 0u ? cnt : 1u;
}

__device__ __forceinline__ void xcd_barrier(const XcdBarrier& b) {
    asm volatile("s_waitcnt vmcnt(0)" ::: "memory");
    __syncthreads();
    if (threadIdx.x == 0) {
        unsigned* bar = b.bar;
        __builtin_amdgcn_s_waitcnt(0);
        unsigned nloc = b.st[0], nx = b.st[1];
        if (nloc == 0u) { xcd_barrier_complete(bar, b.x, nloc, nx); b.st[0] = nloc; b.st[1] = nx; }
        const unsigned old = xb_add(&bar[XB_XSUB(b.x)], 1u);
        const unsigned gen = old / nloc;
        if (old + 1u == (gen + 1u) * nloc) {
            __builtin_amdgcn_fence(__ATOMIC_RELEASE, "agent");
            asm volatile("s_waitcnt vmcnt(0)" ::: "memory");
            const unsigned og = xb_add(&bar[XB_TOP], 1u);
            const unsigned tg = og / nx;
            if (og + 1u == (tg + 1u) * nx) xb_add(&bar[XB_TOPGEN], 1u);
            else XB_SPIN(xb_ld(&bar[XB_TOPGEN]) == tg, bar);
            __builtin_amdgcn_fence(__ATOMIC_ACQUIRE, "agent");
            xb_add(&bar[XB_XGEN(b.x)], 1u);
            asm volatile("s_waitcnt vmcnt(0)" ::: "memory");
        } else {
            XB_SPIN(xb_ld(&bar[XB_XGEN(b.x)]) == gen, bar);
            __builtin_amdgcn_fence(__ATOMIC_ACQUIRE, "agent");
            asm volatile("s_waitcnt vmcnt(0)" ::: "memory");
        }
    }
    __syncthreads();
}

constexpr int DM = 1024, SEQ = 8192, NBAT = 2, MP = NBAT * SEQ, SB = 32, ST = 4, MS = SB * ST, MT = MP + MS;
constexpr int NIN = 3072, INW = 3080, DFF = 4096, NMEM = 256, LW = 2048;
constexpr float EPS = 1e-6f;
constexpr int NWAVES = 8, NTHR = 512;
constexpr int LDS_BYTES = 147456;

constexpr size_t O_YP = 0, O_YS = O_YP + (size_t)MP * DM, O_WKP = O_YS + (size_t)MS * DM, O_WVP = O_WKP + (size_t)NBAT * LW * 512,
    O_CVP = O_WVP + (size_t)NBAT * LW * 512, O_SSP = O_CVP + (size_t)NBAT * 3 * 1024, O_MKP = O_SSP + (size_t)NBAT * 8 * 64 * 128,
    O_MVP = O_MKP + (size_t)NBAT * NMEM * 1024, O_WKS = O_MVP + (size_t)NBAT * NMEM * 1024, O_WVS = O_WKS + (size_t)SB * LW * 512,
    O_CVS = O_WVS + (size_t)SB * LW * 512, O_SSS = O_CVS + (size_t)SB * 3 * 1024, O_END = O_SSS + (size_t)SB * 8 * 64 * 128;

constexpr size_t MiB = 1u << 20;
constexpr size_t WS_WIN = 1 * MiB, WS_WOUT = 7 * MiB, WS_WXQ = 9 * MiB, WS_WMKV = 11 * MiB, WS_WXO = 15 * MiB, WS_WUP = 17 * MiB, WS_WDN = 25 * MiB;
constexpr size_t WS_COS = 33 * MiB, WS_SIN = 35 * MiB, WS_AM = 37 * MiB, WS_DT = 38 * MiB, WS_MKB = 39 * MiB, WS_MVB = 40 * MiB;
constexpr size_t WS_SSQ1 = 41 * MiB, WS_SSQ2 = 43 * MiB + 256 * 1024, WS_SSQ3 = 45 * MiB + 512 * 1024;
constexpr size_t WS_A0 = 48 * MiB;
constexpr size_t WS_MIX = 81 * MiB;
constexpr size_t WS_X = 114 * MiB;
constexpr size_t WS_XB = 179 * MiB;
constexpr size_t WS_QB = 212 * MiB, WS_KB = 229 * MiB, WS_VB = 246 * MiB, WS_ZB = 263 * MiB;
constexpr size_t WS_XBC = 280 * MiB;
constexpr size_t WS_OBR = 313 * MiB;
constexpr size_t WS_LSE = 361 * MiB;
constexpr size_t WS_STATE = 363 * MiB;
constexpr size_t WS_HST = 395 * MiB;
constexpr size_t WS_DEC = 411 * MiB;
constexpr size_t WS_SMISC = 412 * MiB;
constexpr size_t WS_XC = 413 * MiB;
constexpr size_t WS_U = 212 * MiB;
constexpr size_t WS_END = 446 * MiB;

struct Args { const float* in[28]; float* out; unsigned char* ws; int ph_lo, ph_hi; };

template <class F> struct EpiWrap {
    static constexpr bool PERM = true, AFTER_DRAIN = false;
    F f;
    __device__ __forceinline__ void operator()(const pg8::f32x4 (&acc)[2][2][4][2], const pg8::Unit& u, int wr, int wc, int fr, int fq) const {
#pragma unroll
        for (int ai = 0; ai < 2; ++ai) {
            float rs[4]; typename F::Pre pre[4][2];
#pragma unroll
            for (int m = 0; m < 4; ++m) {
                const int row = u.pm * 256 + ai * 128 + wr * 64 + m * 16 + fr;
                rs[m] = f.rowscale(row);
#pragma unroll
                for (int bj = 0; bj < 2; ++bj) pre[m][bj] = f.pre(row, u.pn * 256 + bj * 128 + wc * 32 + 8 * fq);
            }
#pragma unroll
            for (int m = 0; m < 4; ++m) {
                const int row = u.pm * 256 + ai * 128 + wr * 64 + m * 16 + fr;
#pragma unroll
                for (int bj = 0; bj < 2; ++bj) f.apply(row, u.pn * 256 + bj * 128 + wc * 32 + 8 * fq, acc[ai][bj][m][0], acc[ai][bj][m][1], rs[m], pre[m][bj]);
            }
        }
    }
};
struct NoPre {};

template <int RB, class F> __device__ __forceinline__ void small_gemm_unit(LAS unsigned char* lds, const bf16* A, int rowg0, const bf16* Bt, int K, int col0, const F& f, int wave, int lane) {
    const int fr = lane & 15, fq = lane >> 4;
    const int kw = K >> 3;
    const bf16* ap = A + (size_t)fr * K + wave * kw + 8 * fq;
    const bf16* bp0 = Bt + (size_t)(col0 + pg8::perm32(fr)) * K + wave * kw + 8 * fq;
    const bf16* bp1 = Bt + (size_t)(col0 + pg8::perm32(16 + fr)) * K + wave * kw + 8 * fq;
    f32x4 acc[RB][2];
#pragma unroll
    for (int rb = 0; rb < RB; ++rb) { acc[rb][0] = (f32x4){0.f, 0.f, 0.f, 0.f}; acc[rb][1] = (f32x4){0.f, 0.f, 0.f, 0.f}; }
#pragma unroll(RB == 1 ? 8 : 2)
    for (int k0 = 0; k0 < kw; k0 += 32) {
        const bf16x8 b0 = *(const bf16x8*)(bp0 + k0), b1 = *(const bf16x8*)(bp1 + k0);
        bf16x8 a[RB];
#pragma unroll
        for (int rb = 0; rb < RB; ++rb) a[rb] = *(const bf16x8*)(ap + (size_t)rb * 16 * K + k0);
#pragma unroll
        for (int rb = 0; rb < RB; ++rb) { acc[rb][0] = mfma16(b0, a[rb], acc[rb][0]); acc[rb][1] = mfma16(b1, a[rb], acc[rb][1]); }
    }
#pragma unroll
    for (int rb = 0; rb < RB; ++rb) {
        *(LAS f32x4*)(lds + ((wave * RB + rb) * 2 + 0) * 1024 + lane * 16) = acc[rb][0];
        *(LAS f32x4*)(lds + ((wave * RB + rb) * 2 + 1) * 1024 + lane * 16) = acc[rb][1];
    }
    LDS_WAIT(); __builtin_amdgcn_s_barrier(); asm volatile("" ::: "memory");
    if (wave < RB) {
        f32x4 c0 = {0.f, 0.f, 0.f, 0.f}, c1 = {0.f, 0.f, 0.f, 0.f};
#pragma unroll
        for (int w2 = 0; w2 < 8; ++w2) {
            c0 = c0 + *(const LAS f32x4*)(lds + ((w2 * RB + wave) * 2 + 0) * 1024 + lane * 16);
            c1 = c1 + *(const LAS f32x4*)(lds + ((w2 * RB + wave) * 2 + 1) * 1024 + lane * 16);
        }
        const int row = rowg0 + wave * 16 + fr;
        const float rs = f.rowscale(row);
        const typename F::Pre pre = f.pre(row, col0 + 8 * fq);
        f.apply(row, col0 + 8 * fq, c0, c1, rs, pre);
    }
    LDS_WAIT(); __builtin_amdgcn_s_barrier(); asm volatile("" ::: "memory");
}

__device__ __forceinline__ v4u pack8(f32x4 v0, f32x4 v1) { v4u w; w.x = pk2(v0[0], v0[1]); w.y = pk2(v0[2], v0[3]); w.z = pk2(v1[0], v1[1]); w.w = pk2(v1[2], v1[3]); return w; }

struct F1 {
    bf16 *Qb, *Kb, *Vb, *Zb, *XBCb; float* out; float *SQ, *SXBC; const float *cosT, *sinT;
    typedef NoPre Pre;
    __device__ __forceinline__ float rowscale(int) const { return 1.f; }
    __device__ __forceinline__ Pre pre(int, int) const { return Pre{}; }
    __device__ __forceinline__ void apply(int row, int col, f32x4 v0, f32x4 v1, float, const Pre&) const {
        const bool samp = row >= MP;
        int b, t, pos;
        if (!samp) { b = row >> 13; t = row & 8191; pos = t; } else { b = (row - MP) >> 2; t = (row - MP) & 3; pos = SEQ + t; }
        if (col < 1024) {
            const int isk = col >> 9, c = col & 511, hd = c >> 6, i0 = (c & 63) >> 1;
            const f32x4 cs = *(const f32x4*)(cosT + pos * 32 + i0), sn = *(const f32x4*)(sinT + pos * 32 + i0);
            const f32x4 t1 = {v0[0], v0[2], v1[0], v1[2]}, t2 = {v0[1], v0[3], v1[1], v1[3]};
            const f32x4 a = t1 * cs - t2 * sn, bb = t2 * cs + t1 * sn;
            v4u w; w.x = pk2(a[0], bb[0]); w.y = pk2(a[1], bb[1]); w.z = pk2(a[2], bb[2]); w.w = pk2(a[3], bb[3]);
            *(v4u*)((isk ? Kb : Qb) + (size_t)row * 512 + c) = w;
            float* o = nullptr;
            if (isk) {
                if (!samp) { if (t >= SEQ - LW) o = out + O_WKP + ((size_t)(b * LW + t - (SEQ - LW)) * 512 + hd * 64); }
                else o = out + O_WKS + ((size_t)(b * LW + LW - ST + t) * 512 + hd * 64);
            } else if (samp) o = SQ + (size_t)(row - MP) * 512 + hd * 64;
            if (o) { *(f32x4*)(o + i0) = a; *(f32x4*)(o + 32 + i0) = bb; }
        } else if (col < 1536) {
            const int c = col - 1024;
            *(v4u*)(Vb + (size_t)row * 512 + c) = pack8(v0, v1);
            float* o = nullptr;
            if (!samp) { if (t >= SEQ - LW) o = out + O_WVP + ((size_t)(b * LW + t - (SEQ - LW)) * 512 + c); }
            else o = out + O_WVS + ((size_t)(b * LW + LW - ST + t) * 512 + c);
            if (o) { *(f32x4*)o = v0; *(f32x4*)(o + 4) = v1; }
        } else if (col < 2048) {
            *(v4u*)(Zb + (size_t)row * 512 + (col - 1536)) = pack8(v0, v1);
        } else {
            const int c = col - 2048;
            *(v4u*)(XBCb + (size_t)row * 1024 + c) = pack8(v0, v1);
            if (!samp) { if (t >= SEQ - 3) { float* o = out + O_CVP + (size_t)(b * 3 + t - (SEQ - 3)) * 1024 + c; *(f32x4*)o = v0; *(f32x4*)(o + 4) = v1; } }
            else {
                float* o = SXBC + (size_t)(row - MP) * 1024 + c; *(f32x4*)o = v0; *(f32x4*)(o + 4) = v1;
                if (t >= 1) { float* o2 = out + O_CVS + (size_t)(b * 3 + t - 1) * 1024 + c; *(f32x4*)o2 = v0; *(f32x4*)(o2 + 4) = v1; }
            }
        }
    }
};
struct FMem {
    float* out; bf16 *MKb, *MVb;
    typedef NoPre Pre;
    __device__ __forceinline__ float rowscale(int) const { return 1.f; }
    __device__ __forceinline__ Pre pre(int, int) const { return Pre{}; }
    __device__ __forceinline__ void apply(int row, int col, f32x4 v0, f32x4 v1, float, const Pre&) const {
        const int isv = col >> 10, c = col & 1023;
        float* o = out + (isv ? O_MVP : O_MKP) + (size_t)row * 1024 + c; *(f32x4*)o = v0; *(f32x4*)(o + 4) = v1;
        *(v4u*)((isv ? MVb : MKb) + (size_t)row * 1024 + c) = pack8(v0, v1);
    }
};
template <int MODE  > struct FRes {
    const float *xp, *xs; float* out; bf16* Xb; float* ssq;
    struct Pre { f32x4 r0, r1; };
    __device__ __forceinline__ float rowscale(int) const { return 1.f; }
    __device__ __forceinline__ Pre pre(int row, int col) const {
        Pre p;
        if (MODE == 0) { const float* r = (row < MP) ? xp + (size_t)row * DM : xs + (size_t)(row - MP) * DM; p.r0 = *(const f32x4*)(r + col); p.r1 = *(const f32x4*)(r + col + 4); }
        else { const v4u w = *(const v4u*)(Xb + (size_t)row * DM + col); p.r0 = (f32x4){bflo(w.x), bfhi(w.x), bflo(w.y), bfhi(w.y)}; p.r1 = (f32x4){bflo(w.z), bfhi(w.z), bflo(w.w), bfhi(w.w)}; }
        return p;
    }
    __device__ __forceinline__ void apply(int row, int col, f32x4 v0, f32x4 v1, float, const Pre& pr) const {
        v0 = v0 + pr.r0; v1 = v1 + pr.r1;
        if (MODE == 2) { float* d = (row < MP) ? out + O_YP + (size_t)row * DM : out + O_YS + (size_t)(row - MP) * DM; *(f32x4*)(d + col) = v0; *(f32x4*)(d + col + 4) = v1; }
        else *(v4u*)(Xb + (size_t)row * DM + col) = pack8(v0, v1);
        float s = (v0[0] * v0[0] + v0[1] * v0[1]) + (v0[2] * v0[2] + v0[3] * v0[3]) + (v1[0] * v1[0] + v1[1] * v1[1]) + (v1[2] * v1[2] + v1[3] * v1[3]);
        s += __shfl_xor(s, 16); s += __shfl_xor(s, 32);
        if ((threadIdx.x & 48) == 0) ssq[(size_t)row * 32 + (col >> 5)] = s;
    }
};
__device__ __forceinline__ float rstd_from(const float* ssq, int row) {
    const f32x4* p = (const f32x4*)(ssq + (size_t)row * 32 + 8 * ((threadIdx.x >> 4) & 3));
    const f32x4 a = p[0] + p[1];
    float t = (a[0] + a[1]) + (a[2] + a[3]);
    t += __shfl_xor(t, 16); t += __shfl_xor(t, 32);
    return rsqrtf(t * (1.f / DM) + EPS);
}
template <int ACT  > struct FScale {
    const float* ssq; bf16* O; int ldo; float mul;
    typedef NoPre Pre;
    __device__ __forceinline__ float rowscale(int row) const { return rstd_from(ssq, row) * mul; }
    __device__ __forceinline__ Pre pre(int, int) const { return Pre{}; }
    __device__ __forceinline__ void apply(int row, int col, f32x4 v0, f32x4 v1, float rs, const Pre&) const {
        v0 = v0 * rs; v1 = v1 * rs;
        if (ACT == 1) {
#pragma unroll
            for (int i = 0; i < 4; ++i) { const float a = fmaxf(v0[i], 0.f), b = fmaxf(v1[i], 0.f); v0[i] = a * a; v1[i] = b * b; }
        }
        *(v4u*)(O + (size_t)row * ldo + col) = pack8(v0, v1);
    }
};

__device__ __forceinline__ void tr_item(const float* W, int ldw, int K, const float* g, bf16* WT, int row_off, bool permqk, LAS float* scr, int item, int nblk, int lane) {
    const int kb = item / nblk, nb = item % nblk, k0 = 64 * kb, n0 = 32 * nb;
    float wv[32];
#pragma unroll
    for (int i = 0; i < 32; ++i) { const int kk = 2 * i + (lane >> 5); wv[i] = W[(size_t)(k0 + kk) * ldw + n0 + (lane & 31)]; }
#pragma unroll
    for (int i = 0; i < 32; ++i) { const int kk = 2 * i + (lane >> 5); const float gv = g ? g[k0 + kk] : 1.f; scr[kk * 33 + (lane & 31)] = wv[i] * gv; }
    LDS_WAIT();
    const int c = lane & 7;
#pragma unroll
    for (int j = 0; j < 4; ++j) {
        const int n = (lane >> 3) + 8 * j; const LAS float* s = scr + (8 * c) * 33 + n;
        v4u o; o.x = pk2(s[0 * 33], s[1 * 33]); o.y = pk2(s[2 * 33], s[3 * 33]); o.z = pk2(s[4 * 33], s[5 * 33]); o.w = pk2(s[6 * 33], s[7 * 33]);
        const int nsrc = n0 + n; int ndst = nsrc;
        if (permqk && nsrc < 1024) { const int d = nsrc & 63; ndst = (nsrc & ~63) + (d < 32 ? 2 * d : 2 * (d - 32) + 1); }
        *(v4u*)(WT + (size_t)(row_off + ndst) * K + k0 + 8 * c) = o;
    }
    LDS_WAIT();
}

__device__ __forceinline__ void p0_prologue(const Args& A, LAS unsigned char* lds, int tid, int wave, int lane) {
    unsigned char* ws = A.ws;
    const int G = gridDim.x, gw = blockIdx.x * NWAVES + wave, NGW = G * NWAVES;
    const int gt = blockIdx.x * NTHR + tid, NGT = G * NTHR;
    {
        LAS float* scr = (LAS float*)(lds + wave * 16384);
        constexpr int I_IN = 16 * 96, I_SQ = 16 * 32, I_UP = 16 * 128, I_DN = 64 * 32;
        constexpr int NIT = I_IN + 5 * I_SQ + I_UP + I_DN;
        for (int it = gw; it < NIT; it += NGW) {
            int r = it;
            if (r < I_IN) { tr_item(A.in[10], INW, DM, A.in[9], (bf16*)(ws + WS_WIN), 0, true, scr, r, 96, lane); continue; } r -= I_IN;
            if (r < I_SQ) { tr_item(A.in[17], DM, DM, nullptr, (bf16*)(ws + WS_WOUT), 0, false, scr, r, 32, lane); continue; } r -= I_SQ;
            if (r < I_SQ) { tr_item(A.in[20], DM, DM, A.in[18], (bf16*)(ws + WS_WXQ), 0, false, scr, r, 32, lane); continue; } r -= I_SQ;
            if (r < I_SQ) { tr_item(A.in[21], DM, DM, nullptr, (bf16*)(ws + WS_WMKV), 0, false, scr, r, 32, lane); continue; } r -= I_SQ;
            if (r < I_SQ) { tr_item(A.in[22], DM, DM, nullptr, (bf16*)(ws + WS_WMKV), 1024, false, scr, r, 32, lane); continue; } r -= I_SQ;
            if (r < I_SQ) { tr_item(A.in[23], DM, DM, nullptr, (bf16*)(ws + WS_WXO), 0, false, scr, r, 32, lane); continue; } r -= I_SQ;
            if (r < I_UP) { tr_item(A.in[25], DFF, DM, A.in[24], (bf16*)(ws + WS_WUP), 0, false, scr, r, 128, lane); continue; } r -= I_UP;
            tr_item(A.in[26], DM, DFF, nullptr, (bf16*)(ws + WS_WDN), 0, false, scr, r, 32, lane);
        }
    }
    __syncthreads();
    LAS float* wdt = (LAS float*)lds;
    for (int i = tid; i < DM * 8; i += NTHR) { const int k = i >> 3, j = i & 7; wdt[i] = A.in[10][(size_t)k * INW + NIN + j] * A.in[9][k]; }
    __syncthreads();
    {
        bf16* A0 = (bf16*)(ws + WS_A0); float* dtr = (float*)(ws + WS_DT);
        f32x4 nv[4];
        if (gw < MT) {
            const float* xr = (gw < MP) ? A.in[0] + (size_t)gw * DM : A.in[1] + (size_t)(gw - MP) * DM;
#pragma unroll
            for (int j = 0; j < 4; ++j) nv[j] = *(const f32x4*)(xr + 4 * lane + 256 * j);
        }
        for (int row = gw; row < MT; row += NGW) {
            f32x4 v[4]; float s = 0.f;
#pragma unroll
            for (int j = 0; j < 4; ++j) { v[j] = nv[j]; s += (v[j][0] * v[j][0] + v[j][1] * v[j][1]) + (v[j][2] * v[j][2] + v[j][3] * v[j][3]); }
            if (row + NGW < MT) {
                const int rn = row + NGW;
                const float* xr = (rn < MP) ? A.in[0] + (size_t)rn * DM : A.in[1] + (size_t)(rn - MP) * DM;
#pragma unroll
                for (int j = 0; j < 4; ++j) nv[j] = *(const f32x4*)(xr + 4 * lane + 256 * j);
            }
            const float rstd = rsqrtf(wave_sum(s) * (1.f / DM) + EPS);
            float d[8] = {0.f, 0.f, 0.f, 0.f, 0.f, 0.f, 0.f, 0.f};
#pragma unroll
            for (int j = 0; j < 4; ++j) {
                v[j] = v[j] * rstd;
                v2u o; o.x = pk2(v[j][0], v[j][1]); o.y = pk2(v[j][2], v[j][3]);
                *(v2u*)(A0 + (size_t)row * DM + 4 * lane + 256 * j) = o;
#pragma unroll
                for (int e = 0; e < 4; ++e) {
                    const LAS f32x4* wp = (const LAS f32x4*)(wdt + (4 * lane + 256 * j + e) * 8);
                    const f32x4 w0 = wp[0], w1 = wp[1];
                    d[0] += v[j][e] * w0[0]; d[1] += v[j][e] * w0[1]; d[2] += v[j][e] * w0[2]; d[3] += v[j][e] * w0[3];
                    d[4] += v[j][e] * w1[0]; d[5] += v[j][e] * w1[1]; d[6] += v[j][e] * w1[2]; d[7] += v[j][e] * w1[3];
                }
            }
#pragma unroll
            for (int e = 0; e < 8; ++e) d[e] = wave_sum(d[e]);
            if (lane == 0) { *(f32x4*)(dtr + (size_t)row * 8) = (f32x4){d[0], d[1], d[2], d[3]}; *(f32x4*)(dtr + (size_t)row * 8 + 4) = (f32x4){d[4], d[5], d[6], d[7]}; }
        }
        bf16* Am = (bf16*)(ws + WS_AM);
        for (int row = gw; row < NBAT * NMEM; row += NGW) {
            const float* xr = A.in[8] + (size_t)row * DM;
            f32x4 v[4]; float s = 0.f;
#pragma unroll
            for (int j = 0; j < 4; ++j) { v[j] = *(const f32x4*)(xr + 4 * lane + 256 * j); s += (v[j][0] * v[j][0] + v[j][1] * v[j][1]) + (v[j][2] * v[j][2] + v[j][3] * v[j][3]); }
            const float rstd = rsqrtf(wave_sum(s) * (1.f / DM) + EPS);
#pragma unroll
            for (int j = 0; j < 4; ++j) {
                const f32x4 gg = *(const f32x4*)(A.in[19] + 4 * lane + 256 * j);
                v[j] = v[j] * rstd * gg;
                v2u o; o.x = pk2(v[j][0], v[j][1]); o.y = pk2(v[j][2], v[j][3]);
                *(v2u*)(Am + (size_t)row * DM + 4 * lane + 256 * j) = o;
            }
        }
    }
    {
        float* cosT = (float*)(ws + WS_COS); float* sinT = (float*)(ws + WS_SIN);
        for (int i = gt; i < (SEQ + ST) * 32; i += NGT) {
            const int pos = i >> 5, k = i & 31;
            const double inv = exp2(-(double)k * (13.287712379549449 / 32.0));
            const double rev = (double)pos * inv * 0.15915494309189535;
            const double fr = rev - floor(rev);
            const float f = (float)fr;
            cosT[i] = __builtin_amdgcn_cosf(f); sinT[i] = __builtin_amdgcn_sinf(f);
        }
    }
}

constexpr int KS_OFF = 0, KSTR = 72;
constexpr int VS_OFF = 36864;
constexpr int PS_OFF = 73728, PSTR = 264;
typedef short v4i16_t __attribute__((ext_vector_type(4)));

__device__ __forceinline__ bf16x8 tr_frag(const LAS unsigned char* tile, int row0, int col0, int strideel, int lane) {
    const int g = lane >> 4, i = lane & 15, q = i >> 2, p = i & 3;
    const LAS unsigned char* a = tile + ((row0 + 8 * g + q) * strideel + col0 + 4 * p) * 2;
    const v4i16_t lo = __builtin_amdgcn_ds_read_tr16_b64_v4i16((LAS v4i16_t*)a);
    const v4i16_t hi = __builtin_amdgcn_ds_read_tr16_b64_v4i16((LAS v4i16_t*)(a + 4 * strideel * 2));
    bf16x8 r; r[0] = lo[0]; r[1] = lo[1]; r[2] = lo[2]; r[3] = lo[3]; r[4] = hi[0]; r[5] = hi[1]; r[6] = hi[2]; r[7] = hi[3];
    return r;
}

constexpr int CP_PER = (LW - ST) * 128, CP_FULL = LW * 128, CP_CHUNKS = SB * CP_PER / 4096;
constexpr int CP_P7 = 512, CP_P3 = CP_CHUNKS - CP_P7;
static_assert(SB * CP_PER % 4096 == 0 && CP_P3 > 0 && 2 * CP_P3 <= 3072, "copy chunks: the dilated-attention units carry half chunks (2048 float4 per tensor)");
template <int NV> __device__ __forceinline__ void cp_load(const Args& A, int base, f32x4 (&ck)[NV], f32x4 (&cv)[NV], int tid) {
    const f32x4* srck = (const f32x4*)A.in[2]; const f32x4* srcv = (const f32x4*)A.in[3];
#pragma unroll
    for (int k = 0; k < NV; ++k) {
        const int i = base + k * NTHR + tid, sb = i / CP_PER, r = i - sb * CP_PER;
        const size_t so = (size_t)sb * CP_FULL + ST * 128 + r;
        ck[k] = __builtin_nontemporal_load(srck + so); cv[k] = __builtin_nontemporal_load(srcv + so);
    }
}
template <int NV> __device__ __forceinline__ void cp_store(const Args& A, int base, const f32x4 (&ck)[NV], const f32x4 (&cv)[NV], int tid) {
    f32x4* dstk = (f32x4*)(A.out + O_WKS); f32x4* dstv = (f32x4*)(A.out + O_WVS);
#pragma unroll
    for (int k = 0; k < NV; ++k) {
        const int i = base + k * NTHR + tid, sb = i / CP_PER, r = i - sb * CP_PER;
        const size_t dof = (size_t)sb * CP_FULL + r;
        __builtin_nontemporal_store(ck[k], dstk + dof); __builtin_nontemporal_store(cv[k], dstv + dof);
    }
}
struct DilUnit { const bf16 *Q, *K, *V; bf16* O; float* L; ptrdiff_t stride, lstride; bool has_prev; };
__device__ __forceinline__ DilUnit dil_unit(unsigned char* ws, int u) {
    const int br = u >> 10, rem = u & 1023, b = rem >> 9, h = (rem >> 6) & 7, sj = rem & 63;
    const int dil = br == 0 ? 1 : (br == 1 ? 4 : 16);
    const int r = sj % dil, j = sj / dil;
    const ptrdiff_t qrow = (ptrdiff_t)b * SEQ + (ptrdiff_t)j * 128 * dil + r, krow = qrow - (ptrdiff_t)128 * dil;
    DilUnit d;
    d.Q = (const bf16*)(ws + WS_QB) + qrow * 512 + h * 64; d.K = (const bf16*)(ws + WS_KB) + krow * 512 + h * 64; d.V = (const bf16*)(ws + WS_VB) + krow * 512 + h * 64;
    d.O = (bf16*)(ws + WS_OBR) + (size_t)br * MP * 512 + qrow * 512 + h * 64; d.L = (float*)(ws + WS_LSE) + (size_t)br * MP * 8 + qrow * 8 + h;
    d.stride = (ptrdiff_t)dil * 512; d.lstride = (ptrdiff_t)dil * 8; d.has_prev = j > 0;
    return d;
}
__device__ __forceinline__ void dil_load(const DilUnit& d, v4u (&kr)[4], v4u (&vr)[4], bf16x8& q0, bf16x8& q1, int tid, int wave, int lane) {
#pragma unroll
    for (int i = 0; i < 4; ++i) {
        const int idx = tid + NTHR * i, c = idx >> 3, ch = idx & 7;
        kr[i] = (v4u){0u, 0u, 0u, 0u}; vr[i] = (v4u){0u, 0u, 0u, 0u};
        if (d.has_prev || c >= 128) { kr[i] = *(const v4u*)(d.K + (ptrdiff_t)c * d.stride + ch * 8); vr[i] = *(const v4u*)(d.V + (ptrdiff_t)c * d.stride + ch * 8); }
    }
    const bf16* qrow = d.Q + (ptrdiff_t)(wave * 16 + (lane & 15)) * d.stride + 8 * (lane >> 4);
    q0 = *(const bf16x8*)qrow; q1 = *(const bf16x8*)(qrow + 32);
}

__device__ __forceinline__ void dil_attn_phase(const Args& A, LAS unsigned char* lds, int tid, int wave, int lane) {
    const int G = gridDim.x;
    int u = blockIdx.x;
    if (u >= 3072) return;
    const int fr = lane & 15, fq = lane >> 4;
    v4u kr[4], vr[4]; bf16x8 qn0, qn1;
    { const DilUnit fu = dil_unit(A.ws, u); dil_load(fu, kr, vr, qn0, qn1, tid, wave, lane); }
    LAS bf16* Pw = (LAS bf16*)(lds + PS_OFF + wave * 8448);
    f32x4 ck[4], cv[4]; int pend = -1;
    for (;;) {
        const DilUnit cu = dil_unit(A.ws, u);
#pragma unroll
        for (int i = 0; i < 4; ++i) {
            const int idx = tid + NTHR * i, c = idx >> 3, ch = idx & 7;
            *(LAS v4u*)(lds + KS_OFF + (c * KSTR + ch * 8) * 2) = kr[i];
            *(LAS v4u*)(lds + VS_OFF + (c * KSTR + ch * 8) * 2) = vr[i];
        }
        const bf16x8 q0 = qn0, q1 = qn1;
        LDS_WAIT(); __builtin_amdgcn_s_barrier(); asm volatile("" ::: "memory");
        const int un = u + G; const bool more = un < 3072;
        if (more) { const DilUnit nu = dil_unit(A.ws, un); dil_load(nu, kr, vr, qn0, qn1, tid, wave, lane); }
        if (pend >= 0) cp_store<4>(A, pend * 2048, ck, cv, tid);
        pend = -1;
        if (u < 2 * CP_P3) { cp_load<4>(A, u * 2048, ck, cv, tid); pend = u; }
        f32x4 s[9];
#pragma unroll
        for (int i = 0; i < 9; ++i) {
            const LAS unsigned char* kp = lds + KS_OFF + (((wave + i) * 16 + fr) * KSTR + 8 * fq) * 2;
            const bf16x8 k0 = *(const LAS bf16x8*)kp, k1 = *(const LAS bf16x8*)(kp + 64);
            s[i] = mfma16(k0, q0, (f32x4){0.f, 0.f, 0.f, 0.f}); s[i] = mfma16(k1, q1, s[i]);
        }
        float inv_own;
        {
            const int nbz = (wave & 1) ? wave - 1 : wave + 9;
            const int a = wave * 16 + fr;
            float m = -INFINITY;
#pragma unroll
            for (int i = 0; i < 9; ++i)
#pragma unroll
                for (int j = 0; j < 4; ++j) {
                    const int c = (wave + i) * 16 + 4 * fq + j;
                    const bool ok = (c >= a) && (c <= a + 128) && (cu.has_prev || c >= 128);
                    const float v = ok ? s[i][j] * 0.125f : -INFINITY;
                    s[i][j] = v; m = fmaxf(m, v);
                }
            m = fmaxf(m, __shfl_xor(m, 16)); m = fmaxf(m, __shfl_xor(m, 32));
            float sum = 0.f;
#pragma unroll
            for (int i = 0; i < 9; ++i) {
                const float p0 = __expf(s[i][0] - m), p1 = __expf(s[i][1] - m), p2 = __expf(s[i][2] - m), p3 = __expf(s[i][3] - m);
                sum += (p0 + p1) + (p2 + p3);
                v2u w; w.x = pk2(p0, p1); w.y = pk2(p2, p3);
                *(LAS v2u*)(Pw + fr * PSTR + (wave + i) * 16 + 4 * fq) = w;
            }
            *(LAS v2u*)(Pw + fr * PSTR + nbz * 16 + 4 * fq) = (v2u){0u, 0u};
            sum += __shfl_xor(sum, 16); sum += __shfl_xor(sum, 32);
            inv_own = 1.f / sum;
            if (fq == 0) cu.L[(ptrdiff_t)a * cu.lstride] = m + __logf(sum);
        }
        asm volatile("" ::: "memory");
        f32x4 o[4];
#pragma unroll
        for (int db = 0; db < 4; ++db) o[db] = (f32x4){0.f, 0.f, 0.f, 0.f};
#pragma unroll
        for (int kk = 0; kk < 5; ++kk) {
            const int ks = (wave >> 1) + kk;
            const bf16x8 pa = *(const LAS bf16x8*)(Pw + fr * PSTR + ks * 32 + 8 * fq);
#pragma unroll
            for (int db = 0; db < 4; ++db) o[db] = mfma16(tr_frag(lds + VS_OFF, ks * 32, db * 16, KSTR, lane), pa, o[db]);
        }
        {
            bf16* orow = cu.O + (ptrdiff_t)(wave * 16 + fr) * cu.stride + 4 * fq;
#pragma unroll
            for (int db = 0; db < 4; ++db) { v2u w; w.x = pk2(o[db][0] * inv_own, o[db][1] * inv_own); w.y = pk2(o[db][2] * inv_own, o[db][3] * inv_own); *(v2u*)(orow + db * 16) = w; }
        }
        LDS_WAIT(); __builtin_amdgcn_s_barrier(); asm volatile("" ::: "memory");
        if (!more) break;
        u = un;
    }
    if (pend >= 0) cp_store<4>(A, pend * 2048, ck, cv, tid);
}

__device__ __forceinline__ void xattn_load(v4u (&r)[4], const bf16* base, int dc, int tid) {
#pragma unroll
    for (int i = 0; i < 4; ++i) { const int idx = tid + NTHR * i, c = idx >> 3, ch = idx & 7; r[i] = *(const v4u*)(base + (size_t)c * 1024 + dc * 64 + ch * 8); }
}
__device__ __forceinline__ void xattn_store(LAS unsigned char* dst, const v4u (&r)[4], int tid) {
#pragma unroll
    for (int i = 0; i < 4; ++i) { const int idx = tid + NTHR * i, c = idx >> 3, ch = idx & 7; *(LAS v4u*)(dst + (c * KSTR + ch * 8) * 2) = r[i]; }
}
__device__ __forceinline__ void xattn_phase(const Args& A, LAS unsigned char* lds, int tid, int wave, int lane) {
    const int G = gridDim.x;
    const int fr = lane & 15, fq = lane >> 4;
    unsigned char* ws = A.ws;
    LAS bf16* Pw = (LAS bf16*)(lds + PS_OFF + wave * 8448);
    int u = blockIdx.x;
    if (u >= 512) return;
    v4u r0[4], r1[4];
    {
        const int b = u >> 8, h = u & 3; const bf16* Kp = (const bf16*)(ws + WS_MKB) + (size_t)b * NMEM * 1024 + h * 256;
        xattn_load(r0, Kp, 0, tid); xattn_load(r1, Kp, 1, tid);
        xattn_store(lds + KS_OFF, r0, tid); xattn_load(r0, Kp, 2, tid);
        LDS_WAIT(); __builtin_amdgcn_s_barrier(); asm volatile("" ::: "memory");
    }
    for (;;) {
        const int b = u >> 8, qt = (u & 255) >> 2, h = u & 3;
        const size_t row0 = (size_t)b * SEQ + qt * 128;
        const bf16* Qp = (const bf16*)(ws + WS_A0) + (row0 + wave * 16 + fr) * 1024 + h * 256 + 8 * fq;
        const bf16* Kp = (const bf16*)(ws + WS_MKB) + (size_t)b * NMEM * 1024 + h * 256;
        const bf16* Vp = (const bf16*)(ws + WS_MVB) + (size_t)b * NMEM * 1024 + h * 256;
        bf16* Op = (bf16*)(ws + WS_MIX) + row0 * 1024 + h * 256;
        const int un = u + G; const bool more = un < 512;
        const bf16* Kn = (const bf16*)(ws + WS_MKB) + (size_t)(un >> 8) * NMEM * 1024 + (un & 3) * 256;
        bf16x8 qn0 = *(const bf16x8*)Qp, qn1 = *(const bf16x8*)(Qp + 32);
        f32x4 s[16];
#pragma unroll
        for (int nb = 0; nb < 16; ++nb) s[nb] = (f32x4){0.f, 0.f, 0.f, 0.f};
#pragma unroll
        for (int dc = 0; dc < 4; ++dc) {
            if (dc == 0) { xattn_store(lds + VS_OFF, r1, tid); xattn_load(r1, Kp, 3, tid); }
            else if (dc == 1) { xattn_store(lds + KS_OFF, r0, tid); xattn_load(r0, Vp, 0, tid); }
            else if (dc == 2) { xattn_store(lds + VS_OFF, r1, tid); xattn_load(r1, Vp, 1, tid); }
            else { xattn_store(lds + KS_OFF, r0, tid); xattn_load(r0, Vp, 2, tid); }
            const bf16x8 q0 = qn0, q1 = qn1;
            if (dc < 3) { qn0 = *(const bf16x8*)(Qp + (dc + 1) * 64); qn1 = *(const bf16x8*)(Qp + (dc + 1) * 64 + 32); }
            const LAS unsigned char* kb = lds + ((dc & 1) ? VS_OFF : KS_OFF);
#pragma unroll
            for (int nb = 0; nb < 16; ++nb) {
                const LAS unsigned char* kp = kb + ((nb * 16 + fr) * KSTR + 8 * fq) * 2;
                const bf16x8 k0 = *(const LAS bf16x8*)kp, k1 = *(const LAS bf16x8*)(kp + 64);
                s[nb] = mfma16(k0, q0, s[nb]); s[nb] = mfma16(k1, q1, s[nb]);
            }
            LDS_WAIT(); __builtin_amdgcn_s_barrier(); asm volatile("" ::: "memory");
        }
        float inv_own;
        {
            float m = -INFINITY;
#pragma unroll
            for (int nb = 0; nb < 16; ++nb) m = fmaxf(fmaxf(m, fmaxf(s[nb][0], s[nb][1])), fmaxf(s[nb][2], s[nb][3]));
            m = fmaxf(m, __shfl_xor(m, 16)); m = fmaxf(m, __shfl_xor(m, 32));
            float sum = 0.f;
#pragma unroll
            for (int nb = 0; nb < 16; ++nb) {
                const float p0 = __expf(s[nb][0] - m), p1 = __expf(s[nb][1] - m), p2 = __expf(s[nb][2] - m), p3 = __expf(s[nb][3] - m);
                sum += (p0 + p1) + (p2 + p3);
                v2u w; w.x = pk2(p0, p1); w.y = pk2(p2, p3);
                *(LAS v2u*)(Pw + fr * PSTR + nb * 16 + 4 * fq) = w;
            }
            sum += __shfl_xor(sum, 16); sum += __shfl_xor(sum, 32);
            inv_own = 1.f / sum;
        }
#pragma unroll
        for (int dc = 0; dc < 4; ++dc) {
            if (dc == 0) { xattn_store(lds + VS_OFF, r1, tid); xattn_load(r1, Vp, 3, tid); }
            else if (dc == 1) { xattn_store(lds + KS_OFF, r0, tid); if (more) xattn_load(r0, Kn, 0, tid); }
            else if (dc == 2) { xattn_store(lds + VS_OFF, r1, tid); if (more) xattn_load(r1, Kn, 1, tid); }
            else if (more) { xattn_store(lds + KS_OFF, r0, tid); xattn_load(r0, Kn, 2, tid); }
            const LAS unsigned char* vb = lds + ((dc & 1) ? VS_OFF : KS_OFF);
            f32x4 o[4];
#pragma unroll
            for (int db = 0; db < 4; ++db) o[db] = (f32x4){0.f, 0.f, 0.f, 0.f};
#pragma unroll
            for (int ks = 0; ks < 8; ++ks) {
                const bf16x8 pa = *(const LAS bf16x8*)(Pw + fr * PSTR + ks * 32 + 8 * fq);
#pragma unroll
                for (int db = 0; db < 4; ++db) o[db] = mfma16(tr_frag(vb, ks * 32, db * 16, KSTR, lane), pa, o[db]);
            }
            {
                bf16* orow = Op + (size_t)(wave * 16 + fr) * 1024 + dc * 64 + 4 * fq;
#pragma unroll
                for (int db = 0; db < 4; ++db) { v2u w; w.x = pk2(o[db][0] * inv_own, o[db][1] * inv_own); w.y = pk2(o[db][2] * inv_own, o[db][3] * inv_own); *(v2u*)(orow + db * 16) = w; }
            }
            LDS_WAIT(); __builtin_amdgcn_s_barrier(); asm volatile("" ::: "memory");
        }
        if (!more) break;
        u = un;
    }
}

constexpr int SSTR = 136;
constexpr int ACS_OFF = 139264, DTV_OFF = 141312;
__device__ __forceinline__ void ssd_dt_scan(const Args& A, LAS unsigned char* lds, int b, int c, int g, int wave, int lane, float* decay_out) {
    if (wave < 4) {
        const int h = g * 4 + wave;
        const float* dtr = (const float*)(A.ws + WS_DT);
        const float bias = A.in[13][h], aneg = -__expf(A.in[14][h]);
        const size_t row0 = (size_t)b * SEQ + c * 128 + 2 * lane;
        const float d0 = softplus_f(dtr[row0 * 8 + h] + bias), d1 = softplus_f(dtr[(row0 + 1) * 8 + h] + bias);
        const float a0 = d0 * aneg, a1 = d1 * aneg;
        float sc = a0 + a1;
#pragma unroll
        for (int o = 1; o < 64; o <<= 1) { const float t = __shfl_up(sc, o); if (lane >= o) sc += t; }
        const float ex = sc - (a0 + a1);
        LAS float* acs = (LAS float*)(lds + ACS_OFF) + wave * 128; LAS float* dtv = (LAS float*)(lds + DTV_OFF) + wave * 128;
        acs[2 * lane] = ex + a0; acs[2 * lane + 1] = sc; dtv[2 * lane] = d0; dtv[2 * lane + 1] = d1;
        if (decay_out && lane == 63) decay_out[(b * 8 + h) * 64 + c] = __expf(sc);
    }
}

constexpr int XWSTR = 264, BNSTR = 136;
__device__ __forceinline__ void ssd_pass1_unit(const Args& A, LAS unsigned char* lds, int u, int tid, int wave, int lane) {
    const int g = u & 1, c = (u >> 1) & 63, b = u >> 7;
    unsigned char* ws = A.ws;
    ssd_dt_scan(A, lds, b, c, g, wave, lane, (float*)(ws + WS_DEC));
    LDS_WAIT(); __builtin_amdgcn_s_barrier(); asm volatile("" ::: "memory");
    const LAS float* acs = (const LAS float*)(lds + ACS_OFF); const LAS float* dtv = (const LAS float*)(lds + DTV_OFF);
    LAS bf16* Xw = (LAS bf16*)lds;
    LAS bf16* Bn = (LAS bf16*)(lds + 67584);
    {
        const int c8 = tid & 63, ci = 8 * c8;
        int ch; if (ci < 256) ch = g * 256 + ci; else if (ci < 384) ch = 512 + g * 128 + (ci - 256); else ch = 768 + g * 128 + (ci - 384);
        const float* cw = A.in[11]; const float* cb = A.in[12];
        float w[4][8], bia[8];
#pragma unroll
        for (int k = 0; k < 4; ++k) { const f32x4 a = *(const f32x4*)(cw + k * 1024 + ch), bq = *(const f32x4*)(cw + k * 1024 + ch + 4);
            w[k][0] = a[0]; w[k][1] = a[1]; w[k][2] = a[2]; w[k][3] = a[3]; w[k][4] = bq[0]; w[k][5] = bq[1]; w[k][6] = bq[2]; w[k][7] = bq[3]; }
        { const f32x4 a = *(const f32x4*)(cb + ch), bq = *(const f32x4*)(cb + ch + 4); bia[0] = a[0]; bia[1] = a[1]; bia[2] = a[2]; bia[3] = a[3]; bia[4] = bq[0]; bia[5] = bq[1]; bia[6] = bq[2]; bia[7] = bq[3]; }
        const bf16* xb = (const bf16*)(ws + WS_XBC) + (size_t)b * SEQ * 1024 + ch;
        bf16* xc = (bf16*)(ws + WS_XC) + (size_t)b * SEQ * 1024 + ch;
        const int hh = ci >> 6;
        float aend = 0.f; if (ci < 256) aend = acs[hh * 128 + 127];
#pragma unroll 1
        for (int half = 0; half < 2; ++half) {
            const int l0 = wave * 16 + half * 8, t0 = c * 128 + l0;
            v4u raw[11];
#pragma unroll
            for (int k = 0; k < 11; ++k) { const int t = t0 - 3 + k; raw[k] = (v4u){0u, 0u, 0u, 0u}; if (t >= 0) raw[k] = *(const v4u*)(xb + (size_t)t * 1024); }
#pragma unroll
            for (int r = 0; r < 8; ++r) {
                float v[8];
#pragma unroll
                for (int e = 0; e < 8; ++e) {
                    float acc = bia[e];
#pragma unroll
                    for (int k = 0; k < 4; ++k) { const unsigned wd = raw[r + k][e >> 1]; acc += w[k][e] * ((e & 1) ? bfhi(wd) : bflo(wd)); }
                    v[e] = silu_f(acc);
                }
                const int l = l0 + r;
                v4u o; o.x = pk2(v[0], v[1]); o.y = pk2(v[2], v[3]); o.z = pk2(v[4], v[5]); o.w = pk2(v[6], v[7]);
                *(v4u*)(xc + (size_t)(t0 + r) * 1024) = o;
                if (ci < 256) {
                    const float wgt = dtv[hh * 128 + l] * __expf(aend - acs[hh * 128 + l]);
                    v4u ow; ow.x = pk2(v[0] * wgt, v[1] * wgt); ow.y = pk2(v[2] * wgt, v[3] * wgt); ow.z = pk2(v[4] * wgt, v[5] * wgt); ow.w = pk2(v[6] * wgt, v[7] * wgt);
                    *(LAS v4u*)(Xw + l * XWSTR + ci) = ow;
                } else if (ci < 384) {
                    *(LAS v4u*)(Bn + l * BNSTR + (ci - 256)) = o;
                }
            }
        }
    }
    LDS_WAIT(); __builtin_amdgcn_s_barrier(); asm volatile("" ::: "memory");
    {
        const int fr = lane & 15, fq = lane >> 4, pb = wave & 3, nh = wave >> 2;
        float* st = (float*)(ws + WS_STATE);
#pragma unroll 1
        for (int hh = 0; hh < 4; ++hh) {
            f32x4 acc[4];
#pragma unroll
            for (int i = 0; i < 4; ++i) acc[i] = (f32x4){0.f, 0.f, 0.f, 0.f};
#pragma unroll
            for (int ks = 0; ks < 4; ++ks) {
                const bf16x8 a = tr_frag((const LAS unsigned char*)Xw, ks * 32, hh * 64 + pb * 16, XWSTR, lane);
#pragma unroll
                for (int i = 0; i < 4; ++i) acc[i] = mfma16(tr_frag((const LAS unsigned char*)Bn, ks * 32, (nh * 4 + i) * 16, BNSTR, lane), a, acc[i]);
            }
            float* sp = st + ((size_t)((b * 64 + c) * 8 + g * 4 + hh)) * 8192 + (pb * 16 + fr) * 128 + 4 * fq;
#pragma unroll
            for (int i = 0; i < 4; ++i) *(f32x4*)(sp + (nh * 4 + i) * 16) = acc[i];
        }
    }
    LDS_WAIT(); __builtin_amdgcn_s_barrier(); asm volatile("" ::: "memory");
}

__device__ __forceinline__ void ssd_pass2_unit(const Args& A, LAS unsigned char* lds, int u, int tid, int wave, int lane) {
    const int g = u & 1, c = (u >> 1) & 63, b = u >> 7;
    unsigned char* ws = A.ws;
    const int fr = lane & 15, fq = lane >> 4;
    ssd_dt_scan(A, lds, b, c, g, wave, lane, nullptr);
    LAS bf16* Cs = (LAS bf16*)lds; LAS bf16* Bs = (LAS bf16*)(lds + 34816);
    LAS bf16* Pw = (LAS bf16*)(lds + 69632 + wave * 4352);
    LAS bf16* XT = (LAS bf16*)(lds + 104448); LAS bf16* Hs = (LAS bf16*)(lds + 121856);
    const LAS float* acs = (const LAS float*)(lds + ACS_OFF); const LAS float* dtv = (const LAS float*)(lds + DTV_OFF);
    const size_t row0 = (size_t)b * SEQ + c * 128;
    const bf16* xc = (const bf16*)(ws + WS_XC) + row0 * 1024;
#pragma unroll
    for (int i = 0; i < 4; ++i) {
        const int idx = tid + NTHR * i, r = idx >> 4, ch = idx & 15;
        *(LAS v4u*)(Cs + r * SSTR + ch * 8) = *(const v4u*)(xc + (size_t)r * 1024 + 768 + g * 128 + ch * 8);
        *(LAS v4u*)(Bs + r * SSTR + ch * 8) = *(const v4u*)(xc + (size_t)r * 1024 + 512 + g * 128 + ch * 8);
    }
    LDS_WAIT(); __builtin_amdgcn_s_barrier(); asm volatile("" ::: "memory");
    f32x4 G[8];
#pragma unroll
    for (int nb = 0; nb < 8; ++nb) G[nb] = (f32x4){0.f, 0.f, 0.f, 0.f};
#pragma unroll
    for (int ks = 0; ks < 4; ++ks) {
        const bf16x8 a = *(const LAS bf16x8*)(Cs + (wave * 16 + fr) * SSTR + ks * 32 + 8 * fq);
#pragma unroll
        for (int nb = 0; nb < 8; ++nb) { const bf16x8 bb = *(const LAS bf16x8*)(Bs + (nb * 16 + fr) * SSTR + ks * 32 + 8 * fq); G[nb] = mfma16(bb, a, G[nb]); }
    }
    const int l = wave * 16 + fr;
    float ssq1 = 0.f;
    float* tmp = (float*)(ws + WS_STATE) + (size_t)u * 128 * 256 + (size_t)l * 256 + 4 * fq;
    const bf16* zb = (const bf16*)(ws + WS_ZB) + (row0 + l) * 512 + 4 * fq;
    v4u xr[2], hr[2];
    {
        const bf16* hst0 = (const bf16*)(ws + WS_HST) + ((size_t)((b * 64 + c) * 8 + g * 4)) * 8192;
#pragma unroll
        for (int i = 0; i < 2; ++i) {
            const int idx = tid + NTHR * i;
            xr[i] = *(const v4u*)(xc + (size_t)(idx >> 3) * 1024 + g * 256 + (idx & 7) * 8);
            hr[i] = *(const v4u*)(hst0 + (idx >> 4) * 128 + (idx & 15) * 8);
        }
    }
#pragma unroll 1
    for (int hh = 0; hh < 4; ++hh) {
        const int h = g * 4 + hh;
        LDS_WAIT(); __builtin_amdgcn_s_barrier(); asm volatile("" ::: "memory");
#pragma unroll
        for (int i = 0; i < 2; ++i) {
            const int idx = tid + NTHR * i, r = idx >> 3, ch = idx & 7;
            const v4u val = xr[i];
            const float d = dtv[hh * 128 + r];
            LAS bf16* xt = XT + (ch * 8) * SSTR + r;
            xt[0 * SSTR] = f2bf(bflo(val.x) * d); xt[1 * SSTR] = f2bf(bfhi(val.x) * d);
            xt[2 * SSTR] = f2bf(bflo(val.y) * d); xt[3 * SSTR] = f2bf(bfhi(val.y) * d);
            xt[4 * SSTR] = f2bf(bflo(val.z) * d); xt[5 * SSTR] = f2bf(bfhi(val.z) * d);
            xt[6 * SSTR] = f2bf(bflo(val.w) * d); xt[7 * SSTR] = f2bf(bfhi(val.w) * d);
        }
#pragma unroll
        for (int i = 0; i < 2; ++i) {
            const int idx = tid + NTHR * i, r = idx >> 4, ch = idx & 15;
            *(LAS v4u*)(Hs + r * SSTR + ch * 8) = hr[i];
        }
        if (hh < 3) {
            const bf16* hstn = (const bf16*)(ws + WS_HST) + ((size_t)((b * 64 + c) * 8 + h + 1)) * 8192;
#pragma unroll
            for (int i = 0; i < 2; ++i) {
                const int idx = tid + NTHR * i;
                xr[i] = *(const v4u*)(xc + (size_t)(idx >> 3) * 1024 + (h + 1) * 64 + (idx & 7) * 8);
                hr[i] = *(const v4u*)(hstn + (idx >> 4) * 128 + (idx & 15) * 8);
            }
        }
        v2u zv[4];
#pragma unroll
        for (int pb = 0; pb < 4; ++pb) zv[pb] = *(const v2u*)(zb + h * 64 + pb * 16);
        {
            const float al = acs[hh * 128 + l];
#pragma unroll
            for (int nb = 0; nb < 8; ++nb) {
                const int s0 = nb * 16 + 4 * fq;
                const f32x4 as = *(const LAS f32x4*)(acs + hh * 128 + s0);
                float p[4];
#pragma unroll
                for (int j = 0; j < 4; ++j) p[j] = (s0 + j <= l) ? G[nb][j] * __expf(al - as[j]) : 0.f;
                v2u w; w.x = pk2(p[0], p[1]); w.y = pk2(p[2], p[3]);
                *(LAS v2u*)(Pw + fr * SSTR + s0) = w;
            }
        }
        LDS_WAIT(); __builtin_amdgcn_s_barrier(); asm volatile("" ::: "memory");
        f32x4 yd[4], yo[4];
#pragma unroll
        for (int pb = 0; pb < 4; ++pb) { yd[pb] = (f32x4){0.f, 0.f, 0.f, 0.f}; yo[pb] = (f32x4){0.f, 0.f, 0.f, 0.f}; }
#pragma unroll
        for (int ks = 0; ks < 4; ++ks) {
            const bf16x8 pa = *(const LAS bf16x8*)(Pw + fr * SSTR + ks * 32 + 8 * fq);
            const bf16x8 ca = *(const LAS bf16x8*)(Cs + (wave * 16 + fr) * SSTR + ks * 32 + 8 * fq);
#pragma unroll
            for (int pb = 0; pb < 4; ++pb) {
                const bf16x8 xb = *(const LAS bf16x8*)(XT + (pb * 16 + fr) * SSTR + ks * 32 + 8 * fq);
                const bf16x8 hb = *(const LAS bf16x8*)(Hs + (pb * 16 + fr) * SSTR + ks * 32 + 8 * fq);
                yd[pb] = mfma16(xb, pa, yd[pb]); yo[pb] = mfma16(hb, ca, yo[pb]);
            }
        }
        const float dsk = A.in[15][h];
        const float ea = __expf(acs[hh * 128 + l]), idt = 1.f / dtv[hh * 128 + l];
#pragma unroll
        for (int pb = 0; pb < 4; ++pb) {
            const float zf[4] = {bflo(zv[pb].x), bfhi(zv[pb].x), bflo(zv[pb].y), bfhi(zv[pb].y)};
            f32x4 uu;
#pragma unroll
            for (int j = 0; j < 4; ++j) {
                const int p = pb * 16 + 4 * fq + j;
                const float xv = bf2f(XT[p * SSTR + l]) * idt;
                const float y = yd[pb][j] + ea * yo[pb][j] + dsk * xv;
                uu[j] = y * silu_f(zf[j]);
                ssq1 += uu[j] * uu[j];
            }
            *(f32x4*)(tmp + hh * 64 + pb * 16) = uu;
        }
    }
    bf16* mix = (bf16*)(ws + WS_MIX) + (row0 + l) * 1024 + 512 + g * 256 + 4 * fq;
    const float* gs = A.in[16] + g * 256 + 4 * fq;
    ssq1 += __shfl_xor(ssq1, 16); ssq1 += __shfl_xor(ssq1, 32);
    const float rs = rsqrtf(ssq1 * (1.f / 256.f) + EPS);
#pragma unroll
    for (int half = 0; half < 2; ++half) {
        f32x4 tv[8], gv[8];
#pragma unroll
        for (int q = 0; q < 8; ++q) { tv[q] = *(const f32x4*)(tmp + (half * 8 + q) * 16); gv[q] = *(const f32x4*)(gs + (half * 8 + q) * 16); }
#pragma unroll
        for (int q = 0; q < 8; ++q) {
            const f32x4 o = tv[q] * rs * gv[q];
            v2u w; w.x = pk2(o[0], o[1]); w.y = pk2(o[2], o[3]);
            *(v2u*)(mix + (half * 8 + q) * 16) = w;
        }
    }
    LDS_WAIT(); __builtin_amdgcn_s_barrier(); asm volatile("" ::: "memory");
}

__device__ __forceinline__ void sample_attn_pair(const Args& A, LAS unsigned char* lds, int wu, int wave, int lane) {
    const int sb = wu >> 5, h = (wu >> 2) & 7, t = wu & 3;
    const int sub = lane & 7, grp = lane >> 3, half = wave >> 2;
    LAS float* sc = (LAS float*)(lds + wave * 2048);
    const float* SQ = (const float*)(A.ws + WS_SMISC);
    const float* qp = SQ + (size_t)(sb * 4 + t) * 512 + h * 64 + 8 * sub;
    const f32x4 qa = *(const f32x4*)qp, qb = *(const f32x4*)(qp + 4);
    const float* ck = A.in[2]; const float* cv = A.in[3];
    const float* ok = A.out + O_WKS; const float* ov = A.out + O_WVS;
    constexpr int NK = 387;
    const int it0 = half ? 25 : 0, it1 = half ? 49 : 25, k0 = it0 * 8, k1 = (it1 * 8 < NK) ? it1 * 8 : NK;
#pragma unroll 5
    for (int it = it0; it < it1; ++it) {
        const int kk = it * 8 + grp, kc = kk < NK ? kk : NK - 1;
        const int br = kc / 129, j = kc - br * 129, dil = br == 0 ? 1 : (br == 1 ? 4 : 16);
        const int idx = LW + t - dil * j;
        const float* kp = ((idx < LW) ? ck + ((size_t)(sb * LW + idx) * 512 + h * 64) : ok + ((size_t)(sb * LW + idx - ST) * 512 + h * 64)) + 8 * sub;
        const f32x4 ka = *(const f32x4*)kp, kb = *(const f32x4*)(kp + 4);
        float s = ((qa[0] * ka[0] + qa[1] * ka[1]) + (qa[2] * ka[2] + qa[3] * ka[3])) + ((qb[0] * kb[0] + qb[1] * kb[1]) + (qb[2] * kb[2] + qb[3] * kb[3]));
        s += __shfl_xor(s, 1); s += __shfl_xor(s, 2); s += __shfl_xor(s, 4);
        if (sub == 0 && kk < NK) sc[kk - k0] = s * 0.125f;
    }
    LDS_WAIT();
    const int nk = k1 - k0;
    float m = -INFINITY;
    for (int kk = lane; kk < nk; kk += 64) m = fmaxf(m, sc[kk]);
    m = wave_max(m);
    float sum = 0.f;
    for (int kk = lane; kk < nk; kk += 64) { const float p = __expf(sc[kk] - m); sc[kk] = p; sum += p; }
    sum = wave_sum(sum);
    LDS_WAIT();
    f32x4 acca = {0.f, 0.f, 0.f, 0.f}, accb = {0.f, 0.f, 0.f, 0.f};
#pragma unroll 5
    for (int it = it0; it < it1; ++it) {
        const int kk = it * 8 + grp, kc = kk < NK ? kk : NK - 1;
        const int br = kc / 129, j = kc - br * 129, dil = br == 0 ? 1 : (br == 1 ? 4 : 16);
        const int idx = LW + t - dil * j;
        const float* vp = ((idx < LW) ? cv + ((size_t)(sb * LW + idx) * 512 + h * 64) : ov + ((size_t)(sb * LW + idx - ST) * 512 + h * 64)) + 8 * sub;
        const f32x4 va = *(const f32x4*)vp, vb = *(const f32x4*)(vp + 4);
        const float p = kk < NK ? sc[kk - k0] : 0.f;
        acca = acca + va * p; accb = accb + vb * p;
    }
#pragma unroll
    for (int e = 0; e < 4; ++e) {
        acca[e] += __shfl_xor(acca[e], 8); acca[e] += __shfl_xor(acca[e], 16); acca[e] += __shfl_xor(acca[e], 32);
        accb[e] += __shfl_xor(accb[e], 8); accb[e] += __shfl_xor(accb[e], 16); accb[e] += __shfl_xor(accb[e], 32);
    }
    if (half == 1 && grp == 0) {
        *(LAS f32x4*)(sc + 400 + 2 + 8 * sub + 6) = acca; *(LAS f32x4*)(sc + 400 + 2 + 8 * sub + 10) = accb;
        if (sub == 0) { sc[400] = m; sc[401] = sum; }
    }
    __syncthreads();
    if (half == 0 && grp == 0) {
        const LAS float* ps = (const LAS float*)(lds + (wave + 4) * 2048) + 400;
        const float m1 = ps[0], s1 = ps[1];
        const f32x4 oa = *(const LAS f32x4*)(ps + 8 + 8 * sub), ob = *(const LAS f32x4*)(ps + 12 + 8 * sub);
        const float mm = fmaxf(m, m1), a0 = __expf(m - mm), a1 = __expf(m1 - mm);
        const float is = 1.f / (sum * a0 + s1 * a1);
        const f32x4 ra = (acca * a0 + oa * a1) * is, rb = (accb * a0 + ob * a1) * is;
        v4u o; o.x = pk2(ra[0], ra[1]); o.y = pk2(ra[2], ra[3]); o.z = pk2(rb[0], rb[1]); o.w = pk2(rb[2], rb[3]);
        *(v4u*)((bf16*)(A.ws + WS_MIX) + (size_t)(MP + sb * 4 + t) * 1024 + h * 64 + 8 * sub) = o;
    }
    __syncthreads();
}

__device__ __forceinline__ void sample_ssd_unit(const Args& A, LAS unsigned char* lds, int u, int tid) {
    const int sb = u >> 3, h = u & 7, g = h >> 2;
    LAS float* cvv = (LAS float*)lds;
    LAS float* dts = cvv + 1280;
    const float* SX = (const float*)(A.ws + WS_SMISC) + 128 * 512;
    float* SY = (float*)(A.ws + WS_SMISC) + 128 * 512 + 128 * 1024;
    for (int idx = tid; idx < 1280; idx += NTHR) {
        const int t = idx / 320, ci = idx - t * 320;
        int ch; if (ci < 64) ch = h * 64 + ci; else if (ci < 192) ch = 512 + g * 128 + (ci - 64); else ch = 768 + g * 128 + (ci - 192);
        float acc = A.in[12][ch];
#pragma unroll
        for (int i = 0; i < 4; ++i) {
            const int k = t + i;
            const float xv = (k < 3) ? A.in[4][(size_t)(sb * 3 + k) * 1024 + ch] : SX[(size_t)(sb * 4 + k - 3) * 1024 + ch];
            acc += xv * A.in[11][i * 1024 + ch];
        }
        cvv[idx] = silu_f(acc);
    }
    if (tid < 4) {
        const float d = softplus_f(((const float*)(A.ws + WS_DT))[(size_t)(MP + sb * 4 + tid) * 8 + h] + A.in[13][h]);
        dts[tid] = d; dts[4 + tid] = __expf(d * -__expf(A.in[14][h]));
    }
    __syncthreads();
    const int p = tid >> 3, n0 = (tid & 7) * 16;
    const float* sin_ = A.in[5] + ((size_t)(sb * 8 + h) * 64 + p) * 128 + n0;
    float hs[16];
#pragma unroll
    for (int i = 0; i < 4; ++i) { const f32x4 v = *(const f32x4*)(sin_ + 4 * i); hs[4 * i] = v[0]; hs[4 * i + 1] = v[1]; hs[4 * i + 2] = v[2]; hs[4 * i + 3] = v[3]; }
    const float dsk = A.in[15][h];
#pragma unroll
    for (int t = 0; t < 4; ++t) {
        const float dA = dts[4 + t], xv = cvv[t * 320 + p], xd = xv * dts[t];
        float part = 0.f;
#pragma unroll
        for (int i = 0; i < 16; ++i) { hs[i] = hs[i] * dA + xd * cvv[t * 320 + 64 + n0 + i]; part += cvv[t * 320 + 192 + n0 + i] * hs[i]; }
        part += __shfl_xor(part, 1); part += __shfl_xor(part, 2); part += __shfl_xor(part, 4);
        if ((tid & 7) == 0) SY[(size_t)(sb * 4 + t) * 512 + h * 64 + p] = part + dsk * xv;
    }
    float* so = A.out + O_SSS + ((size_t)(sb * 8 + h) * 64 + p) * 128 + n0;
#pragma unroll
    for (int i = 0; i < 4; ++i) *(f32x4*)(so + 4 * i) = (f32x4){hs[4 * i], hs[4 * i + 1], hs[4 * i + 2], hs[4 * i + 3]};
    __syncthreads();
}

__device__ __forceinline__ void sample_xattn_unit(const Args& A, LAS unsigned char* lds, int u, int tid, int wave, int lane) {
    const int sb = u >> 2, h = u & 3;
    LAS float* qs = (LAS float*)lds; LAS float* sc = qs + 1024; LAS float* red = sc + 1024;
    const bf16* XQ = (const bf16*)(A.ws + WS_A0);
    for (int i = tid; i < 1024; i += NTHR) qs[i] = bf2f(XQ[(size_t)(MP + sb * 4 + (i >> 8)) * 1024 + h * 256 + (i & 255)]);
    __syncthreads();
    const float* cmk = A.in[6]; const float* cmv = A.in[7];
    {
        f32x4 q[4];
#pragma unroll
        for (int t = 0; t < 4; ++t) q[t] = *(const LAS f32x4*)(qs + t * 256 + 4 * lane);
#pragma unroll 8
        for (int mi = 0; mi < 32; ++mi) {
            const int m = wave * 32 + mi;
            const f32x4 k4 = *(const f32x4*)(cmk + ((size_t)(sb * 256 + m) * 4 + h) * 256 + 4 * lane);
#pragma unroll
            for (int t = 0; t < 4; ++t) {
                float s = (q[t][0] * k4[0] + q[t][1] * k4[1]) + (q[t][2] * k4[2] + q[t][3] * k4[3]);
                s = wave_sum(s);
                if (lane == 0) sc[t * 256 + m] = s;
            }
        }
    }
    __syncthreads();
    if (wave < 4) {
        float v[4]; float m = -INFINITY;
#pragma unroll
        for (int i = 0; i < 4; ++i) { v[i] = sc[wave * 256 + lane + 64 * i]; m = fmaxf(m, v[i]); }
        m = wave_max(m);
        float sum = 0.f;
#pragma unroll
        for (int i = 0; i < 4; ++i) { v[i] = __expf(v[i] - m); sum += v[i]; }
        sum = wave_sum(sum);
        const float is = 1.f / sum;
#pragma unroll
        for (int i = 0; i < 4; ++i) sc[wave * 256 + lane + 64 * i] = v[i] * is;
    }
    __syncthreads();
    {
        f32x4 o[4];
#pragma unroll
        for (int t = 0; t < 4; ++t) o[t] = (f32x4){0.f, 0.f, 0.f, 0.f};
#pragma unroll 8
        for (int mi = 0; mi < 32; ++mi) {
            const int m = wave * 32 + mi;
            const f32x4 v = *(const f32x4*)(cmv + ((size_t)(sb * 256 + m) * 4 + h) * 256 + 4 * lane);
#pragma unroll
            for (int t = 0; t < 4; ++t) o[t] = o[t] + v * sc[t * 256 + m];
        }
#pragma unroll
        for (int t = 0; t < 4; ++t) *(LAS f32x4*)(red + (wave * 4 + t) * 256 + 4 * lane) = o[t];
    }
    __syncthreads();
    {
        bf16* XO = (bf16*)(A.ws + WS_MIX);
        for (int i = tid; i < 1024; i += NTHR) {
            const int t = i >> 8, d = i & 255; float a = 0.f;
#pragma unroll
            for (int w2 = 0; w2 < 8; ++w2) a += red[(w2 * 4 + t) * 256 + d];
            XO[(size_t)(MP + sb * 4 + t) * 1024 + h * 256 + d] = f2bf(a);
        }
    }
    __syncthreads();
}

#ifndef N_LAUNCHES
#define N_LAUNCHES 1
#endif
constexpr int NPHASE = 13;

__global__ void __launch_bounds__(NTHR, 2) mega_fwd(Args A) {
    extern __shared__ __attribute__((aligned(16))) unsigned char lds_raw[];
    LAS unsigned char* lds = (LAS unsigned char*)lds_raw;
    cg::grid_group grid = cg::this_grid();
    const int tid = threadIdx.x, lane = tid & 63, wave = __builtin_amdgcn_readfirstlane(tid >> 6);
    const int G = gridDim.x, bid = blockIdx.x;
    unsigned char* ws = A.ws;
    const int lo = A.ph_lo, hi = A.ph_hi;
    volatile LAS unsigned* bst = (volatile LAS unsigned*)(lds + LDS_BYTES - 16);
    if (tid < 4) bst[tid] = 0u;
    unsigned* barw = (unsigned*)ws;
    __syncthreads();
    if (lo < 0) grid.sync();
    XcdBarrier xbar = xcd_barrier_post(barw, bst);
#ifndef PHASE_MASK
#define PHASE_MASK 0xfff
#endif
#define IN(k) (((PHASE_MASK >> (k)) & 1) && lo <= (k) && (k) < hi)
#ifndef REPEAT_MASK
#define REPEAT_MASK 0
#endif
#if REPEAT_MASK == 0
#define PH(k) if (IN(k))
#define rep_ 0
#else
#define PH(k) for (int rep_ = 0; rep_ < 1 + ((REPEAT_MASK >> (k)) & 1); ++rep_) if (IN(k))
#endif
#define SEAM(k) do { if (IN(k) && IN((k) + 1)) xcd_barrier(xbar); } while (0)

    PH(0) { if (rep_) grid.sync(); p0_prologue(A, lds, tid, wave, lane); }
    SEAM(0);

    PH(1) { if (rep_) grid.sync();
        F1 f{(bf16*)(ws + WS_QB), (bf16*)(ws + WS_KB), (bf16*)(ws + WS_VB), (bf16*)(ws + WS_ZB), (bf16*)(ws + WS_XBC), A.out,
             (float*)(ws + WS_SMISC), (float*)(ws + WS_SMISC) + 128 * 512, (const float*)(ws + WS_COS), (const float*)(ws + WS_SIN)};
        {
            pg8::Gemm g{(const pg8::bf16_t*)(ws + WS_A0), (const pg8::bf16_t*)(ws + WS_WIN), MP, NIN, DM};
            pg8::StaticOrder S; S.init(MP, NIN, G, bid);
            EpiWrap<F1> E{f};
            pg8::gemm_phase<EpiWrap<F1>, pg8::StaticOrder, true, true>(lds, g, S, E);
        }
        for (int u = bid; u < 2 * (NIN / 32); u += G)
            small_gemm_unit<4>(lds, (const bf16*)(ws + WS_A0) + (size_t)(MP + (u & 1) * 64) * DM, MP + (u & 1) * 64, (const bf16*)(ws + WS_WIN), DM, (u >> 1) * 32, f, wave, lane);
        FMem fm{A.out, (bf16*)(ws + WS_MKB), (bf16*)(ws + WS_MVB)};
        for (int u = bid; u < 4 * 64; u += G) {
            const int rt = u >> 6, cn = u & 63;
            small_gemm_unit<8>(lds, (const bf16*)(ws + WS_AM) + (size_t)rt * 128 * DM, rt * 128, (const bf16*)(ws + WS_WMKV), DM, cn * 32, fm, wave, lane);
        }
    }
    SEAM(1);

    PH(2) { if (rep_) grid.sync();
        static_assert(CP_P7 == 512, "256 pass-1 units + 256 sample SSD units carry the 512 remaining copy chunks");
        for (int u = bid; u < 256; u += G) { f32x4 ck[8], cv[8]; cp_load<8>(A, (CP_P3 + u) * 4096, ck, cv, tid); ssd_pass1_unit(A, lds, u, tid, wave, lane); cp_store<8>(A, (CP_P3 + u) * 4096, ck, cv, tid); }
        for (int u = bid; u < SB * 8; u += G) { f32x4 ck[8], cv[8]; cp_load<8>(A, (CP_P3 + 256 + u) * 4096, ck, cv, tid); sample_ssd_unit(A, lds, u, tid); cp_store<8>(A, (CP_P3 + 256 + u) * 4096, ck, cv, tid); }
        for (int pu = bid * 4; pu < SB * 8 * ST; pu += G * 4) sample_attn_pair(A, lds, pu + (wave & 3), wave, lane);
        __syncthreads();
    }
    SEAM(2);

    PH(3) { if (rep_) grid.sync();
        {
            const float* st = (const float*)(ws + WS_STATE); bf16* hst = (bf16*)(ws + WS_HST); const float* dec = (const float*)(ws + WS_DEC);
            for (int e = bid * NTHR + tid; e < NBAT * 8 * 64 * 128; e += G * NTHR) {
                const int pn = e & 8191, h = (e >> 13) & 7, b = e >> 16;
                float hr = 0.f;
#pragma unroll 1
                for (int c0 = 0; c0 < 64; c0 += 32) {
                    float sv[32], dv[32];
#pragma unroll
                    for (int k = 0; k < 32; ++k) { sv[k] = st[((size_t)((b * 64 + c0 + k) * 8 + h)) * 8192 + pn]; dv[k] = dec[(b * 8 + h) * 64 + c0 + k]; }
#pragma unroll
                    for (int k = 0; k < 32; ++k) { hst[((size_t)((b * 64 + c0 + k) * 8 + h)) * 8192 + pn] = f2bf(hr); hr = hr * dv[k] + sv[k]; }
                }
                A.out[O_SSP + (size_t)(b * 8 + h) * 8192 + pn] = hr;
            }
        }
        dil_attn_phase(A, lds, tid, wave, lane);
    }
    SEAM(3);

    PH(4) { if (rep_) grid.sync();
        for (int u = bid; u < 256; u += G) ssd_pass2_unit(A, lds, u, tid, wave, lane);
        {
            const float* lse = (const float*)(ws + WS_LSE); const bf16* obr = (const bf16*)(ws + WS_OBR); bf16* mix = (bf16*)(ws + WS_MIX);
            for (int i0 = bid * NTHR + tid; i0 < MP * 64; i0 += 4 * G * NTHR) {
                float w0[4], w1[4], w2[4]; v4u a[4], b2[4], c2[4];
#pragma unroll
                for (int k = 0; k < 4; ++k) {
                    const int i = i0 + k * G * NTHR;
                    if (i < MP * 64) {
                        const int row = i >> 6, hc = i & 63, h = hc >> 3;
                        w0[k] = lse[(size_t)row * 8 + h]; w1[k] = lse[(size_t)MP * 8 + (size_t)row * 8 + h]; w2[k] = lse[(size_t)2 * MP * 8 + (size_t)row * 8 + h];
                        const size_t o = (size_t)row * 512 + hc * 8;
                        a[k] = *(const v4u*)(obr + o); b2[k] = *(const v4u*)(obr + (size_t)MP * 512 + o); c2[k] = *(const v4u*)(obr + (size_t)2 * MP * 512 + o);
                    }
                }
#pragma unroll
                for (int k = 0; k < 4; ++k) {
                    const int i = i0 + k * G * NTHR;
                    if (i < MP * 64) {
                        const int row = i >> 6, hc = i & 63;
                        const float m = fmaxf(w0[k], fmaxf(w1[k], w2[k]));
                        float e0 = __expf(w0[k] - m), e1 = __expf(w1[k] - m), e2 = __expf(w2[k] - m);
                        const float is = 1.f / (e0 + e1 + e2); e0 *= is; e1 *= is; e2 *= is;
                        v4u r;
                        r.x = pk2(e0 * bflo(a[k].x) + e1 * bflo(b2[k].x) + e2 * bflo(c2[k].x), e0 * bfhi(a[k].x) + e1 * bfhi(b2[k].x) + e2 * bfhi(c2[k].x));
                        r.y = pk2(e0 * bflo(a[k].y) + e1 * bflo(b2[k].y) + e2 * bflo(c2[k].y), e0 * bfhi(a[k].y) + e1 * bfhi(b2[k].y) + e2 * bfhi(c2[k].y));
                        r.z = pk2(e0 * bflo(a[k].z) + e1 * bflo(b2[k].z) + e2 * bflo(c2[k].z), e0 * bfhi(a[k].z) + e1 * bfhi(b2[k].z) + e2 * bfhi(c2[k].z));
                        r.w = pk2(e0 * bflo(a[k].w) + e1 * bflo(b2[k].w) + e2 * bflo(c2[k].w), e0 * bfhi(a[k].w) + e1 * bfhi(b2[k].w) + e2 * bfhi(c2[k].w));
                        *(v4u*)(mix + (size_t)row * 1024 + hc * 8) = r;
                    }
                }
            }
            const float* SY = (const float*)(ws + WS_SMISC) + 128 * 512 + 128 * 1024; const bf16* zb = (const bf16*)(ws + WS_ZB);
            for (int wu = bid * NWAVES + wave; wu < MS * 2; wu += G * NWAVES) {
                const int r = wu >> 1, g = wu & 1;
                const f32x4 y = *(const f32x4*)(SY + (size_t)r * 512 + g * 256 + 4 * lane);
                const v2u zz = *(const v2u*)(zb + (size_t)(MP + r) * 512 + g * 256 + 4 * lane);
                f32x4 uu = {y[0] * silu_f(bflo(zz.x)), y[1] * silu_f(bfhi(zz.x)), y[2] * silu_f(bflo(zz.y)), y[3] * silu_f(bfhi(zz.y))};
                const float s = wave_sum((uu[0] * uu[0] + uu[1] * uu[1]) + (uu[2] * uu[2] + uu[3] * uu[3]));
                const float rs = rsqrtf(s * (1.f / 256.f) + EPS);
                const f32x4 gg = *(const f32x4*)(A.in[16] + g * 256 + 4 * lane);
                v2u o; o.x = pk2(uu[0] * rs * gg[0], uu[1] * rs * gg[1]); o.y = pk2(uu[2] * rs * gg[2], uu[3] * rs * gg[3]);
                *(v2u*)(mix + (size_t)(MP + r) * 1024 + 512 + g * 256 + 4 * lane) = o;
            }
        }
    }
    SEAM(4);

    PH(5) { if (rep_) grid.sync();
        FRes<0> f{A.in[0], A.in[1], A.out, (bf16*)(ws + WS_XB), (float*)(ws + WS_SSQ1)};
        {
            pg8::Gemm g{(const pg8::bf16_t*)(ws + WS_MIX), (const pg8::bf16_t*)(ws + WS_WOUT), MP, DM, DM};
            pg8::StaticOrder S; S.init(MP, DM, G, bid);
            EpiWrap<FRes<0>> E{f};
            pg8::gemm_phase<EpiWrap<FRes<0>>, pg8::StaticOrder, true, true>(lds, g, S, E);
        }
        for (int u = bid; u < 8 * (DM / 32); u += G)
            small_gemm_unit<1>(lds, (const bf16*)(ws + WS_MIX) + (size_t)MP * DM + (size_t)(u & 7) * 16 * DM, MP + (u & 7) * 16, (const bf16*)(ws + WS_WOUT), DM, (u >> 3) * 32, f, wave, lane);
    }
    SEAM(5);

    PH(6) { if (rep_) grid.sync();
        FScale<0> f{(const float*)(ws + WS_SSQ1), (bf16*)(ws + WS_A0), DM, 0.0625f};
        {
            pg8::Gemm g{(const pg8::bf16_t*)(ws + WS_XB), (const pg8::bf16_t*)(ws + WS_WXQ), MP, DM, DM};
            pg8::StaticOrder S; S.init(MP, DM, G, bid);
            EpiWrap<FScale<0>> E{f};
            pg8::gemm_phase<EpiWrap<FScale<0>>, pg8::StaticOrder, true, true>(lds, g, S, E);
        }
        for (int u = bid; u < 8 * (DM / 32); u += G)
            small_gemm_unit<1>(lds, (const bf16*)(ws + WS_XB) + (size_t)MP * DM + (size_t)(u & 7) * 16 * DM, MP + (u & 7) * 16, (const bf16*)(ws + WS_WXQ), DM, (u >> 3) * 32, f, wave, lane);
    }
    SEAM(6);

    PH(7) { if (rep_) grid.sync();
        xattn_phase(A, lds, tid, wave, lane);
        for (int u = bid; u < SB * 4; u += G) sample_xattn_unit(A, lds, u, tid, wave, lane);
    }
    SEAM(7);

    PH(8) { if (rep_) grid.sync();
        FRes<1> f{nullptr, nullptr, A.out, (bf16*)(ws + WS_XB), (float*)(ws + WS_SSQ2)};
        {
            pg8::Gemm g{(const pg8::bf16_t*)(ws + WS_MIX), (const pg8::bf16_t*)(ws + WS_WXO), MP, DM, DM};
            pg8::StaticOrder S; S.init(MP, DM, G, bid);
            EpiWrap<FRes<1>> E{f};
            pg8::gemm_phase<EpiWrap<FRes<1>>, pg8::StaticOrder, true, true>(lds, g, S, E);
        }
        for (int u = bid; u < 8 * (DM / 32); u += G)
            small_gemm_unit<1>(lds, (const bf16*)(ws + WS_MIX) + (size_t)MP * DM + (size_t)(u & 7) * 16 * DM, MP + (u & 7) * 16, (const bf16*)(ws + WS_WXO), DM, (u >> 3) * 32, f, wave, lane);
    }
    SEAM(8);

    PH(9) { if (rep_) grid.sync();
        FScale<1> f{(const float*)(ws + WS_SSQ2), (bf16*)(ws + WS_U), DFF, 1.f};
        {
            pg8::Gemm g{(const pg8::bf16_t*)(ws + WS_XB), (const pg8::bf16_t*)(ws + WS_WUP), MP, DFF, DM};
            pg8::StaticOrder S; S.init(MP, DFF, G, bid);
            EpiWrap<FScale<1>> E{f};
            pg8::gemm_phase<EpiWrap<FScale<1>>, pg8::StaticOrder, true, true>(lds, g, S, E);
        }
        for (int u = bid; u < 2 * (DFF / 32); u += G)
            small_gemm_unit<4>(lds, (const bf16*)(ws + WS_XB) + (size_t)(MP + (u & 1) * 64) * DM, MP + (u & 1) * 64, (const bf16*)(ws + WS_WUP), DM, (u >> 1) * 32, f, wave, lane);
    }
    SEAM(9);

    PH(10) { if (rep_) grid.sync();
        FRes<1> f{nullptr, nullptr, A.out, (bf16*)(ws + WS_XB), (float*)(ws + WS_SSQ3)};
        {
            pg8::Gemm g{(const pg8::bf16_t*)(ws + WS_U), (const pg8::bf16_t*)(ws + WS_WDN), MP, DM, DFF};
            pg8::StaticOrder S; S.init(MP, DM, G, bid);
            EpiWrap<FRes<1>> E{f};
            pg8::gemm_phase<EpiWrap<FRes<1>>, pg8::StaticOrder, true, true>(lds, g, S, E);
        }
        for (int u = bid; u < 8 * (DM / 32); u += G)
            small_gemm_unit<1>(lds, (const bf16*)(ws + WS_U) + (size_t)MP * DFF + (size_t)(u & 7) * 16 * DFF, MP + (u & 7) * 16, (const bf16*)(ws + WS_WDN), DFF, (u >> 3) * 32, f, wave, lane);
    }
    SEAM(10);

    PH(11) { if (rep_) grid.sync();
        const float* ssq = (const float*)(ws + WS_SSQ3); const bf16* xb = (const bf16*)(ws + WS_XB);
        f32x4 gg[4];
#pragma unroll
        for (int j = 0; j < 4; ++j) gg[j] = *(const f32x4*)(A.in[27] + 4 * lane + 256 * j);
        const int r0 = bid * NWAVES + wave, rstep = G * NWAVES;
        v2u nv[4]; float nrs = 0.f;
        if (r0 < MT) {
            nrs = rstd_from(ssq, r0);
#pragma unroll
            for (int j = 0; j < 4; ++j) nv[j] = *(const v2u*)(xb + (size_t)r0 * DM + 4 * lane + 256 * j);
        }
        for (int row = r0; row < MT; row += rstep) {
            v2u v[4]; const float rs = nrs;
#pragma unroll
            for (int j = 0; j < 4; ++j) v[j] = nv[j];
            const int rn = row + rstep;
            if (rn < MT) {
                nrs = rstd_from(ssq, rn);
#pragma unroll
                for (int j = 0; j < 4; ++j) nv[j] = *(const v2u*)(xb + (size_t)rn * DM + 4 * lane + 256 * j);
            }
            float* y = (row < MP) ? A.out + O_YP + (size_t)row * DM : A.out + O_YS + (size_t)(row - MP) * DM;
#pragma unroll
            for (int j = 0; j < 4; ++j) *(f32x4*)(y + 4 * lane + 256 * j) = (f32x4){bflo(v[j].x), bfhi(v[j].x), bflo(v[j].y), bfhi(v[j].y)} * rs * gg[j];
        }
    }
#ifdef EXTRA_SYNCS
    if (hi == NPHASE && lo == 0) { for (int i = 0; i < EXTRA_SYNCS; ++i) grid.sync(); }
#endif
#undef IN
#undef SEAM
}

extern "C" void kernel_launch(void* const* d_in, const int* in_sizes, int n_in, void* d_out, int out_size, void* d_ws, size_t ws_size, hipStream_t stream) {
    static int grid = 0;
    if (grid == 0) {
        if (n_in != 28 || (size_t)out_size != O_END || ws_size < WS_END) { fprintf(stderr, "kernel_launch: unexpected shapes: n_in %d out %d ws %zu\n", n_in, out_size, ws_size); grid = -1; return; }
        int dev = 0, cus = 0, per_cu = 0;
        (void)hipGetDevice(&dev);
        (void)hipDeviceGetAttribute(&cus, hipDeviceAttributeMultiprocessorCount, dev);
        if (hipFuncSetAttribute((const void*)mega_fwd, hipFuncAttributeMaxDynamicSharedMemorySize, LDS_BYTES) != hipSuccess) { fprintf(stderr, "kernel_launch: hipFuncSetAttribute failed\n"); grid = -1; return; }
        if (hipOccupancyMaxActiveBlocksPerMultiprocessor(&per_cu, (const void*)mega_fwd, NTHR, LDS_BYTES) != hipSuccess || per_cu < 1) { fprintf(stderr, "kernel_launch: occupancy query says %d\n", per_cu); (void)hipGetLastError(); per_cu = 1; }
        grid = cus * 1;
        if (grid <= 0) grid = 256;
    }
    if (grid < 0) return;
    Args a{};
    for (int i = 0; i < 28; ++i) a.in[i] = (const float*)d_in[i];
    a.out = (float*)d_out; a.ws = (unsigned char*)d_ws;
    auto launch = [&](int lo, int hi) {
        a.ph_lo = lo; a.ph_hi = hi;
        (void)hipMemsetAsync(d_ws, 0, XCD_BAR_WORDS * 4, stream);
        void* args[] = {&a};
        hipError_t e = hipLaunchCooperativeKernel((const void*)mega_fwd, dim3(grid), dim3(NTHR), args, LDS_BYTES, stream);
        if (e != hipSuccess) fprintf(stderr, "kernel_launch: cooperative launch failed: %s (grid %d)\n", hipGetErrorString(e), grid);
    };
#if defined(PROBE_PHASE)
    launch(0, PROBE_PHASE + 1); launch(PROBE_PHASE, PROBE_PHASE + 1); if (PROBE_PHASE + 1 < NPHASE) launch(PROBE_PHASE + 1, NPHASE);
#elif N_LAUNCHES == 1
    launch(0, NPHASE);
#else
    for (int p = 0; p < NPHASE; ++p) launch(p, p + 1);
#endif
}
```

```cpp
#include <hip/hip_runtime.h>
#include <hip/hip_cooperative_groups.h>
#include <cstdio>
#include <cstdint>
namespace cg = cooperative_groups;
#define N_LAUNCHES 1
namespace pg8 {
#define PG8_LAS __attribute__((address_space(3)))
typedef unsigned short bf16_t;
typedef short bf16x8 __attribute__((ext_vector_type(8)));
typedef float f32x4 __attribute__((ext_vector_type(4)));
typedef unsigned u32x4 __attribute__((ext_vector_type(4)));
constexpr int BM = 256, BK = 64, HALF = 128, HTB = HALF * BK * 2  , STAGE_BYTES = 8 * HTB, NXCD = 8, WGM = 8;

__host__ __device__ __forceinline__ int lds_byte(int r, int c) { const int st = (r >> 4) * 2 + (c >> 5), rr = r & 15, cc = c & 31, ob = rr * 64 + cc * 2; return st * 1024 + (ob ^ (((ob >> 9) & 1) << 5)); }
__host__ __device__ __forceinline__ void stage_rc(int b, int& R, int& C) { const int st = b / 1024, sb = b % 1024, swz = sb ^ (((sb >> 9) & 1) << 5); R = (st >> 1) * 16 + swz / 64; C = (st & 1) * 32 + (swz % 64) / 2; }
__host__ __device__ __forceinline__ int perm32(int rho) { const int n = rho >> 4, i = rho & 15; return 8 * (i >> 2) + 4 * n + (i & 3); }

struct Unit { int pm, pn; };
struct Gemm { const bf16_t* A; const bf16_t* Bt; int M, N, K; };

struct StaticOrder {
    int nM, nN, nwg, G, c;
    __host__ __device__ void init(int M, int N, int G_, int c_) { nM = M / BM; nN = N / BM; nwg = nM * nN; G = G_; c = c_; }
    __host__ __device__ bool next(int i, Unit& u) const {
        const long L = (long)i * G + c; if (L >= nwg) return false;
        int wgid = (int)L; { const int q = nwg / NXCD, r = nwg % NXCD, xcd = wgid % NXCD, off = wgid / NXCD; wgid = (xcd < r ? xcd * (q + 1) : r * (q + 1) + (xcd - r) * q) + off; }
        const int nig = WGM * nN, gid = wgid / nig, fm = gid * WGM, gsz = (nM - fm) < WGM ? (nM - fm) : WGM;
        u.pm = fm + ((wgid % nig) % gsz); u.pn = (wgid % nig) / gsz; return true;
    }
    __device__ __forceinline__ void a_ready(const Unit&) const {}
    __device__ __forceinline__ void done(const Unit&) const {}
};
__device__ __forceinline__ unsigned cvt_pk_bf16(float lo, float hi) { unsigned r; asm volatile("v_cvt_pk_bf16_f32 %0, %1, %2" : "=v"(r) : "v"(lo), "v"(hi)); return r; }
template <class Epi, class Sched, bool ALIGN_EPI = false, bool SP2 = false>
__device__ __forceinline__ void gemm_phase(PG8_LAS unsigned char* lds, const Gemm g, const Sched& S, const Epi& E) {
    const int tid = threadIdx.x, wid = __builtin_amdgcn_readfirstlane(tid >> 6), lane = tid & 63, wr = wid >> 2, wc = wid & 3, fr = lane & 15, fq = lane >> 4;
    const int K = g.K, nt = K / BK;
    unsigned voffA[2], voffB[2];
#pragma unroll
    for (int i = 0; i < 2; ++i) { int R, C; stage_rc(tid * 16 + i * 8192, R, C); const int Rb = Epi::PERM ? ((R & ~31) + perm32(R & 31)) : R;
        voffA[i] = (unsigned)(R * K + C) * 2u; voffB[i] = (unsigned)(Rb * K + C) * 2u; }
    const size_t kstep = (size_t)(BK * 2);
    const size_t hstep = (size_t)HALF * K * 2;
    const size_t tstep = 2 * hstep;
    const unsigned ldsw = (unsigned)wid * 1024u;
    const int aoff = lds_byte(wr * 64 + fr, fq * 8), boff = lds_byte(wc * 32 + fr, fq * 8);
#define PG8_SA(b, h) (((b) * 2 + (h)) * HTB)
#define PG8_SB(b, h) ((4 + (b) * 2 + (h)) * HTB)
#define PG8_STAGE(bufoff, gbase, voff) do { _Pragma("unroll") for (int _i = 0; _i < 2; ++_i) \
        __builtin_amdgcn_global_load_lds((const unsigned*)((const char*)(gbase) + (voff)[_i]), (PG8_LAS unsigned*)(lds + (bufoff) + ldsw + _i * 8192), 16, 0, 0); } while (0)
#define PG8_LDA(dst, b, h) do { _Pragma("unroll") for (int m = 0; m < 4; ++m) _Pragma("unroll") for (int k = 0; k < 2; ++k) dst[m][k] = *(const PG8_LAS bf16x8*)(lds + PG8_SA(b, h) + aoff + m * 2048 + k * 1024); } while (0)
#define PG8_LDB(dst, b, h) do { _Pragma("unroll") for (int n = 0; n < 2; ++n) _Pragma("unroll") for (int k = 0; k < 2; ++k) dst[n][k] = *(const PG8_LAS bf16x8*)(lds + PG8_SB(b, h) + boff + n * 2048 + k * 1024); } while (0)
#define PG8_MMA(ai, bj, At, Bt) do { __builtin_amdgcn_s_setprio(1); _Pragma("unroll") for (int m = 0; m < 4; ++m) _Pragma("unroll") for (int n = 0; n < 2; ++n) _Pragma("unroll") for (int k = 0; k < 2; ++k) \
        acc[ai][bj][m][n] = __builtin_amdgcn_mfma_f32_16x16x32_bf16(Bt[n][k], At[m][k], acc[ai][bj][m][n], 0, 0, 0); __builtin_amdgcn_s_setprio(0); } while (0)
#define PG8_WAIT_V(n) asm volatile("s_waitcnt vmcnt(" #n ")" ::: "memory")
#define PG8_WAIT_L(n) asm volatile("s_waitcnt lgkmcnt(" #n ")" ::: "memory")
#define PG8_BAR __builtin_amdgcn_s_barrier()
#define PG8_SCHED __builtin_amdgcn_sched_barrier(0)
    Unit cur, nxt; int ui = 0;
    if (!S.next(0, cur)) return;
    f32x4 acc[2][2][4][2];
#pragma unroll
    for (int a = 0; a < 2; ++a)
#pragma unroll
        for (int b = 0; b < 2; ++b)
#pragma unroll
            for (int m = 0; m < 4; ++m)
#pragma unroll
                for (int n = 0; n < 2; ++n) acc[a][b][m][n] = (f32x4){0.f, 0.f, 0.f, 0.f};
    bf16x8 At[4][2], B0[2][2], B1[2][2];
    const char* cA = (const char*)g.A + (size_t)cur.pm * tstep; const char* cB = (const char*)g.Bt + (size_t)cur.pn * tstep;
    S.a_ready(cur);
    if constexpr (SP2) {
        PG8_STAGE(PG8_SB(0, 0), cB, voffB); PG8_STAGE(PG8_SB(0, 1), cB + hstep, voffB); PG8_STAGE(PG8_SA(0, 0), cA, voffA); PG8_STAGE(PG8_SA(0, 1), cA + hstep, voffA);
        if (wr == 1) PG8_BAR;
        PG8_WAIT_V(2); PG8_BAR;
        PG8_STAGE(PG8_SB(1, 0), cB + kstep, voffB); PG8_STAGE(PG8_SA(1, 0), cA + kstep, voffA); PG8_STAGE(PG8_SB(1, 1), cB + hstep + kstep, voffB);
        PG8_WAIT_V(6); PG8_BAR;
    } else {
        PG8_STAGE(PG8_SB(0, 0), cB, voffB); PG8_STAGE(PG8_SA(0, 0), cA, voffA); PG8_STAGE(PG8_SB(0, 1), cB + hstep, voffB); PG8_STAGE(PG8_SA(0, 1), cA + hstep, voffA);
        if (wr == 1) PG8_BAR;
        PG8_WAIT_V(4); PG8_BAR;
        PG8_STAGE(PG8_SB(1, 0), cB + kstep, voffB); PG8_STAGE(PG8_SA(1, 0), cA + kstep, voffA); PG8_STAGE(PG8_SB(1, 1), cB + hstep + kstep, voffB);
        PG8_WAIT_V(6); PG8_BAR;
    }
    for (;;) {
        const bool has_next = S.next(ui + 1, nxt);
        const char* nA = has_next ? (const char*)g.A + (size_t)nxt.pm * tstep : cA; const char* nB = has_next ? (const char*)g.Bt + (size_t)nxt.pn * tstep : cB;
        for (int t = 0; t < nt; t += 2) {
            const bool last = (t == nt - 2);
            const char* a1 = cA + (size_t)(t + 1) * kstep;
            const char* a2 = last ? nA : cA + (size_t)(t + 2) * kstep; const char* b2 = last ? nB : cB + (size_t)(t + 2) * kstep;
            const char* a3 = a2 + kstep; const char* b3 = b2 + kstep;
            if (last && has_next) S.a_ready(nxt);
            if constexpr (SP2) {
            PG8_LDB(B0, 0, 0); PG8_LDB(B1, 0, 1); PG8_SCHED; PG8_LDA(At, 0, 0); PG8_STAGE(PG8_SA(1, 1), a1 + hstep, voffA);
            PG8_WAIT_V(8); PG8_WAIT_L(0); PG8_BAR; PG8_MMA(0, 0, At, B0); PG8_MMA(0, 1, At, B1); PG8_BAR; PG8_SCHED;
            PG8_LDA(At, 0, 1); PG8_STAGE(PG8_SB(0, 0), b2, voffB); PG8_STAGE(PG8_SB(0, 1), b2 + hstep, voffB); PG8_STAGE(PG8_SA(0, 0), a2, voffA);
            PG8_WAIT_V(8); PG8_WAIT_L(0); PG8_BAR; PG8_MMA(1, 0, At, B0); PG8_MMA(1, 1, At, B1); PG8_BAR; PG8_SCHED;
            PG8_LDB(B0, 1, 0); PG8_LDB(B1, 1, 1); PG8_SCHED; PG8_LDA(At, 1, 0); PG8_STAGE(PG8_SA(0, 1), a2 + hstep, voffA);
            PG8_WAIT_V(8); PG8_WAIT_L(0); PG8_BAR; PG8_MMA(0, 0, At, B0); PG8_MMA(0, 1, At, B1); PG8_BAR; PG8_SCHED;
            PG8_LDA(At, 1, 1); PG8_STAGE(PG8_SB(1, 0), b3, voffB); PG8_STAGE(PG8_SB(1, 1), b3 + hstep, voffB); PG8_STAGE(PG8_SA(1, 0), a3, voffA);
            PG8_WAIT_V(8); PG8_WAIT_L(0); PG8_BAR; PG8_MMA(1, 0, At, B0); PG8_MMA(1, 1, At, B1); PG8_BAR; PG8_SCHED;
            } else {
            PG8_LDB(B0, 0, 0); PG8_SCHED; PG8_LDA(At, 0, 0); PG8_STAGE(PG8_SA(1, 1), a1 + hstep, voffA);
            PG8_WAIT_L(8); PG8_BAR; PG8_WAIT_L(0); PG8_MMA(0, 0, At, B0); PG8_BAR; PG8_SCHED;
            PG8_LDB(B1, 0, 1); PG8_STAGE(PG8_SB(0, 0), b2, voffB);
            PG8_BAR; PG8_WAIT_L(0); PG8_MMA(0, 1, At, B1); PG8_BAR;
            PG8_LDA(At, 0, 1); PG8_STAGE(PG8_SA(0, 0), a2, voffA);
            PG8_BAR; PG8_WAIT_L(0); PG8_MMA(1, 0, At, B0); PG8_BAR; PG8_SCHED;
            PG8_STAGE(PG8_SB(0, 1), b2 + hstep, voffB);
            PG8_WAIT_V(6); PG8_BAR; PG8_MMA(1, 1, At, B1); PG8_BAR;
            PG8_LDB(B0, 1, 0); PG8_SCHED; PG8_LDA(At, 1, 0); PG8_STAGE(PG8_SA(0, 1), a2 + hstep, voffA);
            PG8_WAIT_L(8); PG8_BAR; PG8_WAIT_L(0); PG8_MMA(0, 0, At, B0); PG8_BAR; PG8_SCHED;
            PG8_LDB(B1, 1, 1); PG8_STAGE(PG8_SB(1, 0), b3, voffB);
            PG8_BAR; PG8_WAIT_L(0); PG8_MMA(0, 1, At, B1); PG8_BAR;
            PG8_LDA(At, 1, 1); PG8_STAGE(PG8_SA(1, 0), a3, voffA);
            PG8_BAR; PG8_WAIT_L(0); PG8_MMA(1, 0, At, B0); PG8_BAR; PG8_SCHED;
            PG8_STAGE(PG8_SB(1, 1), b3 + hstep, voffB);
            PG8_WAIT_V(6); PG8_BAR; PG8_MMA(1, 1, At, B1); PG8_BAR;
            }
        }
        if constexpr (ALIGN_EPI) { if (wr == 0) PG8_BAR; }
        if constexpr (!Epi::AFTER_DRAIN) { E(acc, cur, wr, wc, fr, fq); S.done(cur); }
        if (!has_next) break;
#pragma unroll
        for (int a = 0; a < 2; ++a)
#pragma unroll
            for (int b = 0; b < 2; ++b)
#pragma unroll
                for (int m = 0; m < 4; ++m)
#pragma unroll
                    for (int n = 0; n < 2; ++n) acc[a][b][m][n] = (f32x4){0.f, 0.f, 0.f, 0.f};
        cur = nxt; cA = nA; cB = nB; ++ui;
        if constexpr (ALIGN_EPI) { if (wr == 1) PG8_BAR; }
    }
    PG8_WAIT_V(0);
    if constexpr (!ALIGN_EPI) { if (wr == 0) PG8_BAR; }
    PG8_BAR;
    if constexpr (Epi::AFTER_DRAIN) { E.fused(acc, cur, wr, wc, fr, fq, lds, wid, lane); S.done(cur); }
#undef PG8_SA
#undef PG8_SB
#undef PG8_STAGE
#undef PG8_LDA
#undef PG8_LDB
#undef PG8_MMA
#undef PG8_WAIT_V
#undef PG8_WAIT_L
#undef PG8_BAR
#undef PG8_SCHED
}
}

#define LAS __attribute__((address_space(3)))
typedef unsigned short bf16;
typedef unsigned v4u __attribute__((ext_vector_type(4)));
typedef unsigned v2u __attribute__((ext_vector_type(2)));
typedef float f32x4 __attribute__((ext_vector_type(4)));
typedef short bf16x8 __attribute__((ext_vector_type(8)));
#define LDS_WAIT() asm volatile("s_waitcnt lgkmcnt(0)" ::: "memory")
__device__ __forceinline__ unsigned pk2(float lo, float hi) { return pg8::cvt_pk_bf16(lo, hi); }
__device__ __forceinline__ bf16 f2bf(float f) { return (bf16)(pg8::cvt_pk_bf16(f, 0.f) & 0xffffu); }
__device__ __forceinline__ float bf2f(unsigned b) { return __uint_as_float((b & 0xffffu) << 16); }
__device__ __forceinline__ float bflo(unsigned w) { return __uint_as_float(w << 16); }
__device__ __forceinline__ float bfhi(unsigned w) { return __uint_as_float(w & 0xffff0000u); }
__device__ __forceinline__ float wave_sum(float v) {
#pragma unroll
    for (int o = 1; o < 64; o <<= 1) v += __shfl_xor(v, o);
    return v;
}
__device__ __forceinline__ float wave_max(float v) {
#pragma unroll
    for (int o = 1; o < 64; o <<= 1) v = fmaxf(v, __shfl_xor(v, o));
    return v;
}
__device__ __forceinline__ float sum16(float v) { v += __shfl_xor(v, 1); v += __shfl_xor(v, 2); v += __shfl_xor(v, 4); v += __shfl_xor(v, 8); return v; }
__device__ __forceinline__ float max16(float v) { v = fmaxf(v, __shfl_xor(v, 1)); v = fmaxf(v, __shfl_xor(v, 2)); v = fmaxf(v, __shfl_xor(v, 4)); v = fmaxf(v, __shfl_xor(v, 8)); return v; }
__device__ __forceinline__ float silu_f(float v) { return v / (1.f + __expf(-v)); }
__device__ __forceinline__ float softplus_f(float x) { return fmaxf(x, 0.f) + log1pf(__expf(-fabsf(x))); }
__device__ __forceinline__ f32x4 mfma16(bf16x8 a, bf16x8 b, f32x4 c) { return __builtin_amdgcn_mfma_f32_16x16x32_bf16(a, b, c, 0, 0, 0); }

#define XB_TMO      128
#define XB_XCNT(j)  (256  + 64 * (j))
#define XB_XSUB(j)  (1280 + 64 * (j))
#define XB_XGEN(j)  (2304 + 64 * (j))
#define XB_TOP      3328
#define XB_TOPGEN   3392
#define XCD_BAR_WORDS 3456
#define XB_SPIN_CAP (1u << 18)

__device__ __forceinline__ unsigned xb_ld(unsigned* p)              { return __hip_atomic_load(p, __ATOMIC_RELAXED, __HIP_MEMORY_SCOPE_AGENT); }
__device__ __forceinline__ unsigned xb_add(unsigned* p, unsigned v) { return __hip_atomic_fetch_add(p, v, __ATOMIC_RELAXED, __HIP_MEMORY_SCOPE_AGENT); }
__device__ __forceinline__ unsigned xb_xcc_id() { return (unsigned)__builtin_amdgcn_s_getreg((3 << 11) | 20) & 0xFu; }
#define XB_SPIN(cond, bar) do { unsigned _sp = 0; while (cond) { __builtin_amdgcn_s_sleep(1); \
    if ((++_sp & 255u) == 0u) { if (xb_ld(&(bar)[XB_TMO])) break; if (_sp > XB_SPIN_CAP) { atomicAdd(&(bar)[XB_TMO], 1u); break; } } } } while (0)

struct XcdBarrier {
    unsigned* bar; unsigned x;
    volatile LAS unsigned* st;
};

__device__ __forceinline__ XcdBarrier xcd_barrier_post(unsigned* bar, volatile LAS unsigned* st) {
    XcdBarrier b; b.bar = bar; b.x = xb_xcc_id(); b.st = st;
    if (threadIdx.x == 0) (void)xb_add(&bar[XB_XCNT(b.x)], 1u);
    return b;
}
__device__ __forceinline__ void xcd_barrier_complete(unsigned* bar, unsigned x, unsigned& nloc, unsigned& nx) {
    const unsigned G = gridDim.x * gridDim.y * gridDim.z;
    unsigned sum, cnt, mine, sp = 0u;
    for (;;) {
        sum = 0u; cnt = 0u; mine = 0u;
#pragma unroll
        for (unsigned j = 0; j < 16; ++j) { const unsigned c = xb_ld(&bar[XB_XCNT(j)]); sum += c; cnt += (c > 0u) ? 1u : 0u; mine = (j == x) ? c : mine; }
        if (sum == G) break;
        __builtin_amdgcn_s_sleep(1);
        if ((++sp & 255u) == 0u) { if (xb_ld(&bar[XB_TMO])) break; if (sp > XB_SPIN_CAP) { atomicAdd(&bar[XB_TMO], 1u); break; } }
    }
    nloc = mine > 0u ? mine : 1u; nx = cnt > 0u ? cnt : 1u;
}

__device__ __forceinline__ void xcd_barrier(const XcdBarrier& b) {
    asm volatile("s_waitcnt vmcnt(0)" ::: "memory");
    __syncthreads();
    if (threadIdx.x == 0) {
        unsigned* bar = b.bar;
        __builtin_amdgcn_s_waitcnt(0);
        unsigned nloc = b.st[0], nx = b.st[1];
        if (nloc == 0u) { xcd_barrier_complete(bar, b.x, nloc, nx); b.st[0] = nloc; b.st[1] = nx; }
        const unsigned old = xb_add(&bar[XB_XSUB(b.x)], 1u);
        const unsigned gen = old / nloc;
        if (old + 1u == (gen + 1u) * nloc) {
            __builtin_amdgcn_fence(__ATOMIC_RELEASE, "agent");
            asm volatile("s_waitcnt vmcnt(0)" ::: "memory");
            const unsigned og = xb_add(&bar[XB_TOP], 1u);
            const unsigned tg = og / nx;
            if (og + 1u == (tg + 1u) * nx) xb_add(&bar[XB_TOPGEN], 1u);
            else XB_SPIN(xb_ld(&bar[XB_TOPGEN]) == tg, bar);
            __builtin_amdgcn_fence(__ATOMIC_ACQUIRE, "agent");
            xb_add(&bar[XB_XGEN(b.x)], 1u);
            asm volatile("s_waitcnt vmcnt(0)" ::: "memory");
        } else {
            XB_SPIN(xb_ld(&bar[XB_XGEN(b.x)]) == gen, bar);
            __builtin_amdgcn_fence(__ATOMIC_ACQUIRE, "agent");
            asm volatile("s_waitcnt vmcnt(0)" ::: "memory");
        }
    }
    __syncthreads();
}

constexpr int DM = 1024, SEQ = 8192, NBAT = 2, MP = NBAT * SEQ, SB = 32, ST = 4, MS = SB * ST, MT = MP + MS;
constexpr int NIN = 3072, INW = 3080, DFF = 4096, NMEM = 256, LW = 2048;
constexpr float EPS = 1e-6f;
constexpr int NWAVES = 8, NTHR = 512;
constexpr int LDS_BYTES = 147456;

constexpr size_t O_YP = 0, O_YS = O_YP + (size_t)MP * DM, O_WKP = O_YS + (size_t)MS * DM, O_WVP = O_WKP + (size_t)NBAT * LW * 512,
    O_CVP = O_WVP + (size_t)NBAT * LW * 512, O_SSP = O_CVP + (size_t)NBAT * 3 * 1024, O_MKP = O_SSP + (size_t)NBAT * 8 * 64 * 128,
    O_MVP = O_MKP + (size_t)NBAT * NMEM * 1024, O_WKS = O_MVP + (size_t)NBAT * NMEM * 1024, O_WVS = O_WKS + (size_t)SB * LW * 512,
    O_CVS = O_WVS + (size_t)SB * LW * 512, O_SSS = O_CVS + (size_t)SB * 3 * 1024, O_END = O_SSS + (size_t)SB * 8 * 64 * 128;

constexpr size_t MiB = 1u << 20;
constexpr size_t WS_WIN = 1 * MiB, WS_WOUT = 7 * MiB, WS_WXQ = 9 * MiB, WS_WMKV = 11 * MiB, WS_WXO = 15 * MiB, WS_WUP = 17 * MiB, WS_WDN = 25 * MiB;
constexpr size_t WS_COS = 33 * MiB, WS_SIN = 35 * MiB, WS_AM = 37 * MiB, WS_DT = 38 * MiB, WS_MKB = 39 * MiB, WS_MVB = 40 * MiB;
constexpr size_t WS_SSQ1 = 41 * MiB, WS_SSQ2 = 43 * MiB + 256 * 1024, WS_SSQ3 = 45 * MiB + 512 * 1024;
constexpr size_t WS_A0 = 48 * MiB;
constexpr size_t WS_MIX = 81 * MiB;
constexpr size_t WS_X = 114 * MiB;
constexpr size_t WS_XB = 179 * MiB;
constexpr size_t WS_QB = 212 * MiB, WS_KB = 229 * MiB, WS_VB = 246 * MiB, WS_ZB = 263 * MiB;
constexpr size_t WS_XBC = 280 * MiB;
constexpr size_t WS_OBR = 313 * MiB;
constexpr size_t WS_LSE = 361 * MiB;
constexpr size_t WS_STATE = 363 * MiB;
constexpr size_t WS_HST = 395 * MiB;
constexpr size_t WS_DEC = 411 * MiB;
constexpr size_t WS_SMISC = 412 * MiB;
constexpr size_t WS_XC = 413 * MiB;
constexpr size_t WS_U = 212 * MiB;
constexpr size_t WS_END = 446 * MiB;

struct Args { const float* in[28]; float* out; unsigned char* ws; int ph_lo, ph_hi; };

template <class F> struct EpiWrap {
    static constexpr bool PERM = true, AFTER_DRAIN = false;
    F f;
    __device__ __forceinline__ void operator()(const pg8::f32x4 (&acc)[2][2][4][2], const pg8::Unit& u, int wr, int wc, int fr, int fq) const {
#pragma unroll
        for (int ai = 0; ai < 2; ++ai) {
            float rs[4]; typename F::Pre pre[4][2];
#pragma unroll
            for (int m = 0; m < 4; ++m) {
                const int row = u.pm * 256 + ai * 128 + wr * 64 + m * 16 + fr;
                rs[m] = f.rowscale(row);
#pragma unroll
                for (int bj = 0; bj < 2; ++bj) pre[m][bj] = f.pre(row, u.pn * 256 + bj * 128 + wc * 32 + 8 * fq);
            }
#pragma unroll
            for (int m = 0; m < 4; ++m) {
                const int row = u.pm * 256 + ai * 128 + wr * 64 + m * 16 + fr;
#pragma unroll
                for (int bj = 0; bj < 2; ++bj) f.apply(row, u.pn * 256 + bj * 128 + wc * 32 + 8 * fq, acc[ai][bj][m][0], acc[ai][bj][m][1], rs[m], pre[m][bj]);
            }
        }
    }
};
struct NoPre {};

template <int RB, class F> __device__ __forceinline__ void small_gemm_unit(LAS unsigned char* lds, const bf16* A, int rowg0, const bf16* Bt, int K, int col0, const F& f, int wave, int lane) {
    const int fr = lane & 15, fq = lane >> 4;
    const int kw = K >> 3;
    const bf16* ap = A + (size_t)fr * K + wave * kw + 8 * fq;
    const bf16* bp0 = Bt + (size_t)(col0 + pg8::perm32(fr)) * K + wave * kw + 8 * fq;
    const bf16* bp1 = Bt + (size_t)(col0 + pg8::perm32(16 + fr)) * K + wave * kw + 8 * fq;
    f32x4 acc[RB][2];
#pragma unroll
    for (int rb = 0; rb < RB; ++rb) { acc[rb][0] = (f32x4){0.f, 0.f, 0.f, 0.f}; acc[rb][1] = (f32x4){0.f, 0.f, 0.f, 0.f}; }
#pragma unroll(RB == 1 ? 8 : 2)
    for (int k0 = 0; k0 < kw; k0 += 32) {
        const bf16x8 b0 = *(const bf16x8*)(bp0 + k0), b1 = *(const bf16x8*)(bp1 + k0);
        bf16x8 a[RB];
#pragma unroll
        for (int rb = 0; rb < RB; ++rb) a[rb] = *(const bf16x8*)(ap + (size_t)rb * 16 * K + k0);
#pragma unroll
        for (int rb = 0; rb < RB; ++rb) { acc[rb][0] = mfma16(b0, a[rb], acc[rb][0]); acc[rb][1] = mfma16(b1, a[rb], acc[rb][1]); }
    }
#pragma unroll
    for (int rb = 0; rb < RB; ++rb) {
        *(LAS f32x4*)(lds + ((wave * RB + rb) * 2 + 0) * 1024 + lane * 16) = acc[rb][0];
        *(LAS f32x4*)(lds + ((wave * RB + rb) * 2 + 1) * 1024 + lane * 16) = acc[rb][1];
    }
    LDS_WAIT(); __builtin_amdgcn_s_barrier(); asm volatile("" ::: "memory");
    if (wave < RB) {
        f32x4 c0 = {0.f, 0.f, 0.f, 0.f}, c1 = {0.f, 0.f, 0.f, 0.f};
#pragma unroll
        for (int w2 = 0; w2 < 8; ++w2) {
            c0 = c0 + *(const LAS f32x4*)(lds + ((w2 * RB + wave) * 2 + 0) * 1024 + lane * 16);
            c1 = c1 + *(const LAS f32x4*)(lds + ((w2 * RB + wave) * 2 + 1) * 1024 + lane * 16);
        }
        const int row = rowg0 + wave * 16 + fr;
        const float rs = f.rowscale(row);
        const typename F::Pre pre = f.pre(row, col0 + 8 * fq);
        f.apply(row, col0 + 8 * fq, c0, c1, rs, pre);
    }
    LDS_WAIT(); __builtin_amdgcn_s_barrier(); asm volatile("" ::: "memory");
}

__device__ __forceinline__ v4u pack8(f32x4 v0, f32x4 v1) { v4u w; w.x = pk2(v0[0], v0[1]); w.y = pk2(v0[2], v0[3]); w.z = pk2(v1[0], v1[1]); w.w = pk2(v1[2], v1[3]); return w; }

struct F1 {
    bf16 *Qb, *Kb, *Vb, *Zb, *XBCb; float* out; float *SQ, *SXBC; const float *cosT, *sinT;
    typedef NoPre Pre;
    __device__ __forceinline__ float rowscale(int) const { return 1.f; }
    __device__ __forceinline__ Pre pre(int, int) const { return Pre{}; }
    __device__ __forceinline__ void apply(int row, int col, f32x4 v0, f32x4 v1, float, const Pre&) const {
        const bool samp = row >= MP;
        int b, t, pos;
        if (!samp) { b = row >> 13; t = row & 8191; pos = t; } else { b = (row - MP) >> 2; t = (row - MP) & 3; pos = SEQ + t; }
        if (col < 1024) {
            const int isk = col >> 9, c = col & 511, hd = c >> 6, i0 = (c & 63) >> 1;
            const f32x4 cs = *(const f32x4*)(cosT + pos * 32 + i0), sn = *(const f32x4*)(sinT + pos * 32 + i0);
            const f32x4 t1 = {v0[0], v0[2], v1[0], v1[2]}, t2 = {v0[1], v0[3], v1[1], v1[3]};
            const f32x4 a = t1 * cs - t2 * sn, bb = t2 * cs + t1 * sn;
            v4u w; w.x = pk2(a[0], bb[0]); w.y = pk2(a[1], bb[1]); w.z = pk2(a[2], bb[2]); w.w = pk2(a[3], bb[3]);
            *(v4u*)((isk ? Kb : Qb) + (size_t)row * 512 + c) = w;
            float* o = nullptr;
            if (isk) {
                if (!samp) { if (t >= SEQ - LW) o = out + O_WKP + ((size_t)(b * LW + t - (SEQ - LW)) * 512 + hd * 64); }
                else o = out + O_WKS + ((size_t)(b * LW + LW - ST + t) * 512 + hd * 64);
            } else if (samp) o = SQ + (size_t)(row - MP) * 512 + hd * 64;
            if (o) { *(f32x4*)(o + i0) = a; *(f32x4*)(o + 32 + i0) = bb; }
        } else if (col < 1536) {
            const int c = col - 1024;
            *(v4u*)(Vb + (size_t)row * 512 + c) = pack8(v0, v1);
            float* o = nullptr;
            if (!samp) { if (t >= SEQ - LW) o = out + O_WVP + ((size_t)(b * LW + t - (SEQ - LW)) * 512 + c); }
            else o = out + O_WVS + ((size_t)(b * LW + LW - ST + t) * 512 + c);
            if (o) { *(f32x4*)o = v0; *(f32x4*)(o + 4) = v1; }
        } else if (col < 2048) {
            *(v4u*)(Zb + (size_t)row * 512 + (col - 1536)) = pack8(v0, v1);
        } else {
            const int c = col - 2048;
            *(v4u*)(XBCb + (size_t)row * 1024 + c) = pack8(v0, v1);
            if (!samp) { if (t >= SEQ - 3) { float* o = out + O_CVP + (size_t)(b * 3 + t - (SEQ - 3)) * 1024 + c; *(f32x4*)o = v0; *(f32x4*)(o + 4) = v1; } }
            else {
                float* o = SXBC + (size_t)(row - MP) * 1024 + c; *(f32x4*)o = v0; *(f32x4*)(o + 4) = v1;
                if (t >= 1) { float* o2 = out + O_CVS + (size_t)(b * 3 + t - 1) * 1024 + c; *(f32x4*)o2 = v0; *(f32x4*)(o2 + 4) = v1; }
            }
        }
    }
};
struct FMem {
    float* out; bf16 *MKb, *MVb;
    typedef NoPre Pre;
    __device__ __forceinline__ float rowscale(int) const { return 1.f; }
    __device__ __forceinline__ Pre pre(int, int) const { return Pre{}; }
    __device__ __forceinline__ void apply(int row, int col, f32x4 v0, f32x4 v1, float, const Pre&) const {
        const int isv = col >> 10, c = col & 1023;
        float* o = out + (isv ? O_MVP : O_MKP) + (size_t)row * 1024 + c; *(f32x4*)o = v0; *(f32x4*)(o + 4) = v1;
        *(v4u*)((isv ? MVb : MKb) + (size_t)row * 1024 + c) = pack8(v0, v1);
    }
};
template <int MODE  > struct FRes {
    const float *xp, *xs; float* out; bf16* Xb; float* ssq;
    struct Pre { f32x4 r0, r1; };
    __device__ __forceinline__ float rowscale(int) const { return 1.f; }
    __device__ __forceinline__ Pre pre(int row, int col) const {
        Pre p;
        if (MODE == 0) { const float* r = (row < MP) ? xp + (size_t)row * DM : xs + (size_t)(row - MP) * DM; p.r0 = *(const f32x4*)(r + col); p.r1 = *(const f32x4*)(r + col + 4); }
        else { const v4u w = *(const v4u*)(Xb + (size_t)row * DM + col); p.r0 = (f32x4){bflo(w.x), bfhi(w.x), bflo(w.y), bfhi(w.y)}; p.r1 = (f32x4){bflo(w.z), bfhi(w.z), bflo(w.w), bfhi(w.w)}; }
        return p;
    }
    __device__ __forceinline__ void apply(int row, int col, f32x4 v0, f32x4 v1, float, const Pre& pr) const {
        v0 = v0 + pr.r0; v1 = v1 + pr.r1;
        if (MODE == 2) { float* d = (row < MP) ? out + O_YP + (size_t)row * DM : out + O_YS + (size_t)(row - MP) * DM; *(f32x4*)(d + col) = v0; *(f32x4*)(d + col + 4) = v1; }
        else *(v4u*)(Xb + (size_t)row * DM + col) = pack8(v0, v1);
        float s = (v0[0] * v0[0] + v0[1] * v0[1]) + (v0[2] * v0[2] + v0[3] * v0[3]) + (v1[0] * v1[0] + v1[1] * v1[1]) + (v1[2] * v1[2] + v1[3] * v1[3]);
        s += __shfl_xor(s, 16); s += __shfl_xor(s, 32);
        if ((threadIdx.x & 48) == 0) ssq[(size_t)row * 32 + (col >> 5)] = s;
    }
};
__device__ __forceinline__ float rstd_from(const float* ssq, int row) {
    const f32x4* p = (const f32x4*)(ssq + (size_t)row * 32 + 8 * ((threadIdx.x >> 4) & 3));
    const f32x4 a = p[0] + p[1];
    float t = (a[0] + a[1]) + (a[2] + a[3]);
    t += __shfl_xor(t, 16); t += __shfl_xor(t, 32);
    return rsqrtf(t * (1.f / DM) + EPS);
}
template <int ACT  > struct FScale {
    const float* ssq; bf16* O; int ldo; float mul;
    typedef NoPre Pre;
    __device__ __forceinline__ float rowscale(int row) const { return rstd_from(ssq, row) * mul; }
    __device__ __forceinline__ Pre pre(int, int) const { return Pre{}; }
    __device__ __forceinline__ void apply(int row, int col, f32x4 v0, f32x4 v1, float rs, const Pre&) const {
        v0 = v0 * rs; v1 = v1 * rs;
        if (ACT == 1) {
#pragma unroll
            for (int i = 0; i < 4; ++i) { const float a = fmaxf(v0[i], 0.f), b = fmaxf(v1[i], 0.f); v0[i] = a * a; v1[i] = b * b; }
        }
        *(v4u*)(O + (size_t)row * ldo + col) = pack8(v0, v1);
    }
};

struct TrD { const float* W; const float* g; bf16* WT; int ldw, K, row_off, nblk, r, perm; };
__device__ __forceinline__ TrD tr_desc(const Args& A, unsigned char* ws, int it) {
    constexpr int I_IN = 16 * 96, I_SQ = 16 * 32, I_UP = 16 * 128;
    TrD d; int r = it;
    if (r < I_IN) { d.W = A.in[10]; d.g = A.in[9]; d.WT = (bf16*)(ws + WS_WIN); d.ldw = INW; d.K = DM; d.row_off = 0; d.nblk = 96; d.r = r; d.perm = 1; return d; } r -= I_IN;
    if (r < I_SQ) { d.W = A.in[17]; d.g = nullptr; d.WT = (bf16*)(ws + WS_WOUT); d.ldw = DM; d.K = DM; d.row_off = 0; d.nblk = 32; d.r = r; d.perm = 0; return d; } r -= I_SQ;
    if (r < I_SQ) { d.W = A.in[20]; d.g = A.in[18]; d.WT = (bf16*)(ws + WS_WXQ); d.ldw = DM; d.K = DM; d.row_off = 0; d.nblk = 32; d.r = r; d.perm = 0; return d; } r -= I_SQ;
    if (r < I_SQ) { d.W = A.in[21]; d.g = nullptr; d.WT = (bf16*)(ws + WS_WMKV); d.ldw = DM; d.K = DM; d.row_off = 0; d.nblk = 32; d.r = r; d.perm = 0; return d; } r -= I_SQ;
    if (r < I_SQ) { d.W = A.in[22]; d.g = nullptr; d.WT = (bf16*)(ws + WS_WMKV); d.ldw = DM; d.K = DM; d.row_off = 1024; d.nblk = 32; d.r = r; d.perm = 0; return d; } r -= I_SQ;
    if (r < I_SQ) { d.W = A.in[23]; d.g = nullptr; d.WT = (bf16*)(ws + WS_WXO); d.ldw = DM; d.K = DM; d.row_off = 0; d.nblk = 32; d.r = r; d.perm = 0; return d; } r -= I_SQ;
    if (r < I_UP) { d.W = A.in[25]; d.g = A.in[24]; d.WT = (bf16*)(ws + WS_WUP); d.ldw = DFF; d.K = DM; d.row_off = 0; d.nblk = 128; d.r = r; d.perm = 0; return d; } r -= I_UP;
    d.W = A.in[26]; d.g = nullptr; d.WT = (bf16*)(ws + WS_WDN); d.ldw = DM; d.K = DFF; d.row_off = 0; d.nblk = 32; d.r = r; d.perm = 0; return d;
}
__device__ __forceinline__ void tr_load(const TrD& d, float (&wv)[32], f32x4 (&gq)[2], int lane) {
    const int kb = d.r / d.nblk, nb = d.r % d.nblk, k0 = 64 * kb, n0 = 32 * nb;
#pragma unroll
    for (int i = 0; i < 32; ++i) { const int kk = 2 * i + (lane >> 5); wv[i] = d.W[(size_t)(k0 + kk) * d.ldw + n0 + (lane & 31)]; }
    gq[0] = (f32x4){1.f, 1.f, 1.f, 1.f}; gq[1] = gq[0];
    if (d.g) { gq[0] = *(const f32x4*)(d.g + k0 + 8 * (lane & 7)); gq[1] = *(const f32x4*)(d.g + k0 + 8 * (lane & 7) + 4); }
}
__device__ __forceinline__ void tr_finish(const TrD& d, const float (&wv)[32], const f32x4 (&gq)[2], LAS float* scr, int lane) {
    const int kb = d.r / d.nblk, nb = d.r % d.nblk, k0 = 64 * kb, n0 = 32 * nb;
#pragma unroll
    for (int i = 0; i < 32; ++i) { const int kk = 2 * i + (lane >> 5); scr[kk * 33 + (lane & 31)] = wv[i]; }
    LDS_WAIT();
    const int c = lane & 7;
#pragma unroll
    for (int j = 0; j < 4; ++j) {
        const int n = (lane >> 3) + 8 * j; const LAS float* s = scr + (8 * c) * 33 + n;
        v4u o; o.x = pk2(s[0 * 33] * gq[0][0], s[1 * 33] * gq[0][1]); o.y = pk2(s[2 * 33] * gq[0][2], s[3 * 33] * gq[0][3]);
        o.z = pk2(s[4 * 33] * gq[1][0], s[5 * 33] * gq[1][1]); o.w = pk2(s[6 * 33] * gq[1][2], s[7 * 33] * gq[1][3]);
        const int nsrc = n0 + n; int ndst = nsrc;
        if (d.perm && nsrc < 1024) { const int dd = nsrc & 63; ndst = (nsrc & ~63) + (dd < 32 ? 2 * dd : 2 * (dd - 32) + 1); }
        *(v4u*)(d.WT + (size_t)(d.row_off + ndst) * d.K + k0 + 8 * c) = o;
    }
    LDS_WAIT();
}

__device__ __forceinline__ void p0_prologue(const Args& A, LAS unsigned char* lds, int tid, int wave, int lane) {
    unsigned char* ws = A.ws;
    const int G = gridDim.x, gw = blockIdx.x * NWAVES + wave, NGW = G * NWAVES;
    const int gt = blockIdx.x * NTHR + tid, NGT = G * NTHR;
    {
        LAS float* scr = (LAS float*)(lds + wave * 16384);
        constexpr int I_IN = 16 * 96, I_SQ = 16 * 32, I_UP = 16 * 128, I_DN = 64 * 32;
        constexpr int NIT = I_IN + 5 * I_SQ + I_UP + I_DN;
        int it = gw;
        if (it < NIT) {
            float wv[32]; f32x4 gq[2];
            TrD d = tr_desc(A, ws, it);
            tr_load(d, wv, gq, lane);
            for (;;) {
                const int itn = it + NGW; const bool more = itn < NIT;
                float wn[32]; f32x4 gn[2];
                TrD dn = d;
                if (more) { dn = tr_desc(A, ws, itn); tr_load(dn, wn, gn, lane); }
                tr_finish(d, wv, gq, scr, lane);
                if (!more) break;
#pragma unroll
                for (int i = 0; i < 32; ++i) wv[i] = wn[i];
                gq[0] = gn[0]; gq[1] = gn[1]; d = dn; it = itn;
            }
        }
    }
    __syncthreads();
    LAS float* wdt = (LAS float*)lds;
    for (int i = tid; i < DM * 8; i += NTHR) { const int k = i >> 3, j = i & 7; wdt[i] = A.in[10][(size_t)k * INW + NIN + j] * A.in[9][k]; }
    __syncthreads();
    {
        bf16* A0 = (bf16*)(ws + WS_A0); float* dtr = (float*)(ws + WS_DT);
        f32x4 nv[4];
        if (gw < MT) {
            const float* xr = (gw < MP) ? A.in[0] + (size_t)gw * DM : A.in[1] + (size_t)(gw - MP) * DM;
#pragma unroll
            for (int j = 0; j < 4; ++j) nv[j] = *(const f32x4*)(xr + 4 * lane + 256 * j);
        }
        for (int row = gw; row < MT; row += NGW) {
            f32x4 v[4]; float s = 0.f;
#pragma unroll
            for (int j = 0; j < 4; ++j) { v[j] = nv[j]; s += (v[j][0] * v[j][0] + v[j][1] * v[j][1]) + (v[j][2] * v[j][2] + v[j][3] * v[j][3]); }
            if (row + NGW < MT) {
                const int rn = row + NGW;
                const float* xr = (rn < MP) ? A.in[0] + (size_t)rn * DM : A.in[1] + (size_t)(rn - MP) * DM;
#pragma unroll
                for (int j = 0; j < 4; ++j) nv[j] = *(const f32x4*)(xr + 4 * lane + 256 * j);
            }
            const float rstd = rsqrtf(wave_sum(s) * (1.f / DM) + EPS);
            float d[8] = {0.f, 0.f, 0.f, 0.f, 0.f, 0.f, 0.f, 0.f};
#pragma unroll
            for (int j = 0; j < 4; ++j) {
                v[j] = v[j] * rstd;
                v2u o; o.x = pk2(v[j][0], v[j][1]); o.y = pk2(v[j][2], v[j][3]);
                *(v2u*)(A0 + (size_t)row * DM + 4 * lane + 256 * j) = o;
#pragma unroll
                for (int e = 0; e < 4; ++e) {
                    const LAS f32x4* wp = (const LAS f32x4*)(wdt + (4 * lane + 256 * j + e) * 8);
                    const f32x4 w0 = wp[0], w1 = wp[1];
                    d[0] += v[j][e] * w0[0]; d[1] += v[j][e] * w0[1]; d[2] += v[j][e] * w0[2]; d[3] += v[j][e] * w0[3];
                    d[4] += v[j][e] * w1[0]; d[5] += v[j][e] * w1[1]; d[6] += v[j][e] * w1[2]; d[7] += v[j][e] * w1[3];
                }
            }
#pragma unroll
            for (int e = 0; e < 8; ++e) d[e] = wave_sum(d[e]);
            if (lane == 0) { *(f32x4*)(dtr + (size_t)row * 8) = (f32x4){d[0], d[1], d[2], d[3]}; *(f32x4*)(dtr + (size_t)row * 8 + 4) = (f32x4){d[4], d[5], d[6], d[7]}; }
        }
        bf16* Am = (bf16*)(ws + WS_AM);
        for (int row = gw; row < NBAT * NMEM; row += NGW) {
            const float* xr = A.in[8] + (size_t)row * DM;
            f32x4 v[4]; float s = 0.f;
#pragma unroll
            for (int j = 0; j < 4; ++j) { v[j] = *(const f32x4*)(xr + 4 * lane + 256 * j); s += (v[j][0] * v[j][0] + v[j][1] * v[j][1]) + (v[j][2] * v[j][2] + v[j][3] * v[j][3]); }
            const float rstd = rsqrtf(wave_sum(s) * (1.f / DM) + EPS);
#pragma unroll
            for (int j = 0; j < 4; ++j) {
                const f32x4 gg = *(const f32x4*)(A.in[19] + 4 * lane + 256 * j);
                v[j] = v[j] * rstd * gg;
                v2u o; o.x = pk2(v[j][0], v[j][1]); o.y = pk2(v[j][2], v[j][3]);
                *(v2u*)(Am + (size_t)row * DM + 4 * lane + 256 * j) = o;
            }
        }
    }
    {
        float* cosT = (float*)(ws + WS_COS); float* sinT = (float*)(ws + WS_SIN);
        for (int i = gt; i < (SEQ + ST) * 32; i += NGT) {
            const int pos = i >> 5, k = i & 31;
            const double inv = exp2(-(double)k * (13.287712379549449 / 32.0));
            const double rev = (double)pos * inv * 0.15915494309189535;
            const double fr = rev - floor(rev);
            const float f = (float)fr;
            cosT[i] = __builtin_amdgcn_cosf(f); sinT[i] = __builtin_amdgcn_sinf(f);
        }
    }
}

constexpr int KS_OFF = 0, KSTR = 72;
constexpr int VS_OFF = 36864;
constexpr int PS_OFF = 73728, PSTR = 264;
typedef short v4i16_t __attribute__((ext_vector_type(4)));

__device__ __forceinline__ bf16x8 tr_frag(const LAS unsigned char* tile, int row0, int col0, int strideel, int lane) {
    const int g = lane >> 4, i = lane & 15, q = i >> 2, p = i & 3;
    const LAS unsigned char* a = tile + ((row0 + 8 * g + q) * strideel + col0 + 4 * p) * 2;
    const v4i16_t lo = __builtin_amdgcn_ds_read_tr16_b64_v4i16((LAS v4i16_t*)a);
    const v4i16_t hi = __builtin_amdgcn_ds_read_tr16_b64_v4i16((LAS v4i16_t*)(a + 4 * strideel * 2));
    bf16x8 r; r[0] = lo[0]; r[1] = lo[1]; r[2] = lo[2]; r[3] = lo[3]; r[4] = hi[0]; r[5] = hi[1]; r[6] = hi[2]; r[7] = hi[3];
    return r;
}

constexpr int CP_PER = (LW - ST) * 128, CP_FULL = LW * 128, CP_CHUNKS = SB * CP_PER / 4096;
constexpr int CP_P7 = 512, CP_P3 = CP_CHUNKS - CP_P7;
static_assert(SB * CP_PER % 4096 == 0 && CP_P3 > 0 && 2 * CP_P3 <= 3072, "copy chunks: the dilated-attention units carry half chunks (2048 float4 per tensor)");
template <int NV> __device__ __forceinline__ void cp_load(const Args& A, int base, f32x4 (&ck)[NV], f32x4 (&cv)[NV], int tid) {
    const f32x4* srck = (const f32x4*)A.in[2]; const f32x4* srcv = (const f32x4*)A.in[3];
#pragma unroll
    for (int k = 0; k < NV; ++k) {
        const int i = base + k * NTHR + tid, sb = i / CP_PER, r = i - sb * CP_PER;
        const size_t so = (size_t)sb * CP_FULL + ST * 128 + r;
        ck[k] = __builtin_nontemporal_load(srck + so); cv[k] = __builtin_nontemporal_load(srcv + so);
    }
}
template <int NV> __device__ __forceinline__ void cp_store(const Args& A, int base, const f32x4 (&ck)[NV], const f32x4 (&cv)[NV], int tid) {
    f32x4* dstk = (f32x4*)(A.out + O_WKS); f32x4* dstv = (f32x4*)(A.out + O_WVS);
#pragma unroll
    for (int k = 0; k < NV; ++k) {
        const int i = base + k * NTHR + tid, sb = i / CP_PER, r = i - sb * CP_PER;
        const size_t dof = (size_t)sb * CP_FULL + r;
        __builtin_nontemporal_store(ck[k], dstk + dof); __builtin_nontemporal_store(cv[k], dstv + dof);
    }
}
struct DilUnit { const bf16 *Q, *K, *V; bf16* O; float* L; ptrdiff_t stride, lstride; bool has_prev; };
__device__ __forceinline__ DilUnit dil_unit(unsigned char* ws, int u) {
    const int br = u >> 10, rem = u & 1023, b = rem >> 9, h = (rem >> 6) & 7, sj = rem & 63;
    const int dil = br == 0 ? 1 : (br == 1 ? 4 : 16);
    const int r = sj % dil, j = sj / dil;
    const ptrdiff_t qrow = (ptrdiff_t)b * SEQ + (ptrdiff_t)j * 128 * dil + r, krow = qrow - (ptrdiff_t)128 * dil;
    DilUnit d;
    d.Q = (const bf16*)(ws + WS_QB) + qrow * 512 + h * 64; d.K = (const bf16*)(ws + WS_KB) + krow * 512 + h * 64; d.V = (const bf16*)(ws + WS_VB) + krow * 512 + h * 64;
    d.O = (bf16*)(ws + WS_OBR) + (size_t)br * MP * 512 + qrow * 512 + h * 64; d.L = (float*)(ws + WS_LSE) + (size_t)br * MP * 8 + qrow * 8 + h;
    d.stride = (ptrdiff_t)dil * 512; d.lstride = (ptrdiff_t)dil * 8; d.has_prev = j > 0;
    return d;
}
__device__ __forceinline__ void dil_load(const DilUnit& d, v4u (&kr)[4], v4u (&vr)[4], bf16x8& q0, bf16x8& q1, int tid, int wave, int lane) {
#pragma unroll
    for (int i = 0; i < 4; ++i) {
        const int idx = tid + NTHR * i, c = idx >> 3, ch = idx & 7;
        kr[i] = (v4u){0u, 0u, 0u, 0u}; vr[i] = (v4u){0u, 0u, 0u, 0u};
        if (d.has_prev || c >= 128) { kr[i] = *(const v4u*)(d.K + (ptrdiff_t)c * d.stride + ch * 8); vr[i] = *(const v4u*)(d.V + (ptrdiff_t)c * d.stride + ch * 8); }
    }
    const bf16* qrow = d.Q + (ptrdiff_t)(wave * 16 + (lane & 15)) * d.stride + 8 * (lane >> 4);
    q0 = *(const bf16x8*)qrow; q1 = *(const bf16x8*)(qrow + 32);
}

__device__ __forceinline__ void dil_attn_phase(const Args& A, LAS unsigned char* lds, int tid, int wave, int lane) {
    const int G = gridDim.x;
    int u = blockIdx.x;
    if (u >= 3072) return;
    const int fr = lane & 15, fq = lane >> 4;
    v4u kr[4], vr[4]; bf16x8 qn0, qn1;
    { const DilUnit fu = dil_unit(A.ws, u); dil_load(fu, kr, vr, qn0, qn1, tid, wave, lane); }
    LAS bf16* Pw = (LAS bf16*)(lds + PS_OFF + wave * 8448);
    f32x4 ck[4], cv[4]; int pend = -1;
    for (;;) {
        const DilUnit cu = dil_unit(A.ws, u);
#pragma unroll
        for (int i = 0; i < 4; ++i) {
            const int idx = tid + NTHR * i, c = idx >> 3, ch = idx & 7;
            *(LAS v4u*)(lds + KS_OFF + (c * KSTR + ch * 8) * 2) = kr[i];
            *(LAS v4u*)(lds + VS_OFF + (c * KSTR + ch * 8) * 2) = vr[i];
        }
        const bf16x8 q0 = qn0, q1 = qn1;
        LDS_WAIT(); __builtin_amdgcn_s_barrier(); asm volatile("" ::: "memory");
        const int un = u + G; const bool more = un < 3072;
        if (more) { const DilUnit nu = dil_unit(A.ws, un); dil_load(nu, kr, vr, qn0, qn1, tid, wave, lane); }
        if (pend >= 0) cp_store<4>(A, pend * 2048, ck, cv, tid);
        pend = -1;
        if (u < 2 * CP_P3) { cp_load<4>(A, u * 2048, ck, cv, tid); pend = u; }
        f32x4 s[9];
#pragma unroll
        for (int i = 0; i < 9; ++i) {
            const LAS unsigned char* kp = lds + KS_OFF + (((wave + i) * 16 + fr) * KSTR + 8 * fq) * 2;
            const bf16x8 k0 = *(const LAS bf16x8*)kp, k1 = *(const LAS bf16x8*)(kp + 64);
            s[i] = mfma16(k0, q0, (f32x4){0.f, 0.f, 0.f, 0.f}); s[i] = mfma16(k1, q1, s[i]);
        }
        float inv_own;
        {
            const int nbz = (wave & 1) ? wave - 1 : wave + 9;
            const int a = wave * 16 + fr;
            float m = -INFINITY;
#pragma unroll
            for (int i = 0; i < 9; ++i)
#pragma unroll
                for (int j = 0; j < 4; ++j) {
                    const int c = (wave + i) * 16 + 4 * fq + j;
                    const bool ok = (c >= a) && (c <= a + 128) && (cu.has_prev || c >= 128);
                    const float v = ok ? s[i][j] * 0.125f : -INFINITY;
                    s[i][j] = v; m = fmaxf(m, v);
                }
            m = fmaxf(m, __shfl_xor(m, 16)); m = fmaxf(m, __shfl_xor(m, 32));
            float sum = 0.f;
#pragma unroll
            for (int i = 0; i < 9; ++i) {
                const float p0 = __expf(s[i][0] - m), p1 = __expf(s[i][1] - m), p2 = __expf(s[i][2] - m), p3 = __expf(s[i][3] - m);
                sum += (p0 + p1) + (p2 + p3);
                v2u w; w.x = pk2(p0, p1); w.y = pk2(p2, p3);
                *(LAS v2u*)(Pw + fr * PSTR + (wave + i) * 16 + 4 * fq) = w;
            }
            *(LAS v2u*)(Pw + fr * PSTR + nbz * 16 + 4 * fq) = (v2u){0u, 0u};
            sum += __shfl_xor(sum, 16); sum += __shfl_xor(sum, 32);
            inv_own = 1.f / sum;
            if (fq == 0) cu.L[(ptrdiff_t)a * cu.lstride] = m + __logf(sum);
        }
        asm volatile("" ::: "memory");
        f32x4 o[4];
#pragma unroll
        for (int db = 0; db < 4; ++db) o[db] = (f32x4){0.f, 0.f, 0.f, 0.f};
#pragma unroll
        for (int kk = 0; kk < 5; ++kk) {
            const int ks = (wave >> 1) + kk;
            const bf16x8 pa = *(const LAS bf16x8*)(Pw + fr * PSTR + ks * 32 + 8 * fq);
#pragma unroll
            for (int db = 0; db < 4; ++db) o[db] = mfma16(tr_frag(lds + VS_OFF, ks * 32, db * 16, KSTR, lane), pa, o[db]);
        }
        {
            bf16* orow = cu.O + (ptrdiff_t)(wave * 16 + fr) * cu.stride + 4 * fq;
#pragma unroll
            for (int db = 0; db < 4; ++db) { v2u w; w.x = pk2(o[db][0] * inv_own, o[db][1] * inv_own); w.y = pk2(o[db][2] * inv_own, o[db][3] * inv_own); *(v2u*)(orow + db * 16) = w; }
        }
        LDS_WAIT(); __builtin_amdgcn_s_barrier(); asm volatile("" ::: "memory");
        if (!more) break;
        u = un;
    }
    if (pend >= 0) cp_store<4>(A, pend * 2048, ck, cv, tid);
}

__device__ __forceinline__ void xattn_load(v4u (&r)[4], const bf16* base, int dc, int tid) {
#pragma unroll
    for (int i = 0; i < 4; ++i) { const int idx = tid + NTHR * i, c = idx >> 3, ch = idx & 7; r[i] = *(const v4u*)(base + (size_t)c * 1024 + dc * 64 + ch * 8); }
}
__device__ __forceinline__ void xattn_store(LAS unsigned char* dst, const v4u (&r)[4], int tid) {
#pragma unroll
    for (int i = 0; i < 4; ++i) { const int idx = tid + NTHR * i, c = idx >> 3, ch = idx & 7; *(LAS v4u*)(dst + (c * KSTR + ch * 8) * 2) = r[i]; }
}
__device__ __forceinline__ void xattn_phase(const Args& A, LAS unsigned char* lds, int tid, int wave, int lane) {
    const int G = gridDim.x;
    const int fr = lane & 15, fq = lane >> 4;
    unsigned char* ws = A.ws;
    LAS bf16* Pw = (LAS bf16*)(lds + PS_OFF + wave * 8448);
    int u = blockIdx.x;
    if (u >= 512) return;
    v4u r0[4], r1[4];
    {
        const int b = u >> 8, h = u & 3; const bf16* Kp = (const bf16*)(ws + WS_MKB) + (size_t)b * NMEM * 1024 + h * 256;
        xattn_load(r0, Kp, 0, tid); xattn_load(r1, Kp, 1, tid);
        xattn_store(lds + KS_OFF, r0, tid); xattn_load(r0, Kp, 2, tid);
        LDS_WAIT(); __builtin_amdgcn_s_barrier(); asm volatile("" ::: "memory");
    }
    for (;;) {
        const int b = u >> 8, qt = (u & 255) >> 2, h = u & 3;
        const size_t row0 = (size_t)b * SEQ + qt * 128;
        const bf16* Qp = (const bf16*)(ws + WS_A0) + (row0 + wave * 16 + fr) * 1024 + h * 256 + 8 * fq;
        const bf16* Kp = (const bf16*)(ws + WS_MKB) + (size_t)b * NMEM * 1024 + h * 256;
        const bf16* Vp = (const bf16*)(ws + WS_MVB) + (size_t)b * NMEM * 1024 + h * 256;
        bf16* Op = (bf16*)(ws + WS_MIX) + row0 * 1024 + h * 256;
        const int un = u + G; const bool more = un < 512;
        const bf16* Kn = (const bf16*)(ws + WS_MKB) + (size_t)(un >> 8) * NMEM * 1024 + (un & 3) * 256;
        bf16x8 qn0 = *(const bf16x8*)Qp, qn1 = *(const bf16x8*)(Qp + 32);
        f32x4 s[16];
#pragma unroll
        for (int nb = 0; nb < 16; ++nb) s[nb] = (f32x4){0.f, 0.f, 0.f, 0.f};
#pragma unroll
        for (int dc = 0; dc < 4; ++dc) {
            if (dc == 0) { xattn_store(lds + VS_OFF, r1, tid); xattn_load(r1, Kp, 3, tid); }
            else if (dc == 1) { xattn_store(lds + KS_OFF, r0, tid); xattn_load(r0, Vp, 0, tid); }
            else if (dc == 2) { xattn_store(lds + VS_OFF, r1, tid); xattn_load(r1, Vp, 1, tid); }
            else { xattn_store(lds + KS_OFF, r0, tid); xattn_load(r0, Vp, 2, tid); }
            const bf16x8 q0 = qn0, q1 = qn1;
            if (dc < 3) { qn0 = *(const bf16x8*)(Qp + (dc + 1) * 64); qn1 = *(const bf16x8*)(Qp + (dc + 1) * 64 + 32); }
            const LAS unsigned char* kb = lds + ((dc & 1) ? VS_OFF : KS_OFF);
#pragma unroll
            for (int nb = 0; nb < 16; ++nb) {
                const LAS unsigned char* kp = kb + ((nb * 16 + fr) * KSTR + 8 * fq) * 2;
                const bf16x8 k0 = *(const LAS bf16x8*)kp, k1 = *(const LAS bf16x8*)(kp + 64);
                s[nb] = mfma16(k0, q0, s[nb]); s[nb] = mfma16(k1, q1, s[nb]);
            }
            LDS_WAIT(); __builtin_amdgcn_s_barrier(); asm volatile("" ::: "memory");
        }
        float inv_own;
        {
            float m = -INFINITY;
#pragma unroll
            for (int nb = 0; nb < 16; ++nb) m = fmaxf(fmaxf(m, fmaxf(s[nb][0], s[nb][1])), fmaxf(s[nb][2], s[nb][3]));
            m = fmaxf(m, __shfl_xor(m, 16)); m = fmaxf(m, __shfl_xor(m, 32));
            float sum = 0.f;
#pragma unroll
            for (int nb = 0; nb < 16; ++nb) {
                const float p0 = __expf(s[nb][0] - m), p1 = __expf(s[nb][1] - m), p2 = __expf(s[nb][2] - m), p3 = __expf(s[nb][3] - m);
                sum += (p0 + p1) + (p2 + p3);
                v2u w; w.x = pk2(p0, p1); w.y = pk2(p2, p3);
                *(LAS v2u*)(Pw + fr * PSTR + nb * 16 + 4 * fq) = w;
            }
            sum += __shfl_xor(sum, 16); sum += __shfl_xor(sum, 32);
            inv_own = 1.f / sum;
        }
#pragma unroll
        for (int dc = 0; dc < 4; ++dc) {
            if (dc == 0) { xattn_store(lds + VS_OFF, r1, tid); xattn_load(r1, Vp, 3, tid); }
            else if (dc == 1) { xattn_store(lds + KS_OFF, r0, tid); if (more) xattn_load(r0, Kn, 0, tid); }
            else if (dc == 2) { xattn_store(lds + VS_OFF, r1, tid); if (more) xattn_load(r1, Kn, 1, tid); }
            else if (more) { xattn_store(lds + KS_OFF, r0, tid); xattn_load(r0, Kn, 2, tid); }
            const LAS unsigned char* vb = lds + ((dc & 1) ? VS_OFF : KS_OFF);
            f32x4 o[4];
#pragma unroll
            for (int db = 0; db < 4; ++db) o[db] = (f32x4){0.f, 0.f, 0.f, 0.f};
#pragma unroll
            for (int ks = 0; ks < 8; ++ks) {
                const bf16x8 pa = *(const LAS bf16x8*)(Pw + fr * PSTR + ks * 32 + 8 * fq);
#pragma unroll
                for (int db = 0; db < 4; ++db) o[db] = mfma16(tr_frag(vb, ks * 32, db * 16, KSTR, lane), pa, o[db]);
            }
            {
                bf16* orow = Op + (size_t)(wave * 16 + fr) * 1024 + dc * 64 + 4 * fq;
#pragma unroll
                for (int db = 0; db < 4; ++db) { v2u w; w.x = pk2(o[db][0] * inv_own, o[db][1] * inv_own); w.y = pk2(o[db][2] * inv_own, o[db][3] * inv_own); *(v2u*)(orow + db * 16) = w; }
            }
            LDS_WAIT(); __builtin_amdgcn_s_barrier(); asm volatile("" ::: "memory");
        }
        if (!more) break;
        u = un;
    }
}

constexpr int SSTR = 136;
constexpr int ACS_OFF = 139264, DTV_OFF = 141312;
__device__ __forceinline__ void ssd_dt_scan(const Args& A, LAS unsigned char* lds, int b, int c, int g, int wave, int lane, float* decay_out) {
    if (wave < 4) {
        const int h = g * 4 + wave;
        const float* dtr = (const float*)(A.ws + WS_DT);
        const float bias = A.in[13][h], aneg = -__expf(A.in[14][h]);
        const size_t row0 = (size_t)b * SEQ + c * 128 + 2 * lane;
        const float d0 = softplus_f(dtr[row0 * 8 + h] + bias), d1 = softplus_f(dtr[(row0 + 1) * 8 + h] + bias);
        const float a0 = d0 * aneg, a1 = d1 * aneg;
        float sc = a0 + a1;
#pragma unroll
        for (int o = 1; o < 64; o <<= 1) { const float t = __shfl_up(sc, o); if (lane >= o) sc += t; }
        const float ex = sc - (a0 + a1);
        LAS float* acs = (LAS float*)(lds + ACS_OFF) + wave * 128; LAS float* dtv = (LAS float*)(lds + DTV_OFF) + wave * 128;
        acs[2 * lane] = ex + a0; acs[2 * lane + 1] = sc; dtv[2 * lane] = d0; dtv[2 * lane + 1] = d1;
        if (decay_out && lane == 63) decay_out[(b * 8 + h) * 64 + c] = __expf(sc);
    }
}

constexpr int XWSTR = 264, BNSTR = 136;
__device__ __forceinline__ void ssd_pass1_unit(const Args& A, LAS unsigned char* lds, int u, int tid, int wave, int lane) {
    const int g = u & 1, c = (u >> 1) & 63, b = u >> 7;
    unsigned char* ws = A.ws;
    ssd_dt_scan(A, lds, b, c, g, wave, lane, (float*)(ws + WS_DEC));
    LDS_WAIT(); __builtin_amdgcn_s_barrier(); asm volatile("" ::: "memory");
    const LAS float* acs = (const LAS float*)(lds + ACS_OFF); const LAS float* dtv = (const LAS float*)(lds + DTV_OFF);
    LAS bf16* Xw = (LAS bf16*)lds;
    LAS bf16* Bn = (LAS bf16*)(lds + 67584);
    {
        const int c8 = tid & 63, ci = 8 * c8;
        int ch; if (ci < 256) ch = g * 256 + ci; else if (ci < 384) ch = 512 + g * 128 + (ci - 256); else ch = 768 + g * 128 + (ci - 384);
        const float* cw = A.in[11]; const float* cb = A.in[12];
        float w[4][8], bia[8];
#pragma unroll
        for (int k = 0; k < 4; ++k) { const f32x4 a = *(const f32x4*)(cw + k * 1024 + ch), bq = *(const f32x4*)(cw + k * 1024 + ch + 4);
            w[k][0] = a[0]; w[k][1] = a[1]; w[k][2] = a[2]; w[k][3] = a[3]; w[k][4] = bq[0]; w[k][5] = bq[1]; w[k][6] = bq[2]; w[k][7] = bq[3]; }
        { const f32x4 a = *(const f32x4*)(cb + ch), bq = *(const f32x4*)(cb + ch + 4); bia[0] = a[0]; bia[1] = a[1]; bia[2] = a[2]; bia[3] = a[3]; bia[4] = bq[0]; bia[5] = bq[1]; bia[6] = bq[2]; bia[7] = bq[3]; }
        const bf16* xb = (const bf16*)(ws + WS_XBC) + (size_t)b * SEQ * 1024 + ch;
        bf16* xc = (bf16*)(ws + WS_XC) + (size_t)b * SEQ * 1024 + ch;
        const int hh = ci >> 6;
        float aend = 0.f; if (ci < 256) aend = acs[hh * 128 + 127];
#pragma unroll 1
        for (int half = 0; half < 2; ++half) {
            const int l0 = wave * 16 + half * 8, t0 = c * 128 + l0;
            v4u raw[11];
#pragma unroll
            for (int k = 0; k < 11; ++k) { const int t = t0 - 3 + k; raw[k] = (v4u){0u, 0u, 0u, 0u}; if (t >= 0) raw[k] = *(const v4u*)(xb + (size_t)t * 1024); }
#pragma unroll
            for (int r = 0; r < 8; ++r) {
                float v[8];
#pragma unroll
                for (int e = 0; e < 8; ++e) {
                    float acc = bia[e];
#pragma unroll
                    for (int k = 0; k < 4; ++k) { const unsigned wd = raw[r + k][e >> 1]; acc += w[k][e] * ((e & 1) ? bfhi(wd) : bflo(wd)); }
                    v[e] = silu_f(acc);
                }
                const int l = l0 + r;
                v4u o; o.x = pk2(v[0], v[1]); o.y = pk2(v[2], v[3]); o.z = pk2(v[4], v[5]); o.w = pk2(v[6], v[7]);
                *(v4u*)(xc + (size_t)(t0 + r) * 1024) = o;
                if (ci < 256) {
                    const float wgt = dtv[hh * 128 + l] * __expf(aend - acs[hh * 128 + l]);
                    v4u ow; ow.x = pk2(v[0] * wgt, v[1] * wgt); ow.y = pk2(v[2] * wgt, v[3] * wgt); ow.z = pk2(v[4] * wgt, v[5] * wgt); ow.w = pk2(v[6] * wgt, v[7] * wgt);
                    *(LAS v4u*)(Xw + l * XWSTR + ci) = ow;
                } else if (ci < 384) {
                    *(LAS v4u*)(Bn + l * BNSTR + (ci - 256)) = o;
                }
            }
        }
    }
    LDS_WAIT(); __builtin_amdgcn_s_barrier(); asm volatile("" ::: "memory");
    {
        const int fr = lane & 15, fq = lane >> 4, pb = wave & 3, nh = wave >> 2;
        float* st = (float*)(ws + WS_STATE);
#pragma unroll 1
        for (int hh = 0; hh < 4; ++hh) {
            f32x4 acc[4];
#pragma unroll
            for (int i = 0; i < 4; ++i) acc[i] = (f32x4){0.f, 0.f, 0.f, 0.f};
#pragma unroll
            for (int ks = 0; ks < 4; ++ks) {
                const bf16x8 a = tr_frag((const LAS unsigned char*)Xw, ks * 32, hh * 64 + pb * 16, XWSTR, lane);
#pragma unroll
                for (int i = 0; i < 4; ++i) acc[i] = mfma16(tr_frag((const LAS unsigned char*)Bn, ks * 32, (nh * 4 + i) * 16, BNSTR, lane), a, acc[i]);
            }
            float* sp = st + ((size_t)((b * 64 + c) * 8 + g * 4 + hh)) * 8192 + (pb * 16 + fr) * 128 + 4 * fq;
#pragma unroll
            for (int i = 0; i < 4; ++i) *(f32x4*)(sp + (nh * 4 + i) * 16) = acc[i];
        }
    }
    LDS_WAIT(); __builtin_amdgcn_s_barrier(); asm volatile("" ::: "memory");
}

__device__ __forceinline__ void ssd_pass2_unit(const Args& A, LAS unsigned char* lds, int u, int tid, int wave, int lane) {
    const int g = u & 1, c = (u >> 1) & 63, b = u >> 7;
    unsigned char* ws = A.ws;
    const int fr = lane & 15, fq = lane >> 4;
    ssd_dt_scan(A, lds, b, c, g, wave, lane, nullptr);
    LAS bf16* Cs = (LAS bf16*)lds; LAS bf16* Bs = (LAS bf16*)(lds + 34816);
    LAS bf16* Pw = (LAS bf16*)(lds + 69632 + wave * 4352);
    LAS bf16* XT = (LAS bf16*)(lds + 104448); LAS bf16* Hs = (LAS bf16*)(lds + 121856);
    const LAS float* acs = (const LAS float*)(lds + ACS_OFF); const LAS float* dtv = (const LAS float*)(lds + DTV_OFF);
    const size_t row0 = (size_t)b * SEQ + c * 128;
    const bf16* xc = (const bf16*)(ws + WS_XC) + row0 * 1024;
#pragma unroll
    for (int i = 0; i < 4; ++i) {
        const int idx = tid + NTHR * i, r = idx >> 4, ch = idx & 15;
        *(LAS v4u*)(Cs + r * SSTR + ch * 8) = *(const v4u*)(xc + (size_t)r * 1024 + 768 + g * 128 + ch * 8);
        *(LAS v4u*)(Bs + r * SSTR + ch * 8) = *(const v4u*)(xc + (size_t)r * 1024 + 512 + g * 128 + ch * 8);
    }
    LDS_WAIT(); __builtin_amdgcn_s_barrier(); asm volatile("" ::: "memory");
    f32x4 G[8];
#pragma unroll
    for (int nb = 0; nb < 8; ++nb) G[nb] = (f32x4){0.f, 0.f, 0.f, 0.f};
#pragma unroll
    for (int ks = 0; ks < 4; ++ks) {
        const bf16x8 a = *(const LAS bf16x8*)(Cs + (wave * 16 + fr) * SSTR + ks * 32 + 8 * fq);
#pragma unroll
        for (int nb = 0; nb < 8; ++nb) { const bf16x8 bb = *(const LAS bf16x8*)(Bs + (nb * 16 + fr) * SSTR + ks * 32 + 8 * fq); G[nb] = mfma16(bb, a, G[nb]); }
    }
    const int l = wave * 16 + fr;
    float ssq1 = 0.f;
    float* tmp = (float*)(ws + WS_STATE) + (size_t)u * 128 * 256 + (size_t)l * 256 + 4 * fq;
    const bf16* zb = (const bf16*)(ws + WS_ZB) + (row0 + l) * 512 + 4 * fq;
    v4u xr[2], hr[2];
    {
        const bf16* hst0 = (const bf16*)(ws + WS_HST) + ((size_t)((b * 64 + c) * 8 + g * 4)) * 8192;
#pragma unroll
        for (int i = 0; i < 2; ++i) {
            const int idx = tid + NTHR * i;
            xr[i] = *(const v4u*)(xc + (size_t)(idx >> 3) * 1024 + g * 256 + (idx & 7) * 8);
            hr[i] = *(const v4u*)(hst0 + (idx >> 4) * 128 + (idx & 15) * 8);
        }
    }
#pragma unroll 1
    for (int hh = 0; hh < 4; ++hh) {
        const int h = g * 4 + hh;
        LDS_WAIT(); __builtin_amdgcn_s_barrier(); asm volatile("" ::: "memory");
#pragma unroll
        for (int i = 0; i < 2; ++i) {
            const int idx = tid + NTHR * i, r = idx >> 3, ch = idx & 7;
            const v4u val = xr[i];
            const float d = dtv[hh * 128 + r];
            LAS bf16* xt = XT + (ch * 8) * SSTR + r;
            xt[0 * SSTR] = f2bf(bflo(val.x) * d); xt[1 * SSTR] = f2bf(bfhi(val.x) * d);
            xt[2 * SSTR] = f2bf(bflo(val.y) * d); xt[3 * SSTR] = f2bf(bfhi(val.y) * d);
            xt[4 * SSTR] = f2bf(bflo(val.z) * d); xt[5 * SSTR] = f2bf(bfhi(val.z) * d);
            xt[6 * SSTR] = f2bf(bflo(val.w) * d); xt[7 * SSTR] = f2bf(bfhi(val.w) * d);
        }
#pragma unroll
        for (int i = 0; i < 2; ++i) {
            const int idx = tid + NTHR * i, r = idx >> 4, ch = idx & 15;
            *(LAS v4u*)(Hs + r * SSTR + ch * 8) = hr[i];
        }
        if (hh < 3) {
            const bf16* hstn = (const bf16*)(ws + WS_HST) + ((size_t)((b * 64 + c) * 8 + h + 1)) * 8192;
#pragma unroll
            for (int i = 0; i < 2; ++i) {
                const int idx = tid + NTHR * i;
                xr[i] = *(const v4u*)(xc + (size_t)(idx >> 3) * 1024 + (h + 1) * 64 + (idx & 7) * 8);
                hr[i] = *(const v4u*)(hstn + (idx >> 4) * 128 + (idx & 15) * 8);
            }
        }
        v2u zv[4];
#pragma unroll
        for (int pb = 0; pb < 4; ++pb) zv[pb] = *(const v2u*)(zb + h * 64 + pb * 16);
        {
            const float al = acs[hh * 128 + l];
#pragma unroll
            for (int nb = 0; nb < 8; ++nb) {
                const int s0 = nb * 16 + 4 * fq;
                const f32x4 as = *(const LAS f32x4*)(acs + hh * 128 + s0);
                float p[4];
#pragma unroll
                for (int j = 0; j < 4; ++j) p[j] = (s0 + j <= l) ? G[nb][j] * __expf(al - as[j]) : 0.f;
                v2u w; w.x = pk2(p[0], p[1]); w.y = pk2(p[2], p[3]);
                *(LAS v2u*)(Pw + fr * SSTR + s0) = w;
            }
        }
        LDS_WAIT(); __builtin_amdgcn_s_barrier(); asm volatile("" ::: "memory");
        f32x4 yd[4], yo[4];
#pragma unroll
        for (int pb = 0; pb < 4; ++pb) { yd[pb] = (f32x4){0.f, 0.f, 0.f, 0.f}; yo[pb] = (f32x4){0.f, 0.f, 0.f, 0.f}; }
#pragma unroll
        for (int ks = 0; ks < 4; ++ks) {
            const bf16x8 pa = *(const LAS bf16x8*)(Pw + fr * SSTR + ks * 32 + 8 * fq);
            const bf16x8 ca = *(const LAS bf16x8*)(Cs + (wave * 16 + fr) * SSTR + ks * 32 + 8 * fq);
#pragma unroll
            for (int pb = 0; pb < 4; ++pb) {
                const bf16x8 xb = *(const LAS bf16x8*)(XT + (pb * 16 + fr) * SSTR + ks * 32 + 8 * fq);
                const bf16x8 hb = *(const LAS bf16x8*)(Hs + (pb * 16 + fr) * SSTR + ks * 32 + 8 * fq);
                yd[pb] = mfma16(xb, pa, yd[pb]); yo[pb] = mfma16(hb, ca, yo[pb]);
            }
        }
        const float dsk = A.in[15][h];
        const float ea = __expf(acs[hh * 128 + l]), idt = 1.f / dtv[hh * 128 + l];
#pragma unroll
        for (int pb = 0; pb < 4; ++pb) {
            const float zf[4] = {bflo(zv[pb].x), bfhi(zv[pb].x), bflo(zv[pb].y), bfhi(zv[pb].y)};
            f32x4 uu;
#pragma unroll
            for (int j = 0; j < 4; ++j) {
                const int p = pb * 16 + 4 * fq + j;
                const float xv = bf2f(XT[p * SSTR + l]) * idt;
                const float y = yd[pb][j] + ea * yo[pb][j] + dsk * xv;
                uu[j] = y * silu_f(zf[j]);
                ssq1 += uu[j] * uu[j];
            }
            *(f32x4*)(tmp + hh * 64 + pb * 16) = uu;
        }
    }
    bf16* mix = (bf16*)(ws + WS_MIX) + (row0 + l) * 1024 + 512 + g * 256 + 4 * fq;
    const float* gs = A.in[16] + g * 256 + 4 * fq;
    ssq1 += __shfl_xor(ssq1, 16); ssq1 += __shfl_xor(ssq1, 32);
    const float rs = rsqrtf(ssq1 * (1.f / 256.f) + EPS);
#pragma unroll
    for (int half = 0; half < 2; ++half) {
        f32x4 tv[8], gv[8];
#pragma unroll
        for (int q = 0; q < 8; ++q) { tv[q] = *(const f32x4*)(tmp + (half * 8 + q) * 16); gv[q] = *(const f32x4*)(gs + (half * 8 + q) * 16); }
#pragma unroll
        for (int q = 0; q < 8; ++q) {
            const f32x4 o = tv[q] * rs * gv[q];
            v2u w; w.x = pk2(o[0], o[1]); w.y = pk2(o[2], o[3]);
            *(v2u*)(mix + (half * 8 + q) * 16) = w;
        }
    }
    LDS_WAIT(); __builtin_amdgcn_s_barrier(); asm volatile("" ::: "memory");
}

__device__ __forceinline__ void sample_attn_pair(const Args& A, LAS unsigned char* lds, int wu, int wave, int lane) {
    const int sb = wu >> 5, h = (wu >> 2) & 7, t = wu & 3;
    const int sub = lane & 7, grp = lane >> 3, half = wave >> 2;
    LAS float* sc = (LAS float*)(lds + wave * 2048);
    const float* SQ = (const float*)(A.ws + WS_SMISC);
    const float* qp = SQ + (size_t)(sb * 4 + t) * 512 + h * 64 + 8 * sub;
    const f32x4 qa = *(const f32x4*)qp, qb = *(const f32x4*)(qp + 4);
    const float* ck = A.in[2]; const float* cv = A.in[3];
    const float* ok = A.out + O_WKS; const float* ov = A.out + O_WVS;
    constexpr int NK = 387;
    const int it0 = half ? 25 : 0, it1 = half ? 49 : 25, k0 = it0 * 8, k1 = (it1 * 8 < NK) ? it1 * 8 : NK;
#pragma unroll 5
    for (int it = it0; it < it1; ++it) {
        const int kk = it * 8 + grp, kc = kk < NK ? kk : NK - 1;
        const int br = kc / 129, j = kc - br * 129, dil = br == 0 ? 1 : (br == 1 ? 4 : 16);
        const int idx = LW + t - dil * j;
        const float* kp = ((idx < LW) ? ck + ((size_t)(sb * LW + idx) * 512 + h * 64) : ok + ((size_t)(sb * LW + idx - ST) * 512 + h * 64)) + 8 * sub;
        const f32x4 ka = *(const f32x4*)kp, kb = *(const f32x4*)(kp + 4);
        float s = ((qa[0] * ka[0] + qa[1] * ka[1]) + (qa[2] * ka[2] + qa[3] * ka[3])) + ((qb[0] * kb[0] + qb[1] * kb[1]) + (qb[2] * kb[2] + qb[3] * kb[3]));
        s += __shfl_xor(s, 1); s += __shfl_xor(s, 2); s += __shfl_xor(s, 4);
        if (sub == 0 && kk < NK) sc[kk - k0] = s * 0.125f;
    }
    LDS_WAIT();
    const int nk = k1 - k0;
    float m = -INFINITY;
    for (int kk = lane; kk < nk; kk += 64) m = fmaxf(m, sc[kk]);
    m = wave_max(m);
    float sum = 0.f;
    for (int kk = lane; kk < nk; kk += 64) { const float p = __expf(sc[kk] - m); sc[kk] = p; sum += p; }
    sum = wave_sum(sum);
    LDS_WAIT();
    f32x4 acca = {0.f, 0.f, 0.f, 0.f}, accb = {0.f, 0.f, 0.f, 0.f};
#pragma unroll 5
    for (int it = it0; it < it1; ++it) {
        const int kk = it * 8 + grp, kc = kk < NK ? kk : NK - 1;
        const int br = kc / 129, j = kc - br * 129, dil = br == 0 ? 1 : (br == 1 ? 4 : 16);
        const int idx = LW + t - dil * j;
        const float* vp = ((idx < LW) ? cv + ((size_t)(sb * LW + idx) * 512 + h * 64) : ov + ((size_t)(sb * LW + idx - ST) * 512 + h * 64)) + 8 * sub;
        const f32x4 va = *(const f32x4*)vp, vb = *(const f32x4*)(vp + 4);
        const float p = kk < NK ? sc[kk - k0] : 0.f;
        acca = acca + va * p; accb = accb + vb * p;
    }
#pragma unroll
    for (int e = 0; e < 4; ++e) {
        acca[e] += __shfl_xor(acca[e], 8); acca[e] += __shfl_xor(acca[e], 16); acca[e] += __shfl_xor(acca[e], 32);
        accb[e] += __shfl_xor(accb[e], 8); accb[e] += __shfl_xor(accb[e], 16); accb[e] += __shfl_xor(accb[e], 32);
    }
    if (half == 1 && grp == 0) {
        *(LAS f32x4*)(sc + 400 + 2 + 8 * sub + 6) = acca; *(LAS f32x4*)(sc + 400 + 2 + 8 * sub + 10) = accb;
        if (sub == 0) { sc[400] = m; sc[401] = sum; }
    }
    __syncthreads();
    if (half == 0 && grp == 0) {
        const LAS float* ps = (const LAS float*)(lds + (wave + 4) * 2048) + 400;
        const float m1 = ps[0], s1 = ps[1];
        const f32x4 oa = *(const LAS f32x4*)(ps + 8 + 8 * sub), ob = *(const LAS f32x4*)(ps + 12 + 8 * sub);
        const float mm = fmaxf(m, m1), a0 = __expf(m - mm), a1 = __expf(m1 - mm);
        const float is = 1.f / (sum * a0 + s1 * a1);
        const f32x4 ra = (acca * a0 + oa * a1) * is, rb = (accb * a0 + ob * a1) * is;
        v4u o; o.x = pk2(ra[0], ra[1]); o.y = pk2(ra[2], ra[3]); o.z = pk2(rb[0], rb[1]); o.w = pk2(rb[2], rb[3]);
        *(v4u*)((bf16*)(A.ws + WS_MIX) + (size_t)(MP + sb * 4 + t) * 1024 + h * 64 + 8 * sub) = o;
    }
    __syncthreads();
}

__device__ __forceinline__ void sample_ssd_unit(const Args& A, LAS unsigned char* lds, int u, int tid) {
    const int sb = u >> 3, h = u & 7, g = h >> 2;
    LAS float* cvv = (LAS float*)lds;
    LAS float* dts = cvv + 1280;
    const float* SX = (const float*)(A.ws + WS_SMISC) + 128 * 512;
    float* SY = (float*)(A.ws + WS_SMISC) + 128 * 512 + 128 * 1024;
    for (int idx = tid; idx < 1280; idx += NTHR) {
        const int t = idx / 320, ci = idx - t * 320;
        int ch; if (ci < 64) ch = h * 64 + ci; else if (ci < 192) ch = 512 + g * 128 + (ci - 64); else ch = 768 + g * 128 + (ci - 192);
        float acc = A.in[12][ch];
#pragma unroll
        for (int i = 0; i < 4; ++i) {
            const int k = t + i;
            const float xv = (k < 3) ? A.in[4][(size_t)(sb * 3 + k) * 1024 + ch] : SX[(size_t)(sb * 4 + k - 3) * 1024 + ch];
            acc += xv * A.in[11][i * 1024 + ch];
        }
        cvv[idx] = silu_f(acc);
    }
    if (tid < 4) {
        const float d = softplus_f(((const float*)(A.ws + WS_DT))[(size_t)(MP + sb * 4 + tid) * 8 + h] + A.in[13][h]);
        dts[tid] = d; dts[4 + tid] = __expf(d * -__expf(A.in[14][h]));
    }
    __syncthreads();
    const int p = tid >> 3, n0 = (tid & 7) * 16;
    const float* sin_ = A.in[5] + ((size_t)(sb * 8 + h) * 64 + p) * 128 + n0;
    float hs[16];
#pragma unroll
    for (int i = 0; i < 4; ++i) { const f32x4 v = *(const f32x4*)(sin_ + 4 * i); hs[4 * i] = v[0]; hs[4 * i + 1] = v[1]; hs[4 * i + 2] = v[2]; hs[4 * i + 3] = v[3]; }
    const float dsk = A.in[15][h];
#pragma unroll
    for (int t = 0; t < 4; ++t) {
        const float dA = dts[4 + t], xv = cvv[t * 320 + p], xd = xv * dts[t];
        float part = 0.f;
#pragma unroll
        for (int i = 0; i < 16; ++i) { hs[i] = hs[i] * dA + xd * cvv[t * 320 + 64 + n0 + i]; part += cvv[t * 320 + 192 + n0 + i] * hs[i]; }
        part += __shfl_xor(part, 1); part += __shfl_xor(part, 2); part += __shfl_xor(part, 4);
        if ((tid & 7) == 0) SY[(size_t)(sb * 4 + t) * 512 + h * 64 + p] = part + dsk * xv;
    }
    float* so = A.out + O_SSS + ((size_t)(sb * 8 + h) * 64 + p) * 128 + n0;
#pragma unroll
    for (int i = 0; i < 4; ++i) *(f32x4*)(so + 4 * i) = (f32x4){hs[4 * i], hs[4 * i + 1], hs[4 * i + 2], hs[4 * i + 3]};
    __syncthreads();
}

__device__ __forceinline__ void sample_xattn_unit(const Args& A, LAS unsigned char* lds, int u, int tid, int wave, int lane) {
    const int sb = u >> 2, h = u & 3;
    LAS float* qs = (LAS float*)lds; LAS float* sc = qs + 1024; LAS float* red = sc + 1024;
    const bf16* XQ = (const bf16*)(A.ws + WS_A0);
    for (int i = tid; i < 1024; i += NTHR) qs[i] = bf2f(XQ[(size_t)(MP + sb * 4 + (i >> 8)) * 1024 + h * 256 + (i & 255)]);
    __syncthreads();
    const float* cmk = A.in[6]; const float* cmv = A.in[7];
    {
        f32x4 q[4];
#pragma unroll
        for (int t = 0; t < 4; ++t) q[t] = *(const LAS f32x4*)(qs + t * 256 + 4 * lane);
#pragma unroll 8
        for (int mi = 0; mi < 32; ++mi) {
            const int m = wave * 32 + mi;
            const f32x4 k4 = *(const f32x4*)(cmk + ((size_t)(sb * 256 + m) * 4 + h) * 256 + 4 * lane);
#pragma unroll
            for (int t = 0; t < 4; ++t) {
                float s = (q[t][0] * k4[0] + q[t][1] * k4[1]) + (q[t][2] * k4[2] + q[t][3] * k4[3]);
                s = wave_sum(s);
                if (lane == 0) sc[t * 256 + m] = s;
            }
        }
    }
    __syncthreads();
    if (wave < 4) {
        float v[4]; float m = -INFINITY;
#pragma unroll
        for (int i = 0; i < 4; ++i) { v[i] = sc[wave * 256 + lane + 64 * i]; m = fmaxf(m, v[i]); }
        m = wave_max(m);
        float sum = 0.f;
#pragma unroll
        for (int i = 0; i < 4; ++i) { v[i] = __expf(v[i] - m); sum += v[i]; }
        sum = wave_sum(sum);
        const float is = 1.f / sum;
#pragma unroll
        for (int i = 0; i < 4; ++i) sc[wave * 256 + lane + 64 * i] = v[i] * is;
    }
    __syncthreads();
    {
        f32x4 o[4];
#pragma unroll
        for (int t = 0; t < 4; ++t) o[t] = (f32x4){0.f, 0.f, 0.f, 0.f};
#pragma unroll 8
        for (int mi = 0; mi < 32; ++mi) {
            const int m = wave * 32 + mi;
            const f32x4 v = *(const f32x4*)(cmv + ((size_t)(sb * 256 + m) * 4 + h) * 256 + 4 * lane);
#pragma unroll
            for (int t = 0; t < 4; ++t) o[t] = o[t] + v * sc[t * 256 + m];
        }
#pragma unroll
        for (int t = 0; t < 4; ++t) *(LAS f32x4*)(red + (wave * 4 + t) * 256 + 4 * lane) = o[t];
    }
    __syncthreads();
    {
        bf16* XO = (bf16*)(A.ws + WS_MIX);
        for (int i = tid; i < 1024; i += NTHR) {
            const int t = i >> 8, d = i & 255; float a = 0.f;
#pragma unroll
            for (int w2 = 0; w2 < 8; ++w2) a += red[(w2 * 4 + t) * 256 + d];
            XO[(size_t)(MP + sb * 4 + t) * 1024 + h * 256 + d] = f2bf(a);
        }
    }
    __syncthreads();
}

#ifndef N_LAUNCHES
#define N_LAUNCHES 1
#endif
constexpr int NPHASE = 13;

__global__ void __launch_bounds__(NTHR, 2) mega_fwd(Args A) {
    extern __shared__ __attribute__((aligned(16))) unsigned char lds_raw[];
    LAS unsigned char* lds = (LAS unsigned char*)lds_raw;
    cg::grid_group grid = cg::this_grid();
    const int tid = threadIdx.x, lane = tid & 63, wave = __builtin_amdgcn_readfirstlane(tid >> 6);
    const int G = gridDim.x, bid = blockIdx.x;
    unsigned char* ws = A.ws;
    const int lo = A.ph_lo, hi = A.ph_hi;
    volatile LAS unsigned* bst = (volatile LAS unsigned*)(lds + LDS_BYTES - 16);
    if (tid < 4) bst[tid] = 0u;
    unsigned* barw = (unsigned*)ws;
    __syncthreads();
    if (lo < 0) grid.sync();
    XcdBarrier xbar = xcd_barrier_post(barw, bst);
#ifndef PHASE_MASK
#define PHASE_MASK 0xfff
#endif
#define IN(k) (((PHASE_MASK >> (k)) & 1) && lo <= (k) && (k) < hi)
#ifndef REPEAT_MASK
#define REPEAT_MASK 0
#endif
#if REPEAT_MASK == 0
#define PH(k) if (IN(k))
#define rep_ 0
#else
#define PH(k) for (int rep_ = 0; rep_ < 1 + ((REPEAT_MASK >> (k)) & 1); ++rep_) if (IN(k))
#endif
#define SEAM(k) do { if (IN(k) && IN((k) + 1)) xcd_barrier(xbar); } while (0)

    PH(0) { if (rep_) grid.sync(); p0_prologue(A, lds, tid, wave, lane); }
    SEAM(0);

    PH(1) { if (rep_) grid.sync();
        F1 f{(bf16*)(ws + WS_QB), (bf16*)(ws + WS_KB), (bf16*)(ws + WS_VB), (bf16*)(ws + WS_ZB), (bf16*)(ws + WS_XBC), A.out,
             (float*)(ws + WS_SMISC), (float*)(ws + WS_SMISC) + 128 * 512, (const float*)(ws + WS_COS), (const float*)(ws + WS_SIN)};
        {
            pg8::Gemm g{(const pg8::bf16_t*)(ws + WS_A0), (const pg8::bf16_t*)(ws + WS_WIN), MP, NIN, DM};
            pg8::StaticOrder S; S.init(MP, NIN, G, bid);
            EpiWrap<F1> E{f};
            pg8::gemm_phase<EpiWrap<F1>, pg8::StaticOrder, true, true>(lds, g, S, E);
        }
        for (int u = bid; u < 2 * (NIN / 32); u += G)
            small_gemm_unit<4>(lds, (const bf16*)(ws + WS_A0) + (size_t)(MP + (u & 1) * 64) * DM, MP + (u & 1) * 64, (const bf16*)(ws + WS_WIN), DM, (u >> 1) * 32, f, wave, lane);
        FMem fm{A.out, (bf16*)(ws + WS_MKB), (bf16*)(ws + WS_MVB)};
        for (int u = bid; u < 4 * 64; u += G) {
            const int rt = u >> 6, cn = u & 63;
            small_gemm_unit<8>(lds, (const bf16*)(ws + WS_AM) + (size_t)rt * 128 * DM, rt * 128, (const bf16*)(ws + WS_WMKV), DM, cn * 32, fm, wave, lane);
        }
    }
    SEAM(1);

    PH(2) { if (rep_) grid.sync();
        static_assert(CP_P7 == 512, "256 pass-1 units + 256 sample SSD units carry the 512 remaining copy chunks");
        for (int u = bid; u < 256; u += G) { f32x4 ck[8], cv[8]; cp_load<8>(A, (CP_P3 + u) * 4096, ck, cv, tid); ssd_pass1_unit(A, lds, u, tid, wave, lane); cp_store<8>(A, (CP_P3 + u) * 4096, ck, cv, tid); }
        for (int u = bid; u < SB * 8; u += G) { f32x4 ck[8], cv[8]; cp_load<8>(A, (CP_P3 + 256 + u) * 4096, ck, cv, tid); sample_ssd_unit(A, lds, u, tid); cp_store<8>(A, (CP_P3 + 256 + u) * 4096, ck, cv, tid); }
        for (int pu = bid * 4; pu < SB * 8 * ST; pu += G * 4) sample_attn_pair(A, lds, pu + (wave & 3), wave, lane);
        __syncthreads();
    }
    SEAM(2);

    PH(3) { if (rep_) grid.sync();
        {
            const float* st = (const float*)(ws + WS_STATE); bf16* hst = (bf16*)(ws + WS_HST); const float* dec = (const float*)(ws + WS_DEC);
            for (int e = bid * NTHR + tid; e < NBAT * 8 * 64 * 128; e += G * NTHR) {
                const int pn = e & 8191, h = (e >> 13) & 7, b = e >> 16;
                float hr = 0.f;
#pragma unroll 1
                for (int c0 = 0; c0 < 64; c0 += 32) {
                    float sv[32], dv[32];
#pragma unroll
                    for (int k = 0; k < 32; ++k) { sv[k] = st[((size_t)((b * 64 + c0 + k) * 8 + h)) * 8192 + pn]; dv[k] = dec[(b * 8 + h) * 64 + c0 + k]; }
#pragma unroll
                    for (int k = 0; k < 32; ++k) { hst[((size_t)((b * 64 + c0 + k) * 8 + h)) * 8192 + pn] = f2bf(hr); hr = hr * dv[k] + sv[k]; }
                }
                A.out[O_SSP + (size_t)(b * 8 + h) * 8192 + pn] = hr;
            }
        }
        dil_attn_phase(A, lds, tid, wave, lane);
    }
    SEAM(3);

    PH(4) { if (rep_) grid.sync();
        for (int u = bid; u < 256; u += G) ssd_pass2_unit(A, lds, u, tid, wave, lane);
        {
            const float* lse = (const float*)(ws + WS_LSE); const bf16* obr = (const bf16*)(ws + WS_OBR); bf16* mix = (bf16*)(ws + WS_MIX);
            for (int i0 = bid * NTHR + tid; i0 < MP * 64; i0 += 4 * G * NTHR) {
                float w0[4], w1[4], w2[4]; v4u a[4], b2[4], c2[4];
#pragma unroll
                for (int k = 0; k < 4; ++k) {
                    const int i = i0 + k * G * NTHR;
                    if (i < MP * 64) {
                        const int row = i >> 6, hc = i & 63, h = hc >> 3;
                        w0[k] = lse[(size_t)row * 8 + h]; w1[k] = lse[(size_t)MP * 8 + (size_t)row * 8 + h]; w2[k] = lse[(size_t)2 * MP * 8 + (size_t)row * 8 + h];
                        const size_t o = (size_t)row * 512 + hc * 8;
                        a[k] = *(const v4u*)(obr + o); b2[k] = *(const v4u*)(obr + (size_t)MP * 512 + o); c2[k] = *(const v4u*)(obr + (size_t)2 * MP * 512 + o);
                    }
                }
#pragma unroll
                for (int k = 0; k < 4; ++k) {
                    const int i = i0 + k * G * NTHR;
                    if (i < MP * 64) {
                        const int row = i >> 6, hc = i & 63;
                        const float m = fmaxf(w0[k], fmaxf(w1[k], w2[k]));
                        float e0 = __expf(w0[k] - m), e1 = __expf(w1[k] - m), e2 = __expf(w2[k] - m);
                        const float is = 1.f / (e0 + e1 + e2); e0 *= is; e1 *= is; e2 *= is;
                        v4u r;
                        r.x = pk2(e0 * bflo(a[k].x) + e1 * bflo(b2[k].x) + e2 * bflo(c2[k].x), e0 * bfhi(a[k].x) + e1 * bfhi(b2[k].x) + e2 * bfhi(c2[k].x));
                        r.y = pk2(e0 * bflo(a[k].y) + e1 * bflo(b2[k].y) + e2 * bflo(c2[k].y), e0 * bfhi(a[k].y) + e1 * bfhi(b2[k].y) + e2 * bfhi(c2[k].y));
                        r.z = pk2(e0 * bflo(a[k].z) + e1 * bflo(b2[k].z) + e2 * bflo(c2[k].z), e0 * bfhi(a[k].z) + e1 * bfhi(b2[k].z) + e2 * bfhi(c2[k].z));
                        r.w = pk2(e0 * bflo(a[k].w) + e1 * bflo(b2[k].w) + e2 * bflo(c2[k].w), e0 * bfhi(a[k].w) + e1 * bfhi(b2[k].w) + e2 * bfhi(c2[k].w));
                        *(v4u*)(mix + (size_t)row * 1024 + hc * 8) = r;
                    }
                }
            }
            const float* SY = (const float*)(ws + WS_SMISC) + 128 * 512 + 128 * 1024; const bf16* zb = (const bf16*)(ws + WS_ZB);
            for (int wu = bid * NWAVES + wave; wu < MS * 2; wu += G * NWAVES) {
                const int r = wu >> 1, g = wu & 1;
                const f32x4 y = *(const f32x4*)(SY + (size_t)r * 512 + g * 256 + 4 * lane);
                const v2u zz = *(const v2u*)(zb + (size_t)(MP + r) * 512 + g * 256 + 4 * lane);
                f32x4 uu = {y[0] * silu_f(bflo(zz.x)), y[1] * silu_f(bfhi(zz.x)), y[2] * silu_f(bflo(zz.y)), y[3] * silu_f(bfhi(zz.y))};
                const float s = wave_sum((uu[0] * uu[0] + uu[1] * uu[1]) + (uu[2] * uu[2] + uu[3] * uu[3]));
                const float rs = rsqrtf(s * (1.f / 256.f) + EPS);
                const f32x4 gg = *(const f32x4*)(A.in[16] + g * 256 + 4 * lane);
                v2u o; o.x = pk2(uu[0] * rs * gg[0], uu[1] * rs * gg[1]); o.y = pk2(uu[2] * rs * gg[2], uu[3] * rs * gg[3]);
                *(v2u*)(mix + (size_t)(MP + r) * 1024 + 512 + g * 256 + 4 * lane) = o;
            }
        }
    }
    SEAM(4);

    PH(5) { if (rep_) grid.sync();
        FRes<0> f{A.in[0], A.in[1], A.out, (bf16*)(ws + WS_XB), (float*)(ws + WS_SSQ1)};
        {
            pg8::Gemm g{(const pg8::bf16_t*)(ws + WS_MIX), (const pg8::bf16_t*)(ws + WS_WOUT), MP, DM, DM};
            pg8::StaticOrder S; S.init(MP, DM, G, bid);
            EpiWrap<FRes<0>> E{f};
            pg8::gemm_phase<EpiWrap<FRes<0>>, pg8::StaticOrder, true, true>(lds, g, S, E);
        }
        for (int u = bid; u < 8 * (DM / 32); u += G)
            small_gemm_unit<1>(lds, (const bf16*)(ws + WS_MIX) + (size_t)MP * DM + (size_t)(u & 7) * 16 * DM, MP + (u & 7) * 16, (const bf16*)(ws + WS_WOUT), DM, (u >> 3) * 32, f, wave, lane);
    }
    SEAM(5);

    PH(6) { if (rep_) grid.sync();
        FScale<0> f{(const float*)(ws + WS_SSQ1), (bf16*)(ws + WS_A0), DM, 0.0625f};
        {
            pg8::Gemm g{(const pg8::bf16_t*)(ws + WS_XB), (const pg8::bf16_t*)(ws + WS_WXQ), MP, DM, DM};
            pg8::StaticOrder S; S.init(MP, DM, G, bid);
            EpiWrap<FScale<0>> E{f};
            pg8::gemm_phase<EpiWrap<FScale<0>>, pg8::StaticOrder, true, true>(lds, g, S, E);
        }
        for (int u = bid; u < 8 * (DM / 32); u += G)
            small_gemm_unit<1>(lds, (const bf16*)(ws + WS_XB) + (size_t)MP * DM + (size_t)(u & 7) * 16 * DM, MP + (u & 7) * 16, (const bf16*)(ws + WS_WXQ), DM, (u >> 3) * 32, f, wave, lane);
    }
    SEAM(6);

    PH(7) { if (rep_) grid.sync();
        xattn_phase(A, lds, tid, wave, lane);
        for (int u = bid; u < SB * 4; u += G) sample_xattn_unit(A, lds, u, tid, wave, lane);
    }
    SEAM(7);

    PH(8) { if (rep_) grid.sync();
        FRes<1> f{nullptr, nullptr, A.out, (bf16*)(ws + WS_XB), (float*)(ws + WS_SSQ2)};
        {
            pg8::Gemm g{(const pg8::bf16_t*)(ws + WS_MIX), (const pg8::bf16_t*)(ws + WS_WXO), MP, DM, DM};
            pg8::StaticOrder S; S.init(MP, DM, G, bid);
            EpiWrap<FRes<1>> E{f};
            pg8::gemm_phase<EpiWrap<FRes<1>>, pg8::StaticOrder, true, true>(lds, g, S, E);
        }
        for (int u = bid; u < 8 * (DM / 32); u += G)
            small_gemm_unit<1>(lds, (const bf16*)(ws + WS_MIX) + (size_t)MP * DM + (size_t)(u & 7) * 16 * DM, MP + (u & 7) * 16, (const bf16*)(ws + WS_WXO), DM, (u >> 3) * 32, f, wave, lane);
    }
    SEAM(8);

    PH(9) { if (rep_) grid.sync();
        FScale<1> f{(const float*)(ws + WS_SSQ2), (bf16*)(ws + WS_U), DFF, 1.f};
        {
            pg8::Gemm g{(const pg8::bf16_t*)(ws + WS_XB), (const pg8::bf16_t*)(ws + WS_WUP), MP, DFF, DM};
            pg8::StaticOrder S; S.init(MP, DFF, G, bid);
            EpiWrap<FScale<1>> E{f};
            pg8::gemm_phase<EpiWrap<FScale<1>>, pg8::StaticOrder, true, true>(lds, g, S, E);
        }
        for (int u = bid; u < 2 * (DFF / 32); u += G)
            small_gemm_unit<4>(lds, (const bf16*)(ws + WS_XB) + (size_t)(MP + (u & 1) * 64) * DM, MP + (u & 1) * 64, (const bf16*)(ws + WS_WUP), DM, (u >> 1) * 32, f, wave, lane);
    }
    SEAM(9);

    PH(10) { if (rep_) grid.sync();
        FRes<1> f{nullptr, nullptr, A.out, (bf16*)(ws + WS_XB), (float*)(ws + WS_SSQ3)};
        {
            pg8::Gemm g{(const pg8::bf16_t*)(ws + WS_U), (const pg8::bf16_t*)(ws + WS_WDN), MP, DM, DFF};
            pg8::StaticOrder S; S.init(MP, DM, G, bid);
            EpiWrap<FRes<1>> E{f};
            pg8::gemm_phase<EpiWrap<FRes<1>>, pg8::StaticOrder, true, true>(lds, g, S, E);
        }
        for (int u = bid; u < 8 * (DM / 32); u += G)
            small_gemm_unit<1>(lds, (const bf16*)(ws + WS_U) + (size_t)MP * DFF + (size_t)(u & 7) * 16 * DFF, MP + (u & 7) * 16, (const bf16*)(ws + WS_WDN), DFF, (u >> 3) * 32, f, wave, lane);
    }
    SEAM(10);

    PH(11) { if (rep_) grid.sync();
        const float* ssq = (const float*)(ws + WS_SSQ3); const bf16* xb = (const bf16*)(ws + WS_XB);
        f32x4 gg[4];
#pragma unroll
        for (int j = 0; j < 4; ++j) gg[j] = *(const f32x4*)(A.in[27] + 4 * lane + 256 * j);
        const int r0 = bid * NWAVES + wave, rstep = G * NWAVES;
        v2u nv[4]; float nrs = 0.f;
        if (r0 < MT) {
            nrs = rstd_from(ssq, r0);
#pragma unroll
            for (int j = 0; j < 4; ++j) nv[j] = *(const v2u*)(xb + (size_t)r0 * DM + 4 * lane + 256 * j);
        }
        for (int row = r0; row < MT; row += rstep) {
            v2u v[4]; const float rs = nrs;
#pragma unroll
            for (int j = 0; j < 4; ++j) v[j] = nv[j];
            const int rn = row + rstep;
            if (rn < MT) {
                nrs = rstd_from(ssq, rn);
#pragma unroll
                for (int j = 0; j < 4; ++j) nv[j] = *(const v2u*)(xb + (size_t)rn * DM + 4 * lane + 256 * j);
            }
            float* y = (row < MP) ? A.out + O_YP + (size_t)row * DM : A.out + O_YS + (size_t)(row - MP) * DM;
#pragma unroll
            for (int j = 0; j < 4; ++j) *(f32x4*)(y + 4 * lane + 256 * j) = (f32x4){bflo(v[j].x), bfhi(v[j].x), bflo(v[j].y), bfhi(v[j].y)} * rs * gg[j];
        }
    }
#ifdef EXTRA_SYNCS
    if (hi == NPHASE && lo == 0) { for (int i = 0; i < EXTRA_SYNCS; ++i) grid.sync(); }
#endif
#undef IN
#undef SEAM
}

extern "C" void kernel_launch(void* const* d_in, const int* in_sizes, int n_in, void* d_out, int out_size, void* d_ws, size_t ws_size, hipStream_t stream) {
    static int grid = 0;
    if (grid == 0) {
        if (n_in != 28 || (size_t)out_size != O_END || ws_size < WS_END) { fprintf(stderr, "kernel_launch: unexpected shapes: n_in %d out %d ws %zu\n", n_in, out_size, ws_size); grid = -1; return; }
        int dev = 0, cus = 0, per_cu = 0;
        (void)hipGetDevice(&dev);
        (void)hipDeviceGetAttribute(&cus, hipDeviceAttributeMultiprocessorCount, dev);
        if (hipFuncSetAttribute((const void*)mega_fwd, hipFuncAttributeMaxDynamicSharedMemorySize, LDS_BYTES) != hipSuccess) { fprintf(stderr, "kernel_launch: hipFuncSetAttribute failed\n"); grid = -1; return; }
        if (hipOccupancyMaxActiveBlocksPerMultiprocessor(&per_cu, (const void*)mega_fwd, NTHR, LDS_BYTES) != hipSuccess || per_cu < 1) { fprintf(stderr, "kernel_launch: occupancy query says %d\n", per_cu); (void)hipGetLastError(); per_cu = 1; }
        grid = cus * 1;
        if (grid <= 0) grid = 256;
    }
    if (grid < 0) return;
    Args a{};
    for (int i = 0; i < 28; ++i) a.in[i] = (const float*)d_in[i];
    a.out = (float*)d_out; a.ws = (unsigned char*)d_ws;
    auto launch = [&](int lo, int hi) {
        a.ph_lo = lo; a.ph_hi = hi;
        (void)hipMemsetAsync(d_ws, 0, XCD_BAR_WORDS * 4, stream);
        void* args[] = {&a};
        hipError_t e = hipLaunchCooperativeKernel((const void*)mega_fwd, dim3(grid), dim3(NTHR), args, LDS_BYTES, stream);
        if (e != hipSuccess) fprintf(stderr, "kernel_launch: cooperative launch failed: %s (grid %d)\n", hipGetErrorString(e), grid);
    };
#if defined(PROBE_PHASE)
    launch(0, PROBE_PHASE + 1); launch(PROBE_PHASE, PROBE_PHASE + 1); if (PROBE_PHASE + 1 < NPHASE) launch(PROBE_PHASE + 1, NPHASE);
#elif N_LAUNCHES == 1
    launch(0, NPHASE);
#else
    for (int p = 0; p < NPHASE; ++p) launch(p, p + 1);
#endif
}
```

```cpp
#include <hip/hip_runtime.h>
#include <hip/hip_cooperative_groups.h>
#include <cstdio>
#include <cstdint>
namespace cg = cooperative_groups;
#define N_LAUNCHES 1
namespace pg8 {
#define PG8_LAS __attribute__((address_space(3)))
typedef unsigned short bf16_t;
typedef short bf16x8 __attribute__((ext_vector_type(8)));
typedef float f32x4 __attribute__((ext_vector_type(4)));
typedef unsigned u32x4 __attribute__((ext_vector_type(4)));
constexpr int BM = 256, BK = 64, HALF = 128, HTB = HALF * BK * 2  , STAGE_BYTES = 8 * HTB, NXCD = 8, WGM = 8;

__host__ __device__ __forceinline__ int lds_byte(int r, int c) { const int st = (r >> 4) * 2 + (c >> 5), rr = r & 15, cc = c & 31, ob = rr * 64 + cc * 2; return st * 1024 + (ob ^ (((ob >> 9) & 1) << 5)); }
__host__ __device__ __forceinline__ void stage_rc(int b, int& R, int& C) { const int st = b / 1024, sb = b % 1024, swz = sb ^ (((sb >> 9) & 1) << 5); R = (st >> 1) * 16 + swz / 64; C = (st & 1) * 32 + (swz % 64) / 2; }
__host__ __device__ __forceinline__ int perm32(int rho) { const int n = rho >> 4, i = rho & 15; return 8 * (i >> 2) + 4 * n + (i & 3); }

struct Unit { int pm, pn; };
struct Gemm { const bf16_t* A; const bf16_t* Bt; int M, N, K; };

struct StaticOrder {
    int nM, nN, nwg, G, c;
    __host__ __device__ void init(int M, int N, int G_, int c_) { nM = M / BM; nN = N / BM; nwg = nM * nN; G = G_; c = c_; }
    __host__ __device__ bool next(int i, Unit& u) const {
        const long L = (long)i * G + c; if (L >= nwg) return false;
        int wgid = (int)L; { const int q = nwg / NXCD, r = nwg % NXCD, xcd = wgid % NXCD, off = wgid / NXCD; wgid = (xcd < r ? xcd * (q + 1) : r * (q + 1) + (xcd - r) * q) + off; }
        const int nig = WGM * nN, gid = wgid / nig, fm = gid * WGM, gsz = (nM - fm) < WGM ? (nM - fm) : WGM;
        u.pm = fm + ((wgid % nig) % gsz); u.pn = (wgid % nig) / gsz; return true;
    }
    __device__ __forceinline__ void a_ready(const Unit&) const {}
    __device__ __forceinline__ void done(const Unit&) const {}
};
__device__ __forceinline__ unsigned cvt_pk_bf16(float lo, float hi) { unsigned r; asm volatile("v_cvt_pk_bf16_f32 %0, %1, %2" : "=v"(r) : "v"(lo), "v"(hi)); return r; }
template <class Epi, class Sched, bool ALIGN_EPI = false, bool SP2 = false>
__device__ __forceinline__ void gemm_phase(PG8_LAS unsigned char* lds, const Gemm g, const Sched& S, const Epi& E) {
    const int tid = threadIdx.x, wid = __builtin_amdgcn_readfirstlane(tid >> 6), lane = tid & 63, wr = wid >> 2, wc = wid & 3, fr = lane & 15, fq = lane >> 4;
    const int K = g.K, nt = K / BK;
    unsigned voffA[2], voffB[2];
#pragma unroll
    for (int i = 0; i < 2; ++i) { int R, C; stage_rc(tid * 16 + i * 8192, R, C); const int Rb = Epi::PERM ? ((R & ~31) + perm32(R & 31)) : R;
        voffA[i] = (unsigned)(R * K + C) * 2u; voffB[i] = (unsigned)(Rb * K + C) * 2u; }
    const size_t kstep = (size_t)(BK * 2);
    const size_t hstep = (size_t)HALF * K * 2;
    const size_t tstep = 2 * hstep;
    const unsigned ldsw = (unsigned)wid * 1024u;
    const int aoff = lds_byte(wr * 64 + fr, fq * 8), boff = lds_byte(wc * 32 + fr, fq * 8);
#define PG8_SA(b, h) (((b) * 2 + (h)) * HTB)
#define PG8_SB(b, h) ((4 + (b) * 2 + (h)) * HTB)
#define PG8_STAGE(bufoff, gbase, voff) do { _Pragma("unroll") for (int _i = 0; _i < 2; ++_i) \
        __builtin_amdgcn_global_load_lds((const unsigned*)((const char*)(gbase) + (voff)[_i]), (PG8_LAS unsigned*)(lds + (bufoff) + ldsw + _i * 8192), 16, 0, 0); } while (0)
#define PG8_LDA(dst, b, h) do { _Pragma("unroll") for (int m = 0; m < 4; ++m) _Pragma("unroll") for (int k = 0; k < 2; ++k) dst[m][k] = *(const PG8_LAS bf16x8*)(lds + PG8_SA(b, h) + aoff + m * 2048 + k * 1024); } while (0)
#define PG8_LDB(dst, b, h) do { _Pragma("unroll") for (int n = 0; n < 2; ++n) _Pragma("unroll") for (int k = 0; k < 2; ++k) dst[n][k] = *(const PG8_LAS bf16x8*)(lds + PG8_SB(b, h) + boff + n * 2048 + k * 1024); } while (0)
#define PG8_MMA(ai, bj, At, Bt) do { __builtin_amdgcn_s_setprio(1); _Pragma("unroll") for (int m = 0; m < 4; ++m) _Pragma("unroll") for (int n = 0; n < 2; ++n) _Pragma("unroll") for (int k = 0; k < 2; ++k) \
        acc[ai][bj][m][n] = __builtin_amdgcn_mfma_f32_16x16x32_bf16(Bt[n][k], At[m][k], acc[ai][bj][m][n], 0, 0, 0); __builtin_amdgcn_s_setprio(0); } while (0)
#define PG8_WAIT_V(n) asm volatile("s_waitcnt vmcnt(" #n ")" ::: "memory")
#define PG8_WAIT_L(n) asm volatile("s_waitcnt lgkmcnt(" #n ")" ::: "memory")
#define PG8_BAR __builtin_amdgcn_s_barrier()
#define PG8_SCHED __builtin_amdgcn_sched_barrier(0)
    Unit cur, nxt; int ui = 0;
    if (!S.next(0, cur)) return;
    f32x4 acc[2][2][4][2];
#pragma unroll
    for (int a = 0; a < 2; ++a)
#pragma unroll
        for (int b = 0; b < 2; ++b)
#pragma unroll
            for (int m = 0; m < 4; ++m)
#pragma unroll
                for (int n = 0; n < 2; ++n) acc[a][b][m][n] = (f32x4){0.f, 0.f, 0.f, 0.f};
    bf16x8 At[4][2], B0[2][2], B1[2][2];
    const char* cA = (const char*)g.A + (size_t)cur.pm * tstep; const char* cB = (const char*)g.Bt + (size_t)cur.pn * tstep;
    S.a_ready(cur);
    if constexpr (SP2) {
        PG8_STAGE(PG8_SB(0, 0), cB, voffB); PG8_STAGE(PG8_SB(0, 1), cB + hstep, voffB); PG8_STAGE(PG8_SA(0, 0), cA, voffA); PG8_STAGE(PG8_SA(0, 1), cA + hstep, voffA);
        if (wr == 1) PG8_BAR;
        PG8_WAIT_V(2); PG8_BAR;
        PG8_STAGE(PG8_SB(1, 0), cB + kstep, voffB); PG8_STAGE(PG8_SA(1, 0), cA + kstep, voffA); PG8_STAGE(PG8_SB(1, 1), cB + hstep + kstep, voffB);
        PG8_WAIT_V(6); PG8_BAR;
    } else {
        PG8_STAGE(PG8_SB(0, 0), cB, voffB); PG8_STAGE(PG8_SA(0, 0), cA, voffA); PG8_STAGE(PG8_SB(0, 1), cB + hstep, voffB); PG8_STAGE(PG8_SA(0, 1), cA + hstep, voffA);
        if (wr == 1) PG8_BAR;
        PG8_WAIT_V(4); PG8_BAR;
        PG8_STAGE(PG8_SB(1, 0), cB + kstep, voffB); PG8_STAGE(PG8_SA(1, 0), cA + kstep, voffA); PG8_STAGE(PG8_SB(1, 1), cB + hstep + kstep, voffB);
        PG8_WAIT_V(6); PG8_BAR;
    }
    for (;;) {
        const bool has_next = S.next(ui + 1, nxt);
        const char* nA = has_next ? (const char*)g.A + (size_t)nxt.pm * tstep : cA; const char* nB = has_next ? (const char*)g.Bt + (size_t)nxt.pn * tstep : cB;
        for (int t = 0; t < nt; t += 2) {
            const bool last = (t == nt - 2);
            const char* a1 = cA + (size_t)(t + 1) * kstep;
            const char* a2 = last ? nA : cA + (size_t)(t + 2) * kstep; const char* b2 = last ? nB : cB + (size_t)(t + 2) * kstep;
            const char* a3 = a2 + kstep; const char* b3 = b2 + kstep;
            if (last && has_next) S.a_ready(nxt);
            if constexpr (SP2) {
            PG8_LDB(B0, 0, 0); PG8_LDB(B1, 0, 1); PG8_SCHED; PG8_LDA(At, 0, 0); PG8_STAGE(PG8_SA(1, 1), a1 + hstep, voffA);
            PG8_WAIT_V(8); PG8_WAIT_L(0); PG8_BAR; PG8_MMA(0, 0, At, B0); PG8_MMA(0, 1, At, B1); PG8_BAR; PG8_SCHED;
            PG8_LDA(At, 0, 1); PG8_STAGE(PG8_SB(0, 0), b2, voffB); PG8_STAGE(PG8_SB(0, 1), b2 + hstep, voffB); PG8_STAGE(PG8_SA(0, 0), a2, voffA);
            PG8_WAIT_V(8); PG8_WAIT_L(0); PG8_BAR; PG8_MMA(1, 0, At, B0); PG8_MMA(1, 1, At, B1); PG8_BAR; PG8_SCHED;
            PG8_LDB(B0, 1, 0); PG8_LDB(B1, 1, 1); PG8_SCHED; PG8_LDA(At, 1, 0); PG8_STAGE(PG8_SA(0, 1), a2 + hstep, voffA);
            PG8_WAIT_V(8); PG8_WAIT_L(0); PG8_BAR; PG8_MMA(0, 0, At, B0); PG8_MMA(0, 1, At, B1); PG8_BAR; PG8_SCHED;
            PG8_LDA(At, 1, 1); PG8_STAGE(PG8_SB(1, 0), b3, voffB); PG8_STAGE(PG8_SB(1, 1), b3 + hstep, voffB); PG8_STAGE(PG8_SA(1, 0), a3, voffA);
            PG8_WAIT_V(8); PG8_WAIT_L(0); PG8_BAR; PG8_MMA(1, 0, At, B0); PG8_MMA(1, 1, At, B1); PG8_BAR; PG8_SCHED;
            } else {
            PG8_LDB(B0, 0, 0); PG8_SCHED; PG8_LDA(At, 0, 0); PG8_STAGE(PG8_SA(1, 1), a1 + hstep, voffA);
            PG8_WAIT_L(8); PG8_BAR; PG8_WAIT_L(0); PG8_MMA(0, 0, At, B0); PG8_BAR; PG8_SCHED;
            PG8_LDB(B1, 0, 1); PG8_STAGE(PG8_SB(0, 0), b2, voffB);
            PG8_BAR; PG8_WAIT_L(0); PG8_MMA(0, 1, At, B1); PG8_BAR;
            PG8_LDA(At, 0, 1); PG8_STAGE(PG8_SA(0, 0), a2, voffA);
            PG8_BAR; PG8_WAIT_L(0); PG8_MMA(1, 0, At, B0); PG8_BAR; PG8_SCHED;
            PG8_STAGE(PG8_SB(0, 1), b2 + hstep, voffB);
            PG8_WAIT_V(6); PG8_BAR; PG8_MMA(1, 1, At, B1); PG8_BAR;
            PG8_LDB(B0, 1, 0); PG8_SCHED; PG8_LDA(At, 1, 0); PG8_STAGE(PG8_SA(0, 1), a2 + hstep, voffA);
            PG8_WAIT_L(8); PG8_BAR; PG8_WAIT_L(0); PG8_MMA(0, 0, At, B0); PG8_BAR; PG8_SCHED;
            PG8_LDB(B1, 1, 1); PG8_STAGE(PG8_SB(1, 0), b3, voffB);
            PG8_BAR; PG8_WAIT_L(0); PG8_MMA(0, 1, At, B1); PG8_BAR;
            PG8_LDA(At, 1, 1); PG8_STAGE(PG8_SA(1, 0), a3, voffA);
            PG8_BAR; PG8_WAIT_L(0); PG8_MMA(1, 0, At, B0); PG8_BAR; PG8_SCHED;
            PG8_STAGE(PG8_SB(1, 1), b3 + hstep, voffB);
            PG8_WAIT_V(6); PG8_BAR; PG8_MMA(1, 1, At, B1); PG8_BAR;
            }
        }
        if constexpr (ALIGN_EPI) { if (wr == 0) PG8_BAR; }
        if constexpr (!Epi::AFTER_DRAIN) { E(acc, cur, wr, wc, fr, fq); S.done(cur); }
        if (!has_next) break;
#pragma unroll
        for (int a = 0; a < 2; ++a)
#pragma unroll
            for (int b = 0; b < 2; ++b)
#pragma unroll
                for (int m = 0; m < 4; ++m)
#pragma unroll
                    for (int n = 0; n < 2; ++n) acc[a][b][m][n] = (f32x4){0.f, 0.f, 0.f, 0.f};
        cur = nxt; cA = nA; cB = nB; ++ui;
        if constexpr (ALIGN_EPI) { if (wr == 1) PG8_BAR; }
    }
    PG8_WAIT_V(0);
    if constexpr (!ALIGN_EPI) { if (wr == 0) PG8_BAR; }
    PG8_BAR;
    if constexpr (Epi::AFTER_DRAIN) { E.fused(acc, cur, wr, wc, fr, fq, lds, wid, lane); S.done(cur); }
#undef PG8_SA
#undef PG8_SB
#undef PG8_STAGE
#undef PG8_LDA
#undef PG8_LDB
#undef PG8_MMA
#undef PG8_WAIT_V
#undef PG8_WAIT_L
#undef PG8_BAR
#undef PG8_SCHED
}
}

#define LAS __attribute__((address_space(3)))
typedef unsigned short bf16;
typedef unsigned v4u __attribute__((ext_vector_type(4)));
typedef unsigned v2u __attribute__((ext_vector_type(2)));
typedef float f32x4 __attribute__((ext_vector_type(4)));
typedef short bf16x8 __attribute__((ext_vector_type(8)));
#define LDS_WAIT() asm volatile("s_waitcnt lgkmcnt(0)" ::: "memory")
__device__ __forceinline__ unsigned pk2(float lo, float hi) { return pg8::cvt_pk_bf16(lo, hi); }
__device__ __forceinline__ bf16 f2bf(float f) { return (bf16)(pg8::cvt_pk_bf16(f, 0.f) & 0xffffu); }
__device__ __forceinline__ float bf2f(unsigned b) { return __uint_as_float((b & 0xffffu) << 16); }
__device__ __forceinline__ float bflo(unsigned w) { return __uint_as_float(w << 16); }
__device__ __forceinline__ float bfhi(unsigned w) { return __uint_as_float(w & 0xffff0000u); }
__device__ __forceinline__ float wave_sum(float v) {
#pragma unroll
    for (int o = 1; o < 64; o <<= 1) v += __shfl_xor(v, o);
    return v;
}
__device__ __forceinline__ float wave_max(float v) {
#pragma unroll
    for (int o = 1; o < 64; o <<= 1) v = fmaxf(v, __shfl_xor(v, o));
    return v;
}
__device__ __forceinline__ float sum16(float v) { v += __shfl_xor(v, 1); v += __shfl_xor(v, 2); v += __shfl_xor(v, 4); v += __shfl_xor(v, 8); return v; }
__device__ __forceinline__ float max16(float v) { v = fmaxf(v, __shfl_xor(v, 1)); v = fmaxf(v, __shfl_xor(v, 2)); v = fmaxf(v, __shfl_xor(v, 4)); v = fmaxf(v, __shfl_xor(v, 8)); return v; }
__device__ __forceinline__ float silu_f(float v) { return v / (1.f + __expf(-v)); }
__device__ __forceinline__ float softplus_f(float x) { return fmaxf(x, 0.f) + log1pf(__expf(-fabsf(x))); }
__device__ __forceinline__ f32x4 mfma16(bf16x8 a, bf16x8 b, f32x4 c) { return __builtin_amdgcn_mfma_f32_16x16x32_bf16(a, b, c, 0, 0, 0); }

#define XB_TMO      128
#define XB_XCNT(j)  (256  + 64 * (j))
#define XB_XSUB(j)  (1280 + 64 * (j))
#define XB_XGEN(j)  (2304 + 64 * (j))
#define XB_TOP      3328
#define XB_TOPGEN   3392
#define XCD_BAR_WORDS 3456
#define XB_SPIN_CAP (1u << 18)

__device__ __forceinline__ unsigned xb_ld(unsigned* p)              { return __hip_atomic_load(p, __ATOMIC_RELAXED, __HIP_MEMORY_SCOPE_AGENT); }
__device__ __forceinline__ unsigned xb_add(unsigned* p, unsigned v) { return __hip_atomic_fetch_add(p, v, __ATOMIC_RELAXED, __HIP_MEMORY_SCOPE_AGENT); }
__device__ __forceinline__ unsigned xb_xcc_id() { return (unsigned)__builtin_amdgcn_s_getreg((3 << 11) | 20) & 0xFu; }
#define XB_SPIN(cond, bar) do { unsigned _sp = 0; while (cond) { __builtin_amdgcn_s_sleep(1); \
    if ((++_sp & 255u) == 0u) { if (xb_ld(&(bar)[XB_TMO])) break; if (_sp > XB_SPIN_CAP) { atomicAdd(&(bar)[XB_TMO], 1u); break; } } } } while (0)

struct XcdBarrier {
    unsigned* bar; unsigned x;
    volatile LAS unsigned* st;
};

__device__ __forceinline__ XcdBarrier xcd_barrier_post(unsigned* bar, volatile LAS unsigned* st) {
    XcdBarrier b; b.bar = bar; b.x = xb_xcc_id(); b.st = st;
    if (threadIdx.x == 0) (void)xb_add(&bar[XB_XCNT(b.x)], 1u);
    return b;
}
__device__ __forceinline__ void xcd_barrier_complete(unsigned* bar, unsigned x, unsigned& nloc, unsigned& nx) {
    const unsigned G = gridDim.x * gridDim.y * gridDim.z;
    unsigned sum, cnt, mine, sp = 0u;
    for (;;) {
        sum = 0u; cnt = 0u; mine = 0u;
#pragma unroll
        for (unsigned j = 0; j < 16; ++j) { const unsigned c = xb_ld(&bar[XB_XCNT(j)]); sum += c; cnt += (c > 0u) ? 1u : 0u; mine = (j == x) ? c : mine; }
        if (sum == G) break;
        __builtin_amdgcn_s_sleep(1);
        if ((++sp & 255u) == 0u) { if (xb_ld(&bar[XB_TMO])) break; if (sp > XB_SPIN_CAP) { atomicAdd(&bar[XB_TMO], 1u); break; } }
    }
    nloc = mine > 0u ? mine : 1u; nx = cnt > 0u ? cnt : 1u;
}

__device__ __forceinline__ void xcd_barrier(const XcdBarrier& b) {
    asm volatile("s_waitcnt vmcnt(0)" ::: "memory");
    __syncthreads();
    if (threadIdx.x == 0) {
        unsigned* bar = b.bar;
        __builtin_amdgcn_s_waitcnt(0);
        unsigned nloc = b.st[0], nx = b.st[1];
        if (nloc == 0u) { xcd_barrier_complete(bar, b.x, nloc, nx); b.st[0] = nloc; b.st[1] = nx; }
        const unsigned old = xb_add(&bar[XB_XSUB(b.x)], 1u);
        const unsigned gen = old / nloc;
        if (old + 1u == (gen + 1u) * nloc) {
            __builtin_amdgcn_fence(__ATOMIC_RELEASE, "agent");
            asm volatile("s_waitcnt vmcnt(0)" ::: "memory");
            const unsigned og = xb_add(&bar[XB_TOP], 1u);
            const unsigned tg = og / nx;
            if (og + 1u == (tg + 1u) * nx) xb_add(&bar[XB_TOPGEN], 1u);
            else XB_SPIN(xb_ld(&bar[XB_TOPGEN]) == tg, bar);
            __builtin_amdgcn_fence(__ATOMIC_ACQUIRE, "agent");
            xb_add(&bar[XB_XGEN(b.x)], 1u);
            asm volatile("s_waitcnt vmcnt(0)" ::: "memory");
        } else {
            XB_SPIN(xb_ld(&bar[XB_XGEN(b.x)]) == gen, bar);
            __builtin_amdgcn_fence(__ATOMIC_ACQUIRE, "agent");
            asm volatile("s_waitcnt vmcnt(0)" ::: "memory");
        }
    }
    __syncthreads();
}

constexpr int DM = 1024, SEQ = 8192, NBAT = 2, MP = NBAT * SEQ, SB = 32, ST = 4, MS = SB * ST, MT = MP + MS;
constexpr int NIN = 3072, INW = 3080, DFF = 4096, NMEM = 256, LW = 2048;
constexpr float EPS = 1e-6f;
constexpr int NWAVES = 8, NTHR = 512;
constexpr int LDS_BYTES = 147456;

constexpr size_t O_YP = 0, O_YS = O_YP + (size_t)MP * DM, O_WKP = O_YS + (size_t)MS * DM, O_WVP = O_WKP + (size_t)NBAT * LW * 512,
    O_CVP = O_WVP + (size_t)NBAT * LW * 512, O_SSP = O_CVP + (size_t)NBAT * 3 * 1024, O_MKP = O_SSP + (size_t)NBAT * 8 * 64 * 128,
    O_MVP = O_MKP + (size_t)NBAT * NMEM * 1024, O_WKS = O_MVP + (size_t)NBAT * NMEM * 1024, O_WVS = O_WKS + (size_t)SB * LW * 512,
    O_CVS = O_WVS + (size_t)SB * LW * 512, O_SSS = O_CVS + (size_t)SB * 3 * 1024, O_END = O_SSS + (size_t)SB * 8 * 64 * 128;

constexpr size_t MiB = 1u << 20;
constexpr size_t WS_WIN = 1 * MiB, WS_WOUT = 7 * MiB, WS_WXQ = 9 * MiB, WS_WMKV = 11 * MiB, WS_WXO = 15 * MiB, WS_WUP = 17 * MiB, WS_WDN = 25 * MiB;
constexpr size_t WS_COS = 33 * MiB, WS_SIN = 35 * MiB, WS_AM = 37 * MiB, WS_DT = 38 * MiB, WS_MKB = 39 * MiB, WS_MVB = 40 * MiB;
constexpr size_t WS_SSQ1 = 41 * MiB, WS_SSQ2 = 43 * MiB + 256 * 1024, WS_SSQ3 = 45 * MiB + 512 * 1024;
constexpr size_t WS_A0 = 48 * MiB;
constexpr size_t WS_MIX = 81 * MiB;
constexpr size_t WS_X = 114 * MiB;
constexpr size_t WS_XB = 179 * MiB;
constexpr size_t WS_QB = 212 * MiB, WS_KB = 229 * MiB, WS_VB = 246 * MiB, WS_ZB = 263 * MiB;
constexpr size_t WS_XBC = 280 * MiB;
constexpr size_t WS_OBR = 313 * MiB;
constexpr size_t WS_LSE = 361 * MiB;
constexpr size_t WS_STATE = 363 * MiB;
constexpr size_t WS_HST = 395 * MiB;
constexpr size_t WS_DEC = 411 * MiB;
constexpr size_t WS_SMISC = 412 * MiB;
constexpr size_t WS_XC = 413 * MiB;
constexpr size_t WS_U = 212 * MiB;
constexpr size_t WS_END = 446 * MiB;

struct Args { const float* in[28]; float* out; unsigned char* ws; int ph_lo, ph_hi; };

template <class F> struct EpiWrap {
    static constexpr bool PERM = true, AFTER_DRAIN = false;
    F f;
    __device__ __forceinline__ void operator()(const pg8::f32x4 (&acc)[2][2][4][2], const pg8::Unit& u, int wr, int wc, int fr, int fq) const {
#pragma unroll
        for (int ai = 0; ai < 2; ++ai) {
            float rs[4]; typename F::Pre pre[4][2];
#pragma unroll
            for (int m = 0; m < 4; ++m) {
                const int row = u.pm * 256 + ai * 128 + wr * 64 + m * 16 + fr;
                rs[m] = f.rowscale(row);
#pragma unroll
                for (int bj = 0; bj < 2; ++bj) pre[m][bj] = f.pre(row, u.pn * 256 + bj * 128 + wc * 32 + 8 * fq);
            }
#pragma unroll
            for (int m = 0; m < 4; ++m) {
                const int row = u.pm * 256 + ai * 128 + wr * 64 + m * 16 + fr;
#pragma unroll
                for (int bj = 0; bj < 2; ++bj) f.apply(row, u.pn * 256 + bj * 128 + wc * 32 + 8 * fq, acc[ai][bj][m][0], acc[ai][bj][m][1], rs[m], pre[m][bj]);
            }
        }
    }
};
struct NoPre {};

template <int RB, class F> __device__ __forceinline__ void small_gemm_unit(LAS unsigned char* lds, const bf16* A, int rowg0, const bf16* Bt, int K, int col0, const F& f, int wave, int lane) {
    const int fr = lane & 15, fq = lane >> 4;
    const int kw = K >> 3;
    const bf16* ap = A + (size_t)fr * K + wave * kw + 8 * fq;
    const bf16* bp0 = Bt + (size_t)(col0 + pg8::perm32(fr)) * K + wave * kw + 8 * fq;
    const bf16* bp1 = Bt + (size_t)(col0 + pg8::perm32(16 + fr)) * K + wave * kw + 8 * fq;
    f32x4 acc[RB][2];
#pragma unroll
    for (int rb = 0; rb < RB; ++rb) { acc[rb][0] = (f32x4){0.f, 0.f, 0.f, 0.f}; acc[rb][1] = (f32x4){0.f, 0.f, 0.f, 0.f}; }
#pragma unroll(RB == 1 ? 8 : 2)
    for (int k0 = 0; k0 < kw; k0 += 32) {
        const bf16x8 b0 = *(const bf16x8*)(bp0 + k0), b1 = *(const bf16x8*)(bp1 + k0);
        bf16x8 a[RB];
#pragma unroll
        for (int rb = 0; rb < RB; ++rb) a[rb] = *(const bf16x8*)(ap + (size_t)rb * 16 * K + k0);
#pragma unroll
        for (int rb = 0; rb < RB; ++rb) { acc[rb][0] = mfma16(b0, a[rb], acc[rb][0]); acc[rb][1] = mfma16(b1, a[rb], acc[rb][1]); }
    }
#pragma unroll
    for (int rb = 0; rb < RB; ++rb) {
        *(LAS f32x4*)(lds + ((wave * RB + rb) * 2 + 0) * 1024 + lane * 16) = acc[rb][0];
        *(LAS f32x4*)(lds + ((wave * RB + rb) * 2 + 1) * 1024 + lane * 16) = acc[rb][1];
    }
    LDS_WAIT(); __builtin_amdgcn_s_barrier(); asm volatile("" ::: "memory");
    if (wave < RB) {
        f32x4 c0 = {0.f, 0.f, 0.f, 0.f}, c1 = {0.f, 0.f, 0.f, 0.f};
#pragma unroll
        for (int w2 = 0; w2 < 8; ++w2) {
            c0 = c0 + *(const LAS f32x4*)(lds + ((w2 * RB + wave) * 2 + 0) * 1024 + lane * 16);
            c1 = c1 + *(const LAS f32x4*)(lds + ((w2 * RB + wave) * 2 + 1) * 1024 + lane * 16);
        }
        const int row = rowg0 + wave * 16 + fr;
        const float rs = f.rowscale(row);
        const typename F::Pre pre = f.pre(row, col0 + 8 * fq);
        f.apply(row, col0 + 8 * fq, c0, c1, rs, pre);
    }
    LDS_WAIT(); __builtin_amdgcn_s_barrier(); asm volatile("" ::: "memory");
}

__device__ __forceinline__ v4u pack8(f32x4 v0, f32x4 v1) { v4u w; w.x = pk2(v0[0], v0[1]); w.y = pk2(v0[2], v0[3]); w.z = pk2(v1[0], v1[1]); w.w = pk2(v1[2], v1[3]); return w; }

struct F1 {
    bf16 *Qb, *Kb, *Vb, *Zb, *XBCb; float* out; float *SQ, *SXBC; const float *cosT, *sinT;
    typedef NoPre Pre;
    __device__ __forceinline__ float rowscale(int) const { return 1.f; }
    __device__ __forceinline__ Pre pre(int, int) const { return Pre{}; }
    __device__ __forceinline__ void apply(int row, int col, f32x4 v0, f32x4 v1, float, const Pre&) const {
        const bool samp = row >= MP;
        int b, t, pos;
        if (!samp) { b = row >> 13; t = row & 8191; pos = t; } else { b = (row - MP) >> 2; t = (row - MP) & 3; pos = SEQ + t; }
        if (col < 1024) {
            const int isk = col >> 9, c = col & 511, hd = c >> 6, i0 = (c & 63) >> 1;
            const f32x4 cs = *(const f32x4*)(cosT + pos * 32 + i0), sn = *(const f32x4*)(sinT + pos * 32 + i0);
            const f32x4 t1 = {v0[0], v0[2], v1[0], v1[2]}, t2 = {v0[1], v0[3], v1[1], v1[3]};
            const f32x4 a = t1 * cs - t2 * sn, bb = t2 * cs + t1 * sn;
            v4u w; w.x = pk2(a[0], bb[0]); w.y = pk2(a[1], bb[1]); w.z = pk2(a[2], bb[2]); w.w = pk2(a[3], bb[3]);
            *(v4u*)((isk ? Kb : Qb) + (size_t)row * 512 + c) = w;
            float* o = nullptr;
            if (isk) {
                if (!samp) { if (t >= SEQ - LW) o = out + O_WKP + ((size_t)(b * LW + t - (SEQ - LW)) * 512 + hd * 64); }
                else o = out + O_WKS + ((size_t)(b * LW + LW - ST + t) * 512 + hd * 64);
            } else if (samp) o = SQ + (size_t)(row - MP) * 512 + hd * 64;
            if (o) { *(f32x4*)(o + i0) = a; *(f32x4*)(o + 32 + i0) = bb; }
        } else if (col < 1536) {
            const int c = col - 1024;
            *(v4u*)(Vb + (size_t)row * 512 + c) = pack8(v0, v1);
            float* o = nullptr;
            if (!samp) { if (t >= SEQ - LW) o = out + O_WVP + ((size_t)(b * LW + t - (SEQ - LW)) * 512 + c); }
            else o = out + O_WVS + ((size_t)(b * LW + LW - ST + t) * 512 + c);
            if (o) { *(f32x4*)o = v0; *(f32x4*)(o + 4) = v1; }
        } else if (col < 2048) {
            *(v4u*)(Zb + (size_t)row * 512 + (col - 1536)) = pack8(v0, v1);
        } else {
            const int c = col - 2048;
            *(v4u*)(XBCb + (size_t)row * 1024 + c) = pack8(v0, v1);
            if (!samp) { if (t >= SEQ - 3) { float* o = out + O_CVP + (size_t)(b * 3 + t - (SEQ - 3)) * 1024 + c; *(f32x4*)o = v0; *(f32x4*)(o + 4) = v1; } }
            else {
                float* o = SXBC + (size_t)(row - MP) * 1024 + c; *(f32x4*)o = v0; *(f32x4*)(o + 4) = v1;
                if (t >= 1) { float* o2 = out + O_CVS + (size_t)(b * 3 + t - 1) * 1024 + c; *(f32x4*)o2 = v0; *(f32x4*)(o2 + 4) = v1; }
            }
        }
    }
};
struct FMem {
    float* out; bf16 *MKb, *MVb;
    typedef NoPre Pre;
    __device__ __forceinline__ float rowscale(int) const { return 1.f; }
    __device__ __forceinline__ Pre pre(int, int) const { return Pre{}; }
    __device__ __forceinline__ void apply(int row, int col, f32x4 v0, f32x4 v1, float, const Pre&) const {
        const int isv = col >> 10, c = col & 1023;
        float* o = out + (isv ? O_MVP : O_MKP) + (size_t)row * 1024 + c; *(f32x4*)o = v0; *(f32x4*)(o + 4) = v1;
        *(v4u*)((isv ? MVb : MKb) + (size_t)row * 1024 + c) = pack8(v0, v1);
    }
};
template <int MODE  > struct FRes {
    const float *xp, *xs; float* out; bf16* Xb; float* ssq;
    struct Pre { f32x4 r0, r1; };
    __device__ __forceinline__ float rowscale(int row) const { return (MODE == 0) ? xs[row] : 1.f; }
    __device__ __forceinline__ Pre pre(int row, int col) const {
        Pre p;
        const v4u w = *(const v4u*)(((MODE == 0) ? (const bf16*)xp : (const bf16*)Xb) + (size_t)row * DM + col);
        p.r0 = (f32x4){bflo(w.x), bfhi(w.x), bflo(w.y), bfhi(w.y)}; p.r1 = (f32x4){bflo(w.z), bfhi(w.z), bflo(w.w), bfhi(w.w)};
        return p;
    }
    __device__ __forceinline__ void apply(int row, int col, f32x4 v0, f32x4 v1, float rsc, const Pre& pr) const {
        if (MODE == 0) { v0 = v0 + pr.r0 * rsc; v1 = v1 + pr.r1 * rsc; } else { v0 = v0 + pr.r0; v1 = v1 + pr.r1; }
        if (MODE == 2) { float* d = (row < MP) ? out + O_YP + (size_t)row * DM : out + O_YS + (size_t)(row - MP) * DM; *(f32x4*)(d + col) = v0; *(f32x4*)(d + col + 4) = v1; }
        else *(v4u*)(Xb + (size_t)row * DM + col) = pack8(v0, v1);
        float s = (v0[0] * v0[0] + v0[1] * v0[1]) + (v0[2] * v0[2] + v0[3] * v0[3]) + (v1[0] * v1[0] + v1[1] * v1[1]) + (v1[2] * v1[2] + v1[3] * v1[3]);
        s += __shfl_xor(s, 16); s += __shfl_xor(s, 32);
        if ((threadIdx.x & 48) == 0) ssq[(size_t)row * 32 + (col >> 5)] = s;
    }
};
__device__ __forceinline__ float rstd_from(const float* ssq, int row) {
    const f32x4* p = (const f32x4*)(ssq + (size_t)row * 32 + 8 * ((threadIdx.x >> 4) & 3));
    const f32x4 a = p[0] + p[1];
    float t = (a[0] + a[1]) + (a[2] + a[3]);
    t += __shfl_xor(t, 16); t += __shfl_xor(t, 32);
    return rsqrtf(t * (1.f / DM) + EPS);
}
template <int ACT  > struct FScale {
    const float* ssq; bf16* O; int ldo; float mul;
    typedef NoPre Pre;
    __device__ __forceinline__ float rowscale(int row) const { return rstd_from(ssq, row) * mul; }
    __device__ __forceinline__ Pre pre(int, int) const { return Pre{}; }
    __device__ __forceinline__ void apply(int row, int col, f32x4 v0, f32x4 v1, float rs, const Pre&) const {
        v0 = v0 * rs; v1 = v1 * rs;
        if (ACT == 1) {
#pragma unroll
            for (int i = 0; i < 4; ++i) { const float a = fmaxf(v0[i], 0.f), b = fmaxf(v1[i], 0.f); v0[i] = a * a; v1[i] = b * b; }
        }
        *(v4u*)(O + (size_t)row * ldo + col) = pack8(v0, v1);
    }
};

struct TrD { const float* W; const float* g; bf16* WT; int ldw, K, row_off, nblk, r, perm; };
__device__ __forceinline__ TrD tr_desc(const Args& A, unsigned char* ws, int it) {
    constexpr int I_IN = 16 * 96, I_SQ = 16 * 32, I_UP = 16 * 128;
    TrD d; int r = it;
    if (r < I_IN) { d.W = A.in[10]; d.g = A.in[9]; d.WT = (bf16*)(ws + WS_WIN); d.ldw = INW; d.K = DM; d.row_off = 0; d.nblk = 96; d.r = r; d.perm = 1; return d; } r -= I_IN;
    if (r < I_SQ) { d.W = A.in[17]; d.g = nullptr; d.WT = (bf16*)(ws + WS_WOUT); d.ldw = DM; d.K = DM; d.row_off = 0; d.nblk = 32; d.r = r; d.perm = 0; return d; } r -= I_SQ;
    if (r < I_SQ) { d.W = A.in[20]; d.g = A.in[18]; d.WT = (bf16*)(ws + WS_WXQ); d.ldw = DM; d.K = DM; d.row_off = 0; d.nblk = 32; d.r = r; d.perm = 0; return d; } r -= I_SQ;
    if (r < I_SQ) { d.W = A.in[21]; d.g = nullptr; d.WT = (bf16*)(ws + WS_WMKV); d.ldw = DM; d.K = DM; d.row_off = 0; d.nblk = 32; d.r = r; d.perm = 0; return d; } r -= I_SQ;
    if (r < I_SQ) { d.W = A.in[22]; d.g = nullptr; d.WT = (bf16*)(ws + WS_WMKV); d.ldw = DM; d.K = DM; d.row_off = 1024; d.nblk = 32; d.r = r; d.perm = 0; return d; } r -= I_SQ;
    if (r < I_SQ) { d.W = A.in[23]; d.g = nullptr; d.WT = (bf16*)(ws + WS_WXO); d.ldw = DM; d.K = DM; d.row_off = 0; d.nblk = 32; d.r = r; d.perm = 0; return d; } r -= I_SQ;
    if (r < I_UP) { d.W = A.in[25]; d.g = A.in[24]; d.WT = (bf16*)(ws + WS_WUP); d.ldw = DFF; d.K = DM; d.row_off = 0; d.nblk = 128; d.r = r; d.perm = 0; return d; } r -= I_UP;
    d.W = A.in[26]; d.g = nullptr; d.WT = (bf16*)(ws + WS_WDN); d.ldw = DM; d.K = DFF; d.row_off = 0; d.nblk = 32; d.r = r; d.perm = 0; return d;
}
__device__ __forceinline__ void tr_load(const TrD& d, float (&wv)[32], f32x4 (&gq)[2], int lane) {
    const int kb = d.r / d.nblk, nb = d.r % d.nblk, k0 = 64 * kb, n0 = 32 * nb;
#pragma unroll
    for (int i = 0; i < 32; ++i) { const int kk = 2 * i + (lane >> 5); wv[i] = d.W[(size_t)(k0 + kk) * d.ldw + n0 + (lane & 31)]; }
    gq[0] = (f32x4){1.f, 1.f, 1.f, 1.f}; gq[1] = gq[0];
    if (d.g) { gq[0] = *(const f32x4*)(d.g + k0 + 8 * (lane & 7)); gq[1] = *(const f32x4*)(d.g + k0 + 8 * (lane & 7) + 4); }
}
__device__ __forceinline__ void tr_finish(const TrD& d, const float (&wv)[32], const f32x4 (&gq)[2], LAS float* scr, int lane) {
    const int kb = d.r / d.nblk, nb = d.r % d.nblk, k0 = 64 * kb, n0 = 32 * nb;
#pragma unroll
    for (int i = 0; i < 32; ++i) { const int kk = 2 * i + (lane >> 5); scr[kk * 33 + (lane & 31)] = wv[i]; }
    LDS_WAIT();
    const int c = lane & 7;
#pragma unroll
    for (int j = 0; j < 4; ++j) {
        const int n = (lane >> 3) + 8 * j; const LAS float* s = scr + (8 * c) * 33 + n;
        v4u o; o.x = pk2(s[0 * 33] * gq[0][0], s[1 * 33] * gq[0][1]); o.y = pk2(s[2 * 33] * gq[0][2], s[3 * 33] * gq[0][3]);
        o.z = pk2(s[4 * 33] * gq[1][0], s[5 * 33] * gq[1][1]); o.w = pk2(s[6 * 33] * gq[1][2], s[7 * 33] * gq[1][3]);
        const int nsrc = n0 + n; int ndst = nsrc;
        if (d.perm && nsrc < 1024) { const int dd = nsrc & 63; ndst = (nsrc & ~63) + (dd < 32 ? 2 * dd : 2 * (dd - 32) + 1); }
        *(v4u*)(d.WT + (size_t)(d.row_off + ndst) * d.K + k0 + 8 * c) = o;
    }
    LDS_WAIT();
}

__device__ __forceinline__ void p0_prologue(const Args& A, LAS unsigned char* lds, int tid, int wave, int lane) {
    unsigned char* ws = A.ws;
    const int G = gridDim.x, gw = blockIdx.x * NWAVES + wave, NGW = G * NWAVES;
    const int gt = blockIdx.x * NTHR + tid, NGT = G * NTHR;
    {
        LAS float* scr = (LAS float*)(lds + wave * 16384);
        constexpr int I_IN = 16 * 96, I_SQ = 16 * 32, I_UP = 16 * 128, I_DN = 64 * 32;
        constexpr int NIT = I_IN + 5 * I_SQ + I_UP + I_DN;
        int it = gw;
        if (it < NIT) {
            float wv[32]; f32x4 gq[2];
            TrD d = tr_desc(A, ws, it);
            tr_load(d, wv, gq, lane);
            for (;;) {
                const int itn = it + NGW; const bool more = itn < NIT;
                float wn[32]; f32x4 gn[2];
                TrD dn = d;
                if (more) { dn = tr_desc(A, ws, itn); tr_load(dn, wn, gn, lane); }
                tr_finish(d, wv, gq, scr, lane);
                if (!more) break;
#pragma unroll
                for (int i = 0; i < 32; ++i) wv[i] = wn[i];
                gq[0] = gn[0]; gq[1] = gn[1]; d = dn; it = itn;
            }
        }
    }
    __syncthreads();
    LAS float* wdt = (LAS float*)lds;
    for (int i = tid; i < DM * 8; i += NTHR) { const int k = i >> 3, j = i & 7; wdt[i] = A.in[10][(size_t)k * INW + NIN + j] * A.in[9][k]; }
    __syncthreads();
    {
        bf16* A0 = (bf16*)(ws + WS_A0); float* dtr = (float*)(ws + WS_DT); float* xnrm = (float*)(ws + WS_DT + 768 * 1024);
        f32x4 nv[4];
        if (gw < MT) {
            const float* xr = (gw < MP) ? A.in[0] + (size_t)gw * DM : A.in[1] + (size_t)(gw - MP) * DM;
#pragma unroll
            for (int j = 0; j < 4; ++j) nv[j] = *(const f32x4*)(xr + 4 * lane + 256 * j);
        }
        for (int row = gw; row < MT; row += NGW) {
            f32x4 v[4]; float s = 0.f;
#pragma unroll
            for (int j = 0; j < 4; ++j) { v[j] = nv[j]; s += (v[j][0] * v[j][0] + v[j][1] * v[j][1]) + (v[j][2] * v[j][2] + v[j][3] * v[j][3]); }
            if (row + NGW < MT) {
                const int rn = row + NGW;
                const float* xr = (rn < MP) ? A.in[0] + (size_t)rn * DM : A.in[1] + (size_t)(rn - MP) * DM;
#pragma unroll
                for (int j = 0; j < 4; ++j) nv[j] = *(const f32x4*)(xr + 4 * lane + 256 * j);
            }
            const float rstd = rsqrtf(wave_sum(s) * (1.f / DM) + EPS);
            if (lane == 0) xnrm[row] = 1.f / rstd;
            float d[8] = {0.f, 0.f, 0.f, 0.f, 0.f, 0.f, 0.f, 0.f};
#pragma unroll
            for (int j = 0; j < 4; ++j) {
                v[j] = v[j] * rstd;
                v2u o; o.x = pk2(v[j][0], v[j][1]); o.y = pk2(v[j][2], v[j][3]);
                *(v2u*)(A0 + (size_t)row * DM + 4 * lane + 256 * j) = o;
#pragma unroll
                for (int e = 0; e < 4; ++e) {
                    const LAS f32x4* wp = (const LAS f32x4*)(wdt + (4 * lane + 256 * j + e) * 8);
                    const f32x4 w0 = wp[0], w1 = wp[1];
                    d[0] += v[j][e] * w0[0]; d[1] += v[j][e] * w0[1]; d[2] += v[j][e] * w0[2]; d[3] += v[j][e] * w0[3];
                    d[4] += v[j][e] * w1[0]; d[5] += v[j][e] * w1[1]; d[6] += v[j][e] * w1[2]; d[7] += v[j][e] * w1[3];
                }
            }
#pragma unroll
            for (int e = 0; e < 8; ++e) d[e] = wave_sum(d[e]);
            if (lane == 0) { *(f32x4*)(dtr + (size_t)row * 8) = (f32x4){d[0], d[1], d[2], d[3]}; *(f32x4*)(dtr + (size_t)row * 8 + 4) = (f32x4){d[4], d[5], d[6], d[7]}; }
        }
        bf16* Am = (bf16*)(ws + WS_AM);
        for (int row = gw; row < NBAT * NMEM; row += NGW) {
            const float* xr = A.in[8] + (size_t)row * DM;
            f32x4 v[4]; float s = 0.f;
#pragma unroll
            for (int j = 0; j < 4; ++j) { v[j] = *(const f32x4*)(xr + 4 * lane + 256 * j); s += (v[j][0] * v[j][0] + v[j][1] * v[j][1]) + (v[j][2] * v[j][2] + v[j][3] * v[j][3]); }
            const float rstd = rsqrtf(wave_sum(s) * (1.f / DM) + EPS);
#pragma unroll
            for (int j = 0; j < 4; ++j) {
                const f32x4 gg = *(const f32x4*)(A.in[19] + 4 * lane + 256 * j);
                v[j] = v[j] * rstd * gg;
                v2u o; o.x = pk2(v[j][0], v[j][1]); o.y = pk2(v[j][2], v[j][3]);
                *(v2u*)(Am + (size_t)row * DM + 4 * lane + 256 * j) = o;
            }
        }
    }
    {
        float* cosT = (float*)(ws + WS_COS); float* sinT = (float*)(ws + WS_SIN);
        for (int i = gt; i < (SEQ + ST) * 32; i += NGT) {
            const int pos = i >> 5, k = i & 31;
            const double inv = exp2(-(double)k * (13.287712379549449 / 32.0));
            const double rev = (double)pos * inv * 0.15915494309189535;
            const double fr = rev - floor(rev);
            const float f = (float)fr;
            cosT[i] = __builtin_amdgcn_cosf(f); sinT[i] = __builtin_amdgcn_sinf(f);
        }
    }
}

constexpr int KS_OFF = 0, KSTR = 72;
constexpr int VS_OFF = 36864;
constexpr int PS_OFF = 73728, PSTR = 264;
typedef short v4i16_t __attribute__((ext_vector_type(4)));

__device__ __forceinline__ bf16x8 tr_frag(const LAS unsigned char* tile, int row0, int col0, int strideel, int lane) {
    const int g = lane >> 4, i = lane & 15, q = i >> 2, p = i & 3;
    const LAS unsigned char* a = tile + ((row0 + 8 * g + q) * strideel + col0 + 4 * p) * 2;
    const v4i16_t lo = __builtin_amdgcn_ds_read_tr16_b64_v4i16((LAS v4i16_t*)a);
    const v4i16_t hi = __builtin_amdgcn_ds_read_tr16_b64_v4i16((LAS v4i16_t*)(a + 4 * strideel * 2));
    bf16x8 r; r[0] = lo[0]; r[1] = lo[1]; r[2] = lo[2]; r[3] = lo[3]; r[4] = hi[0]; r[5] = hi[1]; r[6] = hi[2]; r[7] = hi[3];
    return r;
}

constexpr int CP_PER = (LW - ST) * 128, CP_FULL = LW * 128, CP_CHUNKS = SB * CP_PER / 4096;
constexpr int CP_P7 = 512, CP_P3 = CP_CHUNKS - CP_P7;
static_assert(SB * CP_PER % 4096 == 0 && CP_P3 > 0 && 2 * CP_P3 <= 3072, "copy chunks: the dilated-attention units carry half chunks (2048 float4 per tensor)");
template <int NV> __device__ __forceinline__ void cp_load(const Args& A, int base, f32x4 (&ck)[NV], f32x4 (&cv)[NV], int tid) {
    const f32x4* srck = (const f32x4*)A.in[2]; const f32x4* srcv = (const f32x4*)A.in[3];
#pragma unroll
    for (int k = 0; k < NV; ++k) {
        const int i = base + k * NTHR + tid, sb = i / CP_PER, r = i - sb * CP_PER;
        const size_t so = (size_t)sb * CP_FULL + ST * 128 + r;
        ck[k] = __builtin_nontemporal_load(srck + so); cv[k] = __builtin_nontemporal_load(srcv + so);
    }
}
template <int NV> __device__ __forceinline__ void cp_store(const Args& A, int base, const f32x4 (&ck)[NV], const f32x4 (&cv)[NV], int tid) {
    f32x4* dstk = (f32x4*)(A.out + O_WKS); f32x4* dstv = (f32x4*)(A.out + O_WVS);
#pragma unroll
    for (int k = 0; k < NV; ++k) {
        const int i = base + k * NTHR + tid, sb = i / CP_PER, r = i - sb * CP_PER;
        const size_t dof = (size_t)sb * CP_FULL + r;
        __builtin_nontemporal_store(ck[k], dstk + dof); __builtin_nontemporal_store(cv[k], dstv + dof);
    }
}
struct DilUnit { const bf16 *Q, *K, *V; bf16* O; float* L; ptrdiff_t stride, lstride; bool has_prev; };
__device__ __forceinline__ DilUnit dil_unit(unsigned char* ws, int u) {
    const int br = u >> 10, rem = u & 1023, b = rem >> 9, h = (rem >> 6) & 7, sj = rem & 63;
    const int dil = br == 0 ? 1 : (br == 1 ? 4 : 16);
    const int r = sj % dil, j = sj / dil;
    const ptrdiff_t qrow = (ptrdiff_t)b * SEQ + (ptrdiff_t)j * 128 * dil + r, krow = qrow - (ptrdiff_t)128 * dil;
    DilUnit d;
    d.Q = (const bf16*)(ws + WS_QB) + qrow * 512 + h * 64; d.K = (const bf16*)(ws + WS_KB) + krow * 512 + h * 64; d.V = (const bf16*)(ws + WS_VB) + krow * 512 + h * 64;
    d.O = (bf16*)(ws + WS_OBR) + (size_t)br * MP * 512 + qrow * 512 + h * 64; d.L = (float*)(ws + WS_LSE) + (size_t)br * MP * 8 + qrow * 8 + h;
    d.stride = (ptrdiff_t)dil * 512; d.lstride = (ptrdiff_t)dil * 8; d.has_prev = j > 0;
    return d;
}
__device__ __forceinline__ void dil_load(const DilUnit& d, v4u (&kr)[4], v4u (&vr)[4], bf16x8& q0, bf16x8& q1, int tid, int wave, int lane) {
#pragma unroll
    for (int i = 0; i < 4; ++i) {
        const int idx = tid + NTHR * i, c = idx >> 3, ch = idx & 7;
        kr[i] = (v4u){0u, 0u, 0u, 0u}; vr[i] = (v4u){0u, 0u, 0u, 0u};
        if (d.has_prev || c >= 128) { kr[i] = *(const v4u*)(d.K + (ptrdiff_t)c * d.stride + ch * 8); vr[i] = *(const v4u*)(d.V + (ptrdiff_t)c * d.stride + ch * 8); }
    }
    const bf16* qrow = d.Q + (ptrdiff_t)(wave * 16 + (lane & 15)) * d.stride + 8 * (lane >> 4);
    q0 = *(const bf16x8*)qrow; q1 = *(const bf16x8*)(qrow + 32);
}

__device__ __forceinline__ void dil_attn_phase(const Args& A, LAS unsigned char* lds, int tid, int wave, int lane) {
    const int G = gridDim.x;
    int u = blockIdx.x;
    if (u >= 3072) return;
    const int fr = lane & 15, fq = lane >> 4;
    v4u kr[4], vr[4]; bf16x8 qn0, qn1;
    { const DilUnit fu = dil_unit(A.ws, u); dil_load(fu, kr, vr, qn0, qn1, tid, wave, lane); }
    LAS bf16* Pw = (LAS bf16*)(lds + PS_OFF + wave * 8448);
    f32x4 ck[4], cv[4]; int pend = -1;
    for (;;) {
        const DilUnit cu = dil_unit(A.ws, u);
#pragma unroll
        for (int i = 0; i < 4; ++i) {
            const int idx = tid + NTHR * i, c = idx >> 3, ch = idx & 7;
            *(LAS v4u*)(lds + KS_OFF + (c * KSTR + ch * 8) * 2) = kr[i];
            *(LAS v4u*)(lds + VS_OFF + (c * KSTR + ch * 8) * 2) = vr[i];
        }
        const bf16x8 q0 = qn0, q1 = qn1;
        LDS_WAIT(); __builtin_amdgcn_s_barrier(); asm volatile("" ::: "memory");
        const int un = u + G; const bool more = un < 3072;
        if (more) { const DilUnit nu = dil_unit(A.ws, un); dil_load(nu, kr, vr, qn0, qn1, tid, wave, lane); }
        if (pend >= 0) cp_store<4>(A, pend * 2048, ck, cv, tid);
        pend = -1;
        if (u < 2 * CP_P3) { cp_load<4>(A, u * 2048, ck, cv, tid); pend = u; }
        f32x4 s[9];
#pragma unroll
        for (int i = 0; i < 9; ++i) {
            const LAS unsigned char* kp = lds + KS_OFF + (((wave + i) * 16 + fr) * KSTR + 8 * fq) * 2;
            const bf16x8 k0 = *(const LAS bf16x8*)kp, k1 = *(const LAS bf16x8*)(kp + 64);
            s[i] = mfma16(k0, q0, (f32x4){0.f, 0.f, 0.f, 0.f}); s[i] = mfma16(k1, q1, s[i]);
        }
        float inv_own;
        {
            const int nbz = (wave & 1) ? wave - 1 : wave + 9;
            const int a = wave * 16 + fr;
            float m = -INFINITY;
#pragma unroll
            for (int i = 0; i < 9; ++i)
#pragma unroll
                for (int j = 0; j < 4; ++j) {
                    const int c = (wave + i) * 16 + 4 * fq + j;
                    const bool ok = (c >= a) && (c <= a + 128) && (cu.has_prev || c >= 128);
                    const float v = ok ? s[i][j] * 0.125f : -INFINITY;
                    s[i][j] = v; m = fmaxf(m, v);
                }
            m = fmaxf(m, __shfl_xor(m, 16)); m = fmaxf(m, __shfl_xor(m, 32));
            float sum = 0.f;
#pragma unroll
            for (int i = 0; i < 9; ++i) {
                const float p0 = __expf(s[i][0] - m), p1 = __expf(s[i][1] - m), p2 = __expf(s[i][2] - m), p3 = __expf(s[i][3] - m);
                sum += (p0 + p1) + (p2 + p3);
                v2u w; w.x = pk2(p0, p1); w.y = pk2(p2, p3);
                *(LAS v2u*)(Pw + fr * PSTR + (wave + i) * 16 + 4 * fq) = w;
            }
            *(LAS v2u*)(Pw + fr * PSTR + nbz * 16 + 4 * fq) = (v2u){0u, 0u};
            sum += __shfl_xor(sum, 16); sum += __shfl_xor(sum, 32);
            inv_own = 1.f / sum;
            if (fq == 0) cu.L[(ptrdiff_t)a * cu.lstride] = m + __logf(sum);
        }
        asm volatile("" ::: "memory");
        f32x4 o[4];
#pragma unroll
        for (int db = 0; db < 4; ++db) o[db] = (f32x4){0.f, 0.f, 0.f, 0.f};
#pragma unroll
        for (int kk = 0; kk < 5; ++kk) {
            const int ks = (wave >> 1) + kk;
            const bf16x8 pa = *(const LAS bf16x8*)(Pw + fr * PSTR + ks * 32 + 8 * fq);
#pragma unroll
            for (int db = 0; db < 4; ++db) o[db] = mfma16(tr_frag(lds + VS_OFF, ks * 32, db * 16, KSTR, lane), pa, o[db]);
        }
        {
            bf16* orow = cu.O + (ptrdiff_t)(wave * 16 + fr) * cu.stride + 4 * fq;
#pragma unroll
            for (int db = 0; db < 4; ++db) { v2u w; w.x = pk2(o[db][0] * inv_own, o[db][1] * inv_own); w.y = pk2(o[db][2] * inv_own, o[db][3] * inv_own); *(v2u*)(orow + db * 16) = w; }
        }
        LDS_WAIT(); __builtin_amdgcn_s_barrier(); asm volatile("" ::: "memory");
        if (!more) break;
        u = un;
    }
    if (pend >= 0) cp_store<4>(A, pend * 2048, ck, cv, tid);
}

__device__ __forceinline__ void xattn_load(v4u (&r)[4], const bf16* base, int dc, int tid) {
#pragma unroll
    for (int i = 0; i < 4; ++i) { const int idx = tid + NTHR * i, c = idx >> 3, ch = idx & 7; r[i] = *(const v4u*)(base + (size_t)c * 1024 + dc * 64 + ch * 8); }
}
__device__ __forceinline__ void xattn_store(LAS unsigned char* dst, const v4u (&r)[4], int tid) {
#pragma unroll
    for (int i = 0; i < 4; ++i) { const int idx = tid + NTHR * i, c = idx >> 3, ch = idx & 7; *(LAS v4u*)(dst + (c * KSTR + ch * 8) * 2) = r[i]; }
}
__device__ __forceinline__ void xattn_phase(const Args& A, LAS unsigned char* lds, int tid, int wave, int lane) {
    const int G = gridDim.x;
    const int fr = lane & 15, fq = lane >> 4;
    unsigned char* ws = A.ws;
    LAS bf16* Pw = (LAS bf16*)(lds + PS_OFF + wave * 8448);
    int u = blockIdx.x;
    if (u >= 512) return;
    v4u r0[4], r1[4];
    {
        const int b = u >> 8, h = u & 3; const bf16* Kp = (const bf16*)(ws + WS_MKB) + (size_t)b * NMEM * 1024 + h * 256;
        xattn_load(r0, Kp, 0, tid); xattn_load(r1, Kp, 1, tid);
        xattn_store(lds + KS_OFF, r0, tid); xattn_load(r0, Kp, 2, tid);
        LDS_WAIT(); __builtin_amdgcn_s_barrier(); asm volatile("" ::: "memory");
    }
    for (;;) {
        const int b = u >> 8, qt = (u & 255) >> 2, h = u & 3;
        const size_t row0 = (size_t)b * SEQ + qt * 128;
        const bf16* Qp = (const bf16*)(ws + WS_A0) + (row0 + wave * 16 + fr) * 1024 + h * 256 + 8 * fq;
        const bf16* Kp = (const bf16*)(ws + WS_MKB) + (size_t)b * NMEM * 1024 + h * 256;
        const bf16* Vp = (const bf16*)(ws + WS_MVB) + (size_t)b * NMEM * 1024 + h * 256;
        bf16* Op = (bf16*)(ws + WS_MIX) + row0 * 1024 + h * 256;
        const int un = u + G; const bool more = un < 512;
        const bf16* Kn = (const bf16*)(ws + WS_MKB) + (size_t)(un >> 8) * NMEM * 1024 + (un & 3) * 256;
        bf16x8 qn0 = *(const bf16x8*)Qp, qn1 = *(const bf16x8*)(Qp + 32);
        f32x4 s[16];
#pragma unroll
        for (int nb = 0; nb < 16; ++nb) s[nb] = (f32x4){0.f, 0.f, 0.f, 0.f};
#pragma unroll
        for (int dc = 0; dc < 4; ++dc) {
            if (dc == 0) { xattn_store(lds + VS_OFF, r1, tid); xattn_load(r1, Kp, 3, tid); }
            else if (dc == 1) { xattn_store(lds + KS_OFF, r0, tid); xattn_load(r0, Vp, 0, tid); }
            else if (dc == 2) { xattn_store(lds + VS_OFF, r1, tid); xattn_load(r1, Vp, 1, tid); }
            else { xattn_store(lds + KS_OFF, r0, tid); xattn_load(r0, Vp, 2, tid); }
            const bf16x8 q0 = qn0, q1 = qn1;
            if (dc < 3) { qn0 = *(const bf16x8*)(Qp + (dc + 1) * 64); qn1 = *(const bf16x8*)(Qp + (dc + 1) * 64 + 32); }
            const LAS unsigned char* kb = lds + ((dc & 1) ? VS_OFF : KS_OFF);
#pragma unroll
            for (int nb = 0; nb < 16; ++nb) {
                const LAS unsigned char* kp = kb + ((nb * 16 + fr) * KSTR + 8 * fq) * 2;
                const bf16x8 k0 = *(const LAS bf16x8*)kp, k1 = *(const LAS bf16x8*)(kp + 64);
                s[nb] = mfma16(k0, q0, s[nb]); s[nb] = mfma16(k1, q1, s[nb]);
            }
            LDS_WAIT(); __builtin_amdgcn_s_barrier(); asm volatile("" ::: "memory");
        }
        float inv_own;
        {
            float m = -INFINITY;
#pragma unroll
            for (int nb = 0; nb < 16; ++nb) m = fmaxf(fmaxf(m, fmaxf(s[nb][0], s[nb][1])), fmaxf(s[nb][2], s[nb][3]));
            m = fmaxf(m, __shfl_xor(m, 16)); m = fmaxf(m, __shfl_xor(m, 32));
            float sum = 0.f;
#pragma unroll
            for (int nb = 0; nb < 16; ++nb) {
                const float p0 = __expf(s[nb][0] - m), p1 = __expf(s[nb][1] - m), p2 = __expf(s[nb][2] - m), p3 = __expf(s[nb][3] - m);
                sum += (p0 + p1) + (p2 + p3);
                v2u w; w.x = pk2(p0, p1); w.y = pk2(p2, p3);
                *(LAS v2u*)(Pw + fr * PSTR + nb * 16 + 4 * fq) = w;
            }
            sum += __shfl_xor(sum, 16); sum += __shfl_xor(sum, 32);
            inv_own = 1.f / sum;
        }
#pragma unroll
        for (int dc = 0; dc < 4; ++dc) {
            if (dc == 0) { xattn_store(lds + VS_OFF, r1, tid); xattn_load(r1, Vp, 3, tid); }
            else if (dc == 1) { xattn_store(lds + KS_OFF, r0, tid); if (more) xattn_load(r0, Kn, 0, tid); }
            else if (dc == 2) { xattn_store(lds + VS_OFF, r1, tid); if (more) xattn_load(r1, Kn, 1, tid); }
            else if (more) { xattn_store(lds + KS_OFF, r0, tid); xattn_load(r0, Kn, 2, tid); }
            const LAS unsigned char* vb = lds + ((dc & 1) ? VS_OFF : KS_OFF);
            f32x4 o[4];
#pragma unroll
            for (int db = 0; db < 4; ++db) o[db] = (f32x4){0.f, 0.f, 0.f, 0.f};
#pragma unroll
            for (int ks = 0; ks < 8; ++ks) {
                const bf16x8 pa = *(const LAS bf16x8*)(Pw + fr * PSTR + ks * 32 + 8 * fq);
#pragma unroll
                for (int db = 0; db < 4; ++db) o[db] = mfma16(tr_frag(vb, ks * 32, db * 16, KSTR, lane), pa, o[db]);
            }
            {
                bf16* orow = Op + (size_t)(wave * 16 + fr) * 1024 + dc * 64 + 4 * fq;
#pragma unroll
                for (int db = 0; db < 4; ++db) { v2u w; w.x = pk2(o[db][0] * inv_own, o[db][1] * inv_own); w.y = pk2(o[db][2] * inv_own, o[db][3] * inv_own); *(v2u*)(orow + db * 16) = w; }
            }
            LDS_WAIT(); __builtin_amdgcn_s_barrier(); asm volatile("" ::: "memory");
        }
        if (!more) break;
        u = un;
    }
}

constexpr int SSTR = 136;
constexpr int ACS_OFF = 139264, DTV_OFF = 141312;
__device__ __forceinline__ void ssd_dt_scan(const Args& A, LAS unsigned char* lds, int b, int c, int g, int wave, int lane, float* decay_out) {
    if (wave < 4) {
        const int h = g * 4 + wave;
        const float* dtr = (const float*)(A.ws + WS_DT);
        const float bias = A.in[13][h], aneg = -__expf(A.in[14][h]);
        const size_t row0 = (size_t)b * SEQ + c * 128 + 2 * lane;
        const float d0 = softplus_f(dtr[row0 * 8 + h] + bias), d1 = softplus_f(dtr[(row0 + 1) * 8 + h] + bias);
        const float a0 = d0 * aneg, a1 = d1 * aneg;
        float sc = a0 + a1;
#pragma unroll
        for (int o = 1; o < 64; o <<= 1) { const float t = __shfl_up(sc, o); if (lane >= o) sc += t; }
        const float ex = sc - (a0 + a1);
        LAS float* acs = (LAS float*)(lds + ACS_OFF) + wave * 128; LAS float* dtv = (LAS float*)(lds + DTV_OFF) + wave * 128;
        acs[2 * lane] = ex + a0; acs[2 * lane + 1] = sc; dtv[2 * lane] = d0; dtv[2 * lane + 1] = d1;
        if (decay_out && lane == 63) decay_out[(b * 8 + h) * 64 + c] = __expf(sc);
    }
}

constexpr int XWSTR = 264, BNSTR = 136;
__device__ __forceinline__ void ssd_pass1_unit(const Args& A, LAS unsigned char* lds, int u, int tid, int wave, int lane) {
    const int g = u & 1, c = (u >> 1) & 63, b = u >> 7;
    unsigned char* ws = A.ws;
    ssd_dt_scan(A, lds, b, c, g, wave, lane, (float*)(ws + WS_DEC));
    LDS_WAIT(); __builtin_amdgcn_s_barrier(); asm volatile("" ::: "memory");
    const LAS float* acs = (const LAS float*)(lds + ACS_OFF); const LAS float* dtv = (const LAS float*)(lds + DTV_OFF);
    LAS bf16* Xw = (LAS bf16*)lds;
    LAS bf16* Bn = (LAS bf16*)(lds + 67584);
    {
        const int c8 = tid & 63, ci = 8 * c8;
        int ch; if (ci < 256) ch = g * 256 + ci; else if (ci < 384) ch = 512 + g * 128 + (ci - 256); else ch = 768 + g * 128 + (ci - 384);
        const float* cw = A.in[11]; const float* cb = A.in[12];
        float w[4][8], bia[8];
#pragma unroll
        for (int k = 0; k < 4; ++k) { const f32x4 a = *(const f32x4*)(cw + k * 1024 + ch), bq = *(const f32x4*)(cw + k * 1024 + ch + 4);
            w[k][0] = a[0]; w[k][1] = a[1]; w[k][2] = a[2]; w[k][3] = a[3]; w[k][4] = bq[0]; w[k][5] = bq[1]; w[k][6] = bq[2]; w[k][7] = bq[3]; }
        { const f32x4 a = *(const f32x4*)(cb + ch), bq = *(const f32x4*)(cb + ch + 4); bia[0] = a[0]; bia[1] = a[1]; bia[2] = a[2]; bia[3] = a[3]; bia[4] = bq[0]; bia[5] = bq[1]; bia[6] = bq[2]; bia[7] = bq[3]; }
        const bf16* xb = (const bf16*)(ws + WS_XBC) + (size_t)b * SEQ * 1024 + ch;
        bf16* xc = (bf16*)(ws + WS_XC) + (size_t)b * SEQ * 1024 + ch;
        const int hh = ci >> 6;
        float aend = 0.f; if (ci < 256) aend = acs[hh * 128 + 127];
#pragma unroll 1
        for (int half = 0; half < 2; ++half) {
            const int l0 = wave * 16 + half * 8, t0 = c * 128 + l0;
            v4u raw[11];
#pragma unroll
            for (int k = 0; k < 11; ++k) { const int t = t0 - 3 + k; raw[k] = (v4u){0u, 0u, 0u, 0u}; if (t >= 0) raw[k] = *(const v4u*)(xb + (size_t)t * 1024); }
#pragma unroll
            for (int r = 0; r < 8; ++r) {
                float v[8];
#pragma unroll
                for (int e = 0; e < 8; ++e) {
                    float acc = bia[e];
#pragma unroll
                    for (int k = 0; k < 4; ++k) { const unsigned wd = raw[r + k][e >> 1]; acc += w[k][e] * ((e & 1) ? bfhi(wd) : bflo(wd)); }
                    v[e] = silu_f(acc);
                }
                const int l = l0 + r;
                v4u o; o.x = pk2(v[0], v[1]); o.y = pk2(v[2], v[3]); o.z = pk2(v[4], v[5]); o.w = pk2(v[6], v[7]);
                *(v4u*)(xc + (size_t)(t0 + r) * 1024) = o;
                if (ci < 256) {
                    const float wgt = dtv[hh * 128 + l] * __expf(aend - acs[hh * 128 + l]);
                    v4u ow; ow.x = pk2(v[0] * wgt, v[1] * wgt); ow.y = pk2(v[2] * wgt, v[3] * wgt); ow.z = pk2(v[4] * wgt, v[5] * wgt); ow.w = pk2(v[6] * wgt, v[7] * wgt);
                    *(LAS v4u*)(Xw + l * XWSTR + ci) = ow;
                } else if (ci < 384) {
                    *(LAS v4u*)(Bn + l * BNSTR + (ci - 256)) = o;
                }
            }
        }
    }
    LDS_WAIT(); __builtin_amdgcn_s_barrier(); asm volatile("" ::: "memory");
    {
        const int fr = lane & 15, fq = lane >> 4, pb = wave & 3, nh = wave >> 2;
        float* st = (float*)(ws + WS_STATE);
#pragma unroll 1
        for (int hh = 0; hh < 4; ++hh) {
            f32x4 acc[4];
#pragma unroll
            for (int i = 0; i < 4; ++i) acc[i] = (f32x4){0.f, 0.f, 0.f, 0.f};
#pragma unroll
            for (int ks = 0; ks < 4; ++ks) {
                const bf16x8 a = tr_frag((const LAS unsigned char*)Xw, ks * 32, hh * 64 + pb * 16, XWSTR, lane);
#pragma unroll
                for (int i = 0; i < 4; ++i) acc[i] = mfma16(tr_frag((const LAS unsigned char*)Bn, ks * 32, (nh * 4 + i) * 16, BNSTR, lane), a, acc[i]);
            }
            float* sp = st + ((size_t)((b * 64 + c) * 8 + g * 4 + hh)) * 8192 + (pb * 16 + fr) * 128 + 4 * fq;
#pragma unroll
            for (int i = 0; i < 4; ++i) *(f32x4*)(sp + (nh * 4 + i) * 16) = acc[i];
        }
    }
    LDS_WAIT(); __builtin_amdgcn_s_barrier(); asm volatile("" ::: "memory");
}

__device__ __forceinline__ void ssd_pass2_unit(const Args& A, LAS unsigned char* lds, int u, int tid, int wave, int lane) {
    const int g = u & 1, c = (u >> 1) & 63, b = u >> 7;
    unsigned char* ws = A.ws;
    const int fr = lane & 15, fq = lane >> 4;
    ssd_dt_scan(A, lds, b, c, g, wave, lane, nullptr);
    LAS bf16* Cs = (LAS bf16*)lds; LAS bf16* Bs = (LAS bf16*)(lds + 34816);
    LAS bf16* Pw = (LAS bf16*)(lds + 69632 + wave * 4352);
    LAS bf16* XT = (LAS bf16*)(lds + 104448); LAS bf16* Hs = (LAS bf16*)(lds + 121856);
    const LAS float* acs = (const LAS float*)(lds + ACS_OFF); const LAS float* dtv = (const LAS float*)(lds + DTV_OFF);
    const size_t row0 = (size_t)b * SEQ + c * 128;
    const bf16* xc = (const bf16*)(ws + WS_XC) + row0 * 1024;
#pragma unroll
    for (int i = 0; i < 4; ++i) {
        const int idx = tid + NTHR * i, r = idx >> 4, ch = idx & 15;
        *(LAS v4u*)(Cs + r * SSTR + ch * 8) = *(const v4u*)(xc + (size_t)r * 1024 + 768 + g * 128 + ch * 8);
        *(LAS v4u*)(Bs + r * SSTR + ch * 8) = *(const v4u*)(xc + (size_t)r * 1024 + 512 + g * 128 + ch * 8);
    }
    LDS_WAIT(); __builtin_amdgcn_s_barrier(); asm volatile("" ::: "memory");
    f32x4 G[8];
#pragma unroll
    for (int nb = 0; nb < 8; ++nb) G[nb] = (f32x4){0.f, 0.f, 0.f, 0.f};
#pragma unroll
    for (int ks = 0; ks < 4; ++ks) {
        const bf16x8 a = *(const LAS bf16x8*)(Cs + (wave * 16 + fr) * SSTR + ks * 32 + 8 * fq);
#pragma unroll
        for (int nb = 0; nb < 8; ++nb) { const bf16x8 bb = *(const LAS bf16x8*)(Bs + (nb * 16 + fr) * SSTR + ks * 32 + 8 * fq); G[nb] = mfma16(bb, a, G[nb]); }
    }
    const int l = wave * 16 + fr;
    float ssq1 = 0.f;
    float* tmp = (float*)(ws + WS_STATE) + (size_t)u * 128 * 256 + (size_t)l * 256 + 4 * fq;
    const bf16* zb = (const bf16*)(ws + WS_ZB) + (row0 + l) * 512 + 4 * fq;
    v4u xr[2], hr[2];
    {
        const bf16* hst0 = (const bf16*)(ws + WS_HST) + ((size_t)((b * 64 + c) * 8 + g * 4)) * 8192;
#pragma unroll
        for (int i = 0; i < 2; ++i) {
            const int idx = tid + NTHR * i;
            xr[i] = *(const v4u*)(xc + (size_t)(idx >> 3) * 1024 + g * 256 + (idx & 7) * 8);
            hr[i] = *(const v4u*)(hst0 + (idx >> 4) * 128 + (idx & 15) * 8);
        }
    }
#pragma unroll 1
    for (int hh = 0; hh < 4; ++hh) {
        const int h = g * 4 + hh;
        LDS_WAIT(); __builtin_amdgcn_s_barrier(); asm volatile("" ::: "memory");
#pragma unroll
        for (int i = 0; i < 2; ++i) {
            const int idx = tid + NTHR * i, r = idx >> 3, ch = idx & 7;
            const v4u val = xr[i];
            const float d = dtv[hh * 128 + r];
            LAS bf16* xt = XT + (ch * 8) * SSTR + r;
            xt[0 * SSTR] = f2bf(bflo(val.x) * d); xt[1 * SSTR] = f2bf(bfhi(val.x) * d);
            xt[2 * SSTR] = f2bf(bflo(val.y) * d); xt[3 * SSTR] = f2bf(bfhi(val.y) * d);
            xt[4 * SSTR] = f2bf(bflo(val.z) * d); xt[5 * SSTR] = f2bf(bfhi(val.z) * d);
            xt[6 * SSTR] = f2bf(bflo(val.w) * d); xt[7 * SSTR] = f2bf(bfhi(val.w) * d);
        }
#pragma unroll
        for (int i = 0; i < 2; ++i) {
            const int idx = tid + NTHR * i, r = idx >> 4, ch = idx & 15;
            *(LAS v4u*)(Hs + r * SSTR + ch * 8) = hr[i];
        }
        if (hh < 3) {
            const bf16* hstn = (const bf16*)(ws + WS_HST) + ((size_t)((b * 64 + c) * 8 + h + 1)) * 8192;
#pragma unroll
            for (int i = 0; i < 2; ++i) {
                const int idx = tid + NTHR * i;
                xr[i] = *(const v4u*)(xc + (size_t)(idx >> 3) * 1024 + (h + 1) * 64 + (idx & 7) * 8);
                hr[i] = *(const v4u*)(hstn + (idx >> 4) * 128 + (idx & 15) * 8);
            }
        }
        v2u zv[4];
#pragma unroll
        for (int pb = 0; pb < 4; ++pb) zv[pb] = *(const v2u*)(zb + h * 64 + pb * 16);
        {
            const float al = acs[hh * 128 + l];
#pragma unroll
            for (int nb = 0; nb < 8; ++nb) {
                const int s0 = nb * 16 + 4 * fq;
                const f32x4 as = *(const LAS f32x4*)(acs + hh * 128 + s0);
                float p[4];
#pragma unroll
                for (int j = 0; j < 4; ++j) p[j] = (s0 + j <= l) ? G[nb][j] * __expf(al - as[j]) : 0.f;
                v2u w; w.x = pk2(p[0], p[1]); w.y = pk2(p[2], p[3]);
                *(LAS v2u*)(Pw + fr * SSTR + s0) = w;
            }
        }
        LDS_WAIT(); __builtin_amdgcn_s_barrier(); asm volatile("" ::: "memory");
        f32x4 yd[4], yo[4];
#pragma unroll
        for (int pb = 0; pb < 4; ++pb) { yd[pb] = (f32x4){0.f, 0.f, 0.f, 0.f}; yo[pb] = (f32x4){0.f, 0.f, 0.f, 0.f}; }
#pragma unroll
        for (int ks = 0; ks < 4; ++ks) {
            const bf16x8 pa = *(const LAS bf16x8*)(Pw + fr * SSTR + ks * 32 + 8 * fq);
            const bf16x8 ca = *(const LAS bf16x8*)(Cs + (wave * 16 + fr) * SSTR + ks * 32 + 8 * fq);
#pragma unroll
            for (int pb = 0; pb < 4; ++pb) {
                const bf16x8 xb = *(const LAS bf16x8*)(XT + (pb * 16 + fr) * SSTR + ks * 32 + 8 * fq);
                const bf16x8 hb = *(const LAS bf16x8*)(Hs + (pb * 16 + fr) * SSTR + ks * 32 + 8 * fq);
                yd[pb] = mfma16(xb, pa, yd[pb]); yo[pb] = mfma16(hb, ca, yo[pb]);
            }
        }
        const float dsk = A.in[15][h];
        const float ea = __expf(acs[hh * 128 + l]), idt = 1.f / dtv[hh * 128 + l];
#pragma unroll
        for (int pb = 0; pb < 4; ++pb) {
            const float zf[4] = {bflo(zv[pb].x), bfhi(zv[pb].x), bflo(zv[pb].y), bfhi(zv[pb].y)};
            f32x4 uu;
#pragma unroll
            for (int j = 0; j < 4; ++j) {
                const int p = pb * 16 + 4 * fq + j;
                const float xv = bf2f(XT[p * SSTR + l]) * idt;
                const float y = yd[pb][j] + ea * yo[pb][j] + dsk * xv;
                uu[j] = y * silu_f(zf[j]);
                ssq1 += uu[j] * uu[j];
            }
            *(f32x4*)(tmp + hh * 64 + pb * 16) = uu;
        }
    }
    bf16* mix = (bf16*)(ws + WS_MIX) + (row0 + l) * 1024 + 512 + g * 256 + 4 * fq;
    const float* gs = A.in[16] + g * 256 + 4 * fq;
    ssq1 += __shfl_xor(ssq1, 16); ssq1 += __shfl_xor(ssq1, 32);
    const float rs = rsqrtf(ssq1 * (1.f / 256.f) + EPS);
#pragma unroll
    for (int half = 0; half < 2; ++half) {
        f32x4 tv[8], gv[8];
#pragma unroll
        for (int q = 0; q < 8; ++q) { tv[q] = *(const f32x4*)(tmp + (half * 8 + q) * 16); gv[q] = *(const f32x4*)(gs + (half * 8 + q) * 16); }
#pragma unroll
        for (int q = 0; q < 8; ++q) {
            const f32x4 o = tv[q] * rs * gv[q];
            v2u w; w.x = pk2(o[0], o[1]); w.y = pk2(o[2], o[3]);
            *(v2u*)(mix + (half * 8 + q) * 16) = w;
        }
    }
    LDS_WAIT(); __builtin_amdgcn_s_barrier(); asm volatile("" ::: "memory");
}

__device__ __forceinline__ void sample_attn_pair(const Args& A, LAS unsigned char* lds, int wu, int wave, int lane) {
    const int sb = wu >> 5, h = (wu >> 2) & 7, t = wu & 3;
    const int sub = lane & 7, grp = lane >> 3, half = wave >> 2;
    LAS float* sc = (LAS float*)(lds + wave * 2048);
    const float* SQ = (const float*)(A.ws + WS_SMISC);
    const float* qp = SQ + (size_t)(sb * 4 + t) * 512 + h * 64 + 8 * sub;
    const f32x4 qa = *(const f32x4*)qp, qb = *(const f32x4*)(qp + 4);
    const float* ck = A.in[2]; const float* cv = A.in[3];
    const float* ok = A.out + O_WKS; const float* ov = A.out + O_WVS;
    constexpr int NK = 387;
    const int it0 = half ? 25 : 0, it1 = half ? 49 : 25, k0 = it0 * 8, k1 = (it1 * 8 < NK) ? it1 * 8 : NK;
#pragma unroll 5
    for (int it = it0; it < it1; ++it) {
        const int kk = it * 8 + grp, kc = kk < NK ? kk : NK - 1;
        const int br = kc / 129, j = kc - br * 129, dil = br == 0 ? 1 : (br == 1 ? 4 : 16);
        const int idx = LW + t - dil * j;
        const float* kp = ((idx < LW) ? ck + ((size_t)(sb * LW + idx) * 512 + h * 64) : ok + ((size_t)(sb * LW + idx - ST) * 512 + h * 64)) + 8 * sub;
        const f32x4 ka = *(const f32x4*)kp, kb = *(const f32x4*)(kp + 4);
        float s = ((qa[0] * ka[0] + qa[1] * ka[1]) + (qa[2] * ka[2] + qa[3] * ka[3])) + ((qb[0] * kb[0] + qb[1] * kb[1]) + (qb[2] * kb[2] + qb[3] * kb[3]));
        s += __shfl_xor(s, 1); s += __shfl_xor(s, 2); s += __shfl_xor(s, 4);
        if (sub == 0 && kk < NK) sc[kk - k0] = s * 0.125f;
    }
    LDS_WAIT();
    const int nk = k1 - k0;
    float m = -INFINITY;
    for (int kk = lane; kk < nk; kk += 64) m = fmaxf(m, sc[kk]);
    m = wave_max(m);
    float sum = 0.f;
    for (int kk = lane; kk < nk; kk += 64) { const float p = __expf(sc[kk] - m); sc[kk] = p; sum += p; }
    sum = wave_sum(sum);
    LDS_WAIT();
    f32x4 acca = {0.f, 0.f, 0.f, 0.f}, accb = {0.f, 0.f, 0.f, 0.f};
#pragma unroll 5
    for (int it = it0; it < it1; ++it) {
        const int kk = it * 8 + grp, kc = kk < NK ? kk : NK - 1;
        const int br = kc / 129, j = kc - br * 129, dil = br == 0 ? 1 : (br == 1 ? 4 : 16);
        const int idx = LW + t - dil * j;
        const float* vp = ((idx < LW) ? cv + ((size_t)(sb * LW + idx) * 512 + h * 64) : ov + ((size_t)(sb * LW + idx - ST) * 512 + h * 64)) + 8 * sub;
        const f32x4 va = *(const f32x4*)vp, vb = *(const f32x4*)(vp + 4);
        const float p = kk < NK ? sc[kk - k0] : 0.f;
        acca = acca + va * p; accb = accb + vb * p;
    }
#pragma unroll
    for (int e = 0; e < 4; ++e) {
        acca[e] += __shfl_xor(acca[e], 8); acca[e] += __shfl_xor(acca[e], 16); acca[e] += __shfl_xor(acca[e], 32);
        accb[e] += __shfl_xor(accb[e], 8); accb[e] += __shfl_xor(accb[e], 16); accb[e] += __shfl_xor(accb[e], 32);
    }
    if (half == 1 && grp == 0) {
        *(LAS f32x4*)(sc + 400 + 2 + 8 * sub + 6) = acca; *(LAS f32x4*)(sc + 400 + 2 + 8 * sub + 10) = accb;
        if (sub == 0) { sc[400] = m; sc[401] = sum; }
    }
    __syncthreads();
    if (half == 0 && grp == 0) {
        const LAS float* ps = (const LAS float*)(lds + (wave + 4) * 2048) + 400;
        const float m1 = ps[0], s1 = ps[1];
        const f32x4 oa = *(const LAS f32x4*)(ps + 8 + 8 * sub), ob = *(const LAS f32x4*)(ps + 12 + 8 * sub);
        const float mm = fmaxf(m, m1), a0 = __expf(m - mm), a1 = __expf(m1 - mm);
        const float is = 1.f / (sum * a0 + s1 * a1);
        const f32x4 ra = (acca * a0 + oa * a1) * is, rb = (accb * a0 + ob * a1) * is;
        v4u o; o.x = pk2(ra[0], ra[1]); o.y = pk2(ra[2], ra[3]); o.z = pk2(rb[0], rb[1]); o.w = pk2(rb[2], rb[3]);
        *(v4u*)((bf16*)(A.ws + WS_MIX) + (size_t)(MP + sb * 4 + t) * 1024 + h * 64 + 8 * sub) = o;
    }
    __syncthreads();
}

__device__ __forceinline__ void sample_ssd_unit(const Args& A, LAS unsigned char* lds, int u, int tid) {
    const int sb = u >> 3, h = u & 7, g = h >> 2;
    LAS float* cvv = (LAS float*)lds;
    LAS float* dts = cvv + 1280;
    const float* SX = (const float*)(A.ws + WS_SMISC) + 128 * 512;
    float* SY = (float*)(A.ws + WS_SMISC) + 128 * 512 + 128 * 1024;
    for (int idx = tid; idx < 1280; idx += NTHR) {
        const int t = idx / 320, ci = idx - t * 320;
        int ch; if (ci < 64) ch = h * 64 + ci; else if (ci < 192) ch = 512 + g * 128 + (ci - 64); else ch = 768 + g * 128 + (ci - 192);
        float acc = A.in[12][ch];
#pragma unroll
        for (int i = 0; i < 4; ++i) {
            const int k = t + i;
            const float xv = (k < 3) ? A.in[4][(size_t)(sb * 3 + k) * 1024 + ch] : SX[(size_t)(sb * 4 + k - 3) * 1024 + ch];
            acc += xv * A.in[11][i * 1024 + ch];
        }
        cvv[idx] = silu_f(acc);
    }
    if (tid < 4) {
        const float d = softplus_f(((const float*)(A.ws + WS_DT))[(size_t)(MP + sb * 4 + tid) * 8 + h] + A.in[13][h]);
        dts[tid] = d; dts[4 + tid] = __expf(d * -__expf(A.in[14][h]));
    }
    __syncthreads();
    const int p = tid >> 3, n0 = (tid & 7) * 16;
    const float* sin_ = A.in[5] + ((size_t)(sb * 8 + h) * 64 + p) * 128 + n0;
    float hs[16];
#pragma unroll
    for (int i = 0; i < 4; ++i) { const f32x4 v = *(const f32x4*)(sin_ + 4 * i); hs[4 * i] = v[0]; hs[4 * i + 1] = v[1]; hs[4 * i + 2] = v[2]; hs[4 * i + 3] = v[3]; }
    const float dsk = A.in[15][h];
#pragma unroll
    for (int t = 0; t < 4; ++t) {
        const float dA = dts[4 + t], xv = cvv[t * 320 + p], xd = xv * dts[t];
        float part = 0.f;
#pragma unroll
        for (int i = 0; i < 16; ++i) { hs[i] = hs[i] * dA + xd * cvv[t * 320 + 64 + n0 + i]; part += cvv[t * 320 + 192 + n0 + i] * hs[i]; }
        part += __shfl_xor(part, 1); part += __shfl_xor(part, 2); part += __shfl_xor(part, 4);
        if ((tid & 7) == 0) SY[(size_t)(sb * 4 + t) * 512 + h * 64 + p] = part + dsk * xv;
    }
    float* so = A.out + O_SSS + ((size_t)(sb * 8 + h) * 64 + p) * 128 + n0;
#pragma unroll
    for (int i = 0; i < 4; ++i) *(f32x4*)(so + 4 * i) = (f32x4){hs[4 * i], hs[4 * i + 1], hs[4 * i + 2], hs[4 * i + 3]};
    __syncthreads();
}

__device__ __forceinline__ void sample_xattn_unit(const Args& A, LAS unsigned char* lds, int u, int tid, int wave, int lane) {
    const int sb = u >> 2, h = u & 3;
    LAS float* qs = (LAS float*)lds; LAS float* sc = qs + 1024; LAS float* red = sc + 1024;
    const bf16* XQ = (const bf16*)(A.ws + WS_A0);
    for (int i = tid; i < 1024; i += NTHR) qs[i] = bf2f(XQ[(size_t)(MP + sb * 4 + (i >> 8)) * 1024 + h * 256 + (i & 255)]);
    __syncthreads();
    const float* cmk = A.in[6]; const float* cmv = A.in[7];
    {
        f32x4 q[4];
#pragma unroll
        for (int t = 0; t < 4; ++t) q[t] = *(const LAS f32x4*)(qs + t * 256 + 4 * lane);
#pragma unroll 8
        for (int mi = 0; mi < 32; ++mi) {
            const int m = wave * 32 + mi;
            const f32x4 k4 = *(const f32x4*)(cmk + ((size_t)(sb * 256 + m) * 4 + h) * 256 + 4 * lane);
#pragma unroll
            for (int t = 0; t < 4; ++t) {
                float s = (q[t][0] * k4[0] + q[t][1] * k4[1]) + (q[t][2] * k4[2] + q[t][3] * k4[3]);
                s = wave_sum(s);
                if (lane == 0) sc[t * 256 + m] = s;
            }
        }
    }
    __syncthreads();
    if (wave < 4) {
        float v[4]; float m = -INFINITY;
#pragma unroll
        for (int i = 0; i < 4; ++i) { v[i] = sc[wave * 256 + lane + 64 * i]; m = fmaxf(m, v[i]); }
        m = wave_max(m);
        float sum = 0.f;
#pragma unroll
        for (int i = 0; i < 4; ++i) { v[i] = __expf(v[i] - m); sum += v[i]; }
        sum = wave_sum(sum);
        const float is = 1.f / sum;
#pragma unroll
        for (int i = 0; i < 4; ++i) sc[wave * 256 + lane + 64 * i] = v[i] * is;
    }
    __syncthreads();
    {
        f32x4 o[4];
#pragma unroll
        for (int t = 0; t < 4; ++t) o[t] = (f32x4){0.f, 0.f, 0.f, 0.f};
#pragma unroll 8
        for (int mi = 0; mi < 32; ++mi) {
            const int m = wave * 32 + mi;
            const f32x4 v = *(const f32x4*)(cmv + ((size_t)(sb * 256 + m) * 4 + h) * 256 + 4 * lane);
#pragma unroll
            for (int t = 0; t < 4; ++t) o[t] = o[t] + v * sc[t * 256 + m];
        }
#pragma unroll
        for (int t = 0; t < 4; ++t) *(LAS f32x4*)(red + (wave * 4 + t) * 256 + 4 * lane) = o[t];
    }
    __syncthreads();
    {
        bf16* XO = (bf16*)(A.ws + WS_MIX);
        for (int i = tid; i < 1024; i += NTHR) {
            const int t = i >> 8, d = i & 255; float a = 0.f;
#pragma unroll
            for (int w2 = 0; w2 < 8; ++w2) a += red[(w2 * 4 + t) * 256 + d];
            XO[(size_t)(MP + sb * 4 + t) * 1024 + h * 256 + d] = f2bf(a);
        }
    }
    __syncthreads();
}

#ifndef N_LAUNCHES
#define N_LAUNCHES 1
#endif
constexpr int NPHASE = 13;

__global__ void __launch_bounds__(NTHR, 2) mega_fwd(Args A) {
    extern __shared__ __attribute__((aligned(16))) unsigned char lds_raw[];
    LAS unsigned char* lds = (LAS unsigned char*)lds_raw;
    cg::grid_group grid = cg::this_grid();
    const int tid = threadIdx.x, lane = tid & 63, wave = __builtin_amdgcn_readfirstlane(tid >> 6);
    const int G = gridDim.x, bid = blockIdx.x;
    unsigned char* ws = A.ws;
    const int lo = A.ph_lo, hi = A.ph_hi;
    volatile LAS unsigned* bst = (volatile LAS unsigned*)(lds + LDS_BYTES - 16);
    if (tid < 4) bst[tid] = 0u;
    unsigned* barw = (unsigned*)ws;
    __syncthreads();
    if (lo < 0) grid.sync();
    XcdBarrier xbar = xcd_barrier_post(barw, bst);
#ifndef PHASE_MASK
#define PHASE_MASK 0xfff
#endif
#define IN(k) (((PHASE_MASK >> (k)) & 1) && lo <= (k) && (k) < hi)
#ifndef REPEAT_MASK
#define REPEAT_MASK 0
#endif
#if REPEAT_MASK == 0
#define PH(k) if (IN(k))
#define rep_ 0
#else
#define PH(k) for (int rep_ = 0; rep_ < 1 + ((REPEAT_MASK >> (k)) & 1); ++rep_) if (IN(k))
#endif
#define SEAM(k) do { if (IN(k) && IN((k) + 1)) xcd_barrier(xbar); } while (0)

    PH(0) { if (rep_) grid.sync(); p0_prologue(A, lds, tid, wave, lane); }
    SEAM(0);

    PH(1) { if (rep_) grid.sync();
        F1 f{(bf16*)(ws + WS_QB), (bf16*)(ws + WS_KB), (bf16*)(ws + WS_VB), (bf16*)(ws + WS_ZB), (bf16*)(ws + WS_XBC), A.out,
             (float*)(ws + WS_SMISC), (float*)(ws + WS_SMISC) + 128 * 512, (const float*)(ws + WS_COS), (const float*)(ws + WS_SIN)};
        {
            pg8::Gemm g{(const pg8::bf16_t*)(ws + WS_A0), (const pg8::bf16_t*)(ws + WS_WIN), MP, NIN, DM};
            pg8::StaticOrder S; S.init(MP, NIN, G, bid);
            EpiWrap<F1> E{f};
            pg8::gemm_phase<EpiWrap<F1>, pg8::StaticOrder, true, true>(lds, g, S, E);
        }
        for (int u = bid; u < 2 * (NIN / 32); u += G)
            small_gemm_unit<4>(lds, (const bf16*)(ws + WS_A0) + (size_t)(MP + (u & 1) * 64) * DM, MP + (u & 1) * 64, (const bf16*)(ws + WS_WIN), DM, (u >> 1) * 32, f, wave, lane);
        FMem fm{A.out, (bf16*)(ws + WS_MKB), (bf16*)(ws + WS_MVB)};
        for (int u = bid; u < 4 * 64; u += G) {
            const int rt = u >> 6, cn = u & 63;
            small_gemm_unit<8>(lds, (const bf16*)(ws + WS_AM) + (size_t)rt * 128 * DM, rt * 128, (const bf16*)(ws + WS_WMKV), DM, cn * 32, fm, wave, lane);
        }
    }
    SEAM(1);

    PH(2) { if (rep_) grid.sync();
        static_assert(CP_P7 == 512, "256 pass-1 units + 256 sample SSD units carry the 512 remaining copy chunks");
        for (int u = bid; u < 256; u += G) { f32x4 ck[8], cv[8]; cp_load<8>(A, (CP_P3 + u) * 4096, ck, cv, tid); ssd_pass1_unit(A, lds, u, tid, wave, lane); cp_store<8>(A, (CP_P3 + u) * 4096, ck, cv, tid); }
        for (int u = bid; u < SB * 8; u += G) { f32x4 ck[8], cv[8]; cp_load<8>(A, (CP_P3 + 256 + u) * 4096, ck, cv, tid); sample_ssd_unit(A, lds, u, tid); cp_store<8>(A, (CP_P3 + 256 + u) * 4096, ck, cv, tid); }
        for (int pu = bid * 4; pu < SB * 8 * ST; pu += G * 4) sample_attn_pair(A, lds, pu + (wave & 3), wave, lane);
        __syncthreads();
    }
    SEAM(2);

    PH(3) { if (rep_) grid.sync();
        {
            const float* st = (const float*)(ws + WS_STATE); bf16* hst = (bf16*)(ws + WS_HST); const float* dec = (const float*)(ws + WS_DEC);
            for (int e = bid * NTHR + tid; e < NBAT * 8 * 64 * 128; e += G * NTHR) {
                const int pn = e & 8191, h = (e >> 13) & 7, b = e >> 16;
                float hr = 0.f;
#pragma unroll 1
                for (int c0 = 0; c0 < 64; c0 += 32) {
                    float sv[32], dv[32];
#pragma unroll
                    for (int k = 0; k < 32; ++k) { sv[k] = st[((size_t)((b * 64 + c0 + k) * 8 + h)) * 8192 + pn]; dv[k] = dec[(b * 8 + h) * 64 + c0 + k]; }
#pragma unroll
                    for (int k = 0; k < 32; ++k) { hst[((size_t)((b * 64 + c0 + k) * 8 + h)) * 8192 + pn] = f2bf(hr); hr = hr * dv[k] + sv[k]; }
                }
                A.out[O_SSP + (size_t)(b * 8 + h) * 8192 + pn] = hr;
            }
        }
        dil_attn_phase(A, lds, tid, wave, lane);
    }
    SEAM(3);

    PH(4) { if (rep_) grid.sync();
        for (int u = bid; u < 256; u += G) ssd_pass2_unit(A, lds, u, tid, wave, lane);
        {
            const float* lse = (const float*)(ws + WS_LSE); const bf16* obr = (const bf16*)(ws + WS_OBR); bf16* mix = (bf16*)(ws + WS_MIX);
            for (int i0 = bid * NTHR + tid; i0 < MP * 64; i0 += 4 * G * NTHR) {
                float w0[4], w1[4], w2[4]; v4u a[4], b2[4], c2[4];
#pragma unroll
                for (int k = 0; k < 4; ++k) {
                    const int i = i0 + k * G * NTHR;
                    if (i < MP * 64) {
                        const int row = i >> 6, hc = i & 63, h = hc >> 3;
                        w0[k] = lse[(size_t)row * 8 + h]; w1[k] = lse[(size_t)MP * 8 + (size_t)row * 8 + h]; w2[k] = lse[(size_t)2 * MP * 8 + (size_t)row * 8 + h];
                        const size_t o = (size_t)row * 512 + hc * 8;
                        a[k] = *(const v4u*)(obr + o); b2[k] = *(const v4u*)(obr + (size_t)MP * 512 + o); c2[k] = *(const v4u*)(obr + (size_t)2 * MP * 512 + o);
                    }
                }
#pragma unroll
                for (int k = 0; k < 4; ++k) {
                    const int i = i0 + k * G * NTHR;
                    if (i < MP * 64) {
                        const int row = i >> 6, hc = i & 63;
                        const float m = fmaxf(w0[k], fmaxf(w1[k], w2[k]));
                        float e0 = __expf(w0[k] - m), e1 = __expf(w1[k] - m), e2 = __expf(w2[k] - m);
                        const float is = 1.f / (e0 + e1 + e2); e0 *= is; e1 *= is; e2 *= is;
                        v4u r;
                        r.x = pk2(e0 * bflo(a[k].x) + e1 * bflo(b2[k].x) + e2 * bflo(c2[k].x), e0 * bfhi(a[k].x) + e1 * bfhi(b2[k].x) + e2 * bfhi(c2[k].x));
                        r.y = pk2(e0 * bflo(a[k].y) + e1 * bflo(b2[k].y) + e2 * bflo(c2[k].y), e0 * bfhi(a[k].y) + e1 * bfhi(b2[k].y) + e2 * bfhi(c2[k].y));
                        r.z = pk2(e0 * bflo(a[k].z) + e1 * bflo(b2[k].z) + e2 * bflo(c2[k].z), e0 * bfhi(a[k].z) + e1 * bfhi(b2[k].z) + e2 * bfhi(c2[k].z));
                        r.w = pk2(e0 * bflo(a[k].w) + e1 * bflo(b2[k].w) + e2 * bflo(c2[k].w), e0 * bfhi(a[k].w) + e1 * bfhi(b2[k].w) + e2 * bfhi(c2[k].w));
                        *(v4u*)(mix + (size_t)row * 1024 + hc * 8) = r;
                    }
                }
            }
            const float* SY = (const float*)(ws + WS_SMISC) + 128 * 512 + 128 * 1024; const bf16* zb = (const bf16*)(ws + WS_ZB);
            for (int wu = bid * NWAVES + wave; wu < MS * 2; wu += G * NWAVES) {
                const int r = wu >> 1, g = wu & 1;
                const f32x4 y = *(const f32x4*)(SY + (size_t)r * 512 + g * 256 + 4 * lane);
                const v2u zz = *(const v2u*)(zb + (size_t)(MP + r) * 512 + g * 256 + 4 * lane);
                f32x4 uu = {y[0] * silu_f(bflo(zz.x)), y[1] * silu_f(bfhi(zz.x)), y[2] * silu_f(bflo(zz.y)), y[3] * silu_f(bfhi(zz.y))};
                const float s = wave_sum((uu[0] * uu[0] + uu[1] * uu[1]) + (uu[2] * uu[2] + uu[3] * uu[3]));
                const float rs = rsqrtf(s * (1.f / 256.f) + EPS);
                const f32x4 gg = *(const f32x4*)(A.in[16] + g * 256 + 4 * lane);
                v2u o; o.x = pk2(uu[0] * rs * gg[0], uu[1] * rs * gg[1]); o.y = pk2(uu[2] * rs * gg[2], uu[3] * rs * gg[3]);
                *(v2u*)(mix + (size_t)(MP + r) * 1024 + 512 + g * 256 + 4 * lane) = o;
            }
        }
    }
    SEAM(4);

    PH(5) { if (rep_) grid.sync();
        FRes<0> f{(const float*)(ws + WS_A0), (const float*)(ws + WS_DT + 768 * 1024), A.out, (bf16*)(ws + WS_XB), (float*)(ws + WS_SSQ1)};
        {
            pg8::Gemm g{(const pg8::bf16_t*)(ws + WS_MIX), (const pg8::bf16_t*)(ws + WS_WOUT), MP, DM, DM};
            pg8::StaticOrder S; S.init(MP, DM, G, bid);
            EpiWrap<FRes<0>> E{f};
            pg8::gemm_phase<EpiWrap<FRes<0>>, pg8::StaticOrder, true, true>(lds, g, S, E);
        }
        for (int u = bid; u < 8 * (DM / 32); u += G)
            small_gemm_unit<1>(lds, (const bf16*)(ws + WS_MIX) + (size_t)MP * DM + (size_t)(u & 7) * 16 * DM, MP + (u & 7) * 16, (const bf16*)(ws + WS_WOUT), DM, (u >> 3) * 32, f, wave, lane);
    }
    SEAM(5);

    PH(6) { if (rep_) grid.sync();
        FScale<0> f{(const float*)(ws + WS_SSQ1), (bf16*)(ws + WS_A0), DM, 0.0625f};
        {
            pg8::Gemm g{(const pg8::bf16_t*)(ws + WS_XB), (const pg8::bf16_t*)(ws + WS_WXQ), MP, DM, DM};
            pg8::StaticOrder S; S.init(MP, DM, G, bid);
            EpiWrap<FScale<0>> E{f};
            pg8::gemm_phase<EpiWrap<FScale<0>>, pg8::StaticOrder, true, true>(lds, g, S, E);
        }
        for (int u = bid; u < 8 * (DM / 32); u += G)
            small_gemm_unit<1>(lds, (const bf16*)(ws + WS_XB) + (size_t)MP * DM + (size_t)(u & 7) * 16 * DM, MP + (u & 7) * 16, (const bf16*)(ws + WS_WXQ), DM, (u >> 3) * 32, f, wave, lane);
    }
    SEAM(6);

    PH(7) { if (rep_) grid.sync();
        xattn_phase(A, lds, tid, wave, lane);
        for (int u = bid; u < SB * 4; u += G) sample_xattn_unit(A, lds, u, tid, wave, lane);
    }
    SEAM(7);

    PH(8) { if (rep_) grid.sync();
        FRes<1> f{nullptr, nullptr, A.out, (bf16*)(ws + WS_XB), (float*)(ws + WS_SSQ2)};
        {
            pg8::Gemm g{(const pg8::bf16_t*)(ws + WS_MIX), (const pg8::bf16_t*)(ws + WS_WXO), MP, DM, DM};
            pg8::StaticOrder S; S.init(MP, DM, G, bid);
            EpiWrap<FRes<1>> E{f};
            pg8::gemm_phase<EpiWrap<FRes<1>>, pg8::StaticOrder, true, true>(lds, g, S, E);
        }
        for (int u = bid; u < 8 * (DM / 32); u += G)
            small_gemm_unit<1>(lds, (const bf16*)(ws + WS_MIX) + (size_t)MP * DM + (size_t)(u & 7) * 16 * DM, MP + (u & 7) * 16, (const bf16*)(ws + WS_WXO), DM, (u >> 3) * 32, f, wave, lane);
    }
    SEAM(8);

    PH(9) { if (rep_) grid.sync();
        FScale<1> f{(const float*)(ws + WS_SSQ2), (bf16*)(ws + WS_U), DFF, 1.f};
        {
            pg8::Gemm g{(const pg8::bf16_t*)(ws + WS_XB), (const pg8::bf16_t*)(ws + WS_WUP), MP, DFF, DM};
            pg8::StaticOrder S; S.init(MP, DFF, G, bid);
            EpiWrap<FScale<1>> E{f};
            pg8::gemm_phase<EpiWrap<FScale<1>>, pg8::StaticOrder, true, true>(lds, g, S, E);
        }
        for (int u = bid; u < 2 * (DFF / 32); u += G)
            small_gemm_unit<4>(lds, (const bf16*)(ws + WS_XB) + (size_t)(MP + (u & 1) * 64) * DM, MP + (u & 1) * 64, (const bf16*)(ws + WS_WUP), DM, (u >> 1) * 32, f, wave, lane);
    }
    SEAM(9);

    PH(10) { if (rep_) grid.sync();
        FRes<1> f{nullptr, nullptr, A.out, (bf16*)(ws + WS_XB), (float*)(ws + WS_SSQ3)};
        {
            pg8::Gemm g{(const pg8::bf16_t*)(ws + WS_U), (const pg8::bf16_t*)(ws + WS_WDN), MP, DM, DFF};
            pg8::StaticOrder S; S.init(MP, DM, G, bid);
            EpiWrap<FRes<1>> E{f};
            pg8::gemm_phase<EpiWrap<FRes<1>>, pg8::StaticOrder, true, true>(lds, g, S, E);
        }
        for (int u = bid; u < 8 * (DM / 32); u += G)
            small_gemm_unit<1>(lds, (const bf16*)(ws + WS_U) + (size_t)MP * DFF + (size_t)(u & 7) * 16 * DFF, MP + (u & 7) * 16, (const bf16*)(ws + WS_WDN), DFF, (u >> 3) * 32, f, wave, lane);
    }
    SEAM(10);

    PH(11) { if (rep_) grid.sync();
        const float* ssq = (const float*)(ws + WS_SSQ3); const bf16* xb = (const bf16*)(ws + WS_XB);
        f32x4 gg[4];
#pragma unroll
        for (int j = 0; j < 4; ++j) gg[j] = *(const f32x4*)(A.in[27] + 4 * lane + 256 * j);
        const int r0 = bid * NWAVES + wave, rstep = G * NWAVES;
        v2u nv[4]; float nrs = 0.f;
        if (r0 < MT) {
            nrs = rstd_from(ssq, r0);
#pragma unroll
            for (int j = 0; j < 4; ++j) nv[j] = *(const v2u*)(xb + (size_t)r0 * DM + 4 * lane + 256 * j);
        }
        for (int row = r0; row < MT; row += rstep) {
            v2u v[4]; const float rs = nrs;
#pragma unroll
            for (int j = 0; j < 4; ++j) v[j] = nv[j];
            const int rn = row + rstep;
            if (rn < MT) {
                nrs = rstd_from(ssq, rn);
#pragma unroll
                for (int j = 0; j < 4; ++j) nv[j] = *(const v2u*)(xb + (size_t)rn * DM + 4 * lane + 256 * j);
            }
            float* y = (row < MP) ? A.out + O_YP + (size_t)row * DM : A.out + O_YS + (size_t)(row - MP) * DM;
#pragma unroll
            for (int j = 0; j < 4; ++j) *(f32x4*)(y + 4 * lane + 256 * j) = (f32x4){bflo(v[j].x), bfhi(v[j].x), bflo(v[j].y), bfhi(v[j].y)} * rs * gg[j];
        }
    }
#ifdef EXTRA_SYNCS
    if (hi == NPHASE && lo == 0) { for (int i = 0; i < EXTRA_SYNCS; ++i) grid.sync(); }
#endif
#undef IN
#undef SEAM
}

extern "C" void kernel_launch(void* const* d_in, const int* in_sizes, int n_in, void* d_out, int out_size, void* d_ws, size_t ws_size, hipStream_t stream) {
    static int grid = 0;
    if (grid == 0) {
        if (n_in != 28 || (size_t)out_size != O_END || ws_size < WS_END) { fprintf(stderr, "kernel_launch: unexpected shapes: n_in %d out %d ws %zu\n", n_in, out_size, ws_size); grid = -1; return; }
        int dev = 0, cus = 0, per_cu = 0;
        (void)hipGetDevice(&dev);
        (void)hipDeviceGetAttribute(&cus, hipDeviceAttributeMultiprocessorCount, dev);
        if (hipFuncSetAttribute((const void*)mega_fwd, hipFuncAttributeMaxDynamicSharedMemorySize, LDS_BYTES) != hipSuccess) { fprintf(stderr, "kernel_launch: hipFuncSetAttribute failed\n"); grid = -1; return; }
        if (hipOccupancyMaxActiveBlocksPerMultiprocessor(&per_cu, (const void*)mega_fwd, NTHR, LDS_BYTES) != hipSuccess || per_cu < 1) { fprintf(stderr, "kernel_launch: occupancy query says %d\n", per_cu); (void)hipGetLastError(); per_cu = 1; }
        grid = cus * 1;
        if (grid <= 0) grid = 256;
    }
    if (grid < 0) return;
    Args a{};
    for (int i = 0; i < 28; ++i) a.in[i] = (const float*)d_in[i];
    a.out = (float*)d_out; a.ws = (unsigned char*)d_ws;
    auto launch = [&](int lo, int hi) {
        a.ph_lo = lo; a.ph_hi = hi;
        (void)hipMemsetAsync(d_ws, 0, XCD_BAR_WORDS * 4, stream);
        void* args[] = {&a};
        hipError_t e = hipLaunchCooperativeKernel((const void*)mega_fwd, dim3(grid), dim3(NTHR), args, LDS_BYTES, stream);
        if (e != hipSuccess) fprintf(stderr, "kernel_launch: cooperative launch failed: %s (grid %d)\n", hipGetErrorString(e), grid);
    };
#if defined(PROBE_PHASE)
    launch(0, PROBE_PHASE + 1); launch(PROBE_PHASE, PROBE_PHASE + 1); if (PROBE_PHASE + 1 < NPHASE) launch(PROBE_PHASE + 1, NPHASE);
#elif N_LAUNCHES == 1
    launch(0, NPHASE);
#else
    for (int p = 0; p < NPHASE; ++p) launch(p, p + 1);
#endif
}
```
